# Optimizing an MI355X kernel written in HIP

```python
import jax, jax.numpy as jnp
from jax import lax
import numpy as np

D_MODEL = 2048
BATCH = 8
SEQ = 2048
DEPTH = 2

N_META = 16
MLSTM_W = D_MODEL // 2
CONV_W = D_MODEL - MLSTM_W
MLSTM_HEADS = 4
DV = MLSTM_W // MLSTM_HEADS
DQK = DV // 2
QK_W = MLSTM_HEADS * DQK
CHUNK = 64
CONV_K = 3
D_FF = -(-8 * D_MODEL // (3 * 256)) * 256
GATE_CAP = 15.0
EPS = 1e-6
SPLIT_SIZES = (QK_W, QK_W, MLSTM_W, MLSTM_W, MLSTM_HEADS, MLSTM_HEADS, CONV_W, CONV_W, CONV_W)
D_IN = sum(SPLIT_SIZES)

kernel_name = "hymba_mlstm_shortconv_swiglu"


def rmsnorm(x, w):
    xf = x.astype(jnp.float32)
    y = xf * lax.rsqrt(jnp.mean(xf * xf, axis=-1, keepdims=True) + EPS)
    return (y * w.astype(jnp.float32)).astype(x.dtype)


def mlstm_chunkwise(q, k, v, log_i, log_f):
    b_, h_, t_, _ = q.shape
    nc = t_ // CHUNK

    def to_chunks(a):
        return jnp.moveaxis(a.reshape(a.shape[:2] + (nc, CHUNK) + a.shape[3:]), 2, 0)

    causal = jnp.tril(jnp.ones((CHUNK, CHUNK), dtype=bool))

    def step(carry, inp):
        c_st, n_st, m_st = carry
        qb, kb, vb, li, lf = inp
        b = jnp.cumsum(lf, axis=-1)
        dmat = jnp.where(causal, b[..., :, None] - b[..., None, :] + li[..., None, :], -jnp.inf)
        inter = b + m_st[..., None]
        m_t = jnp.maximum(inter, jnp.max(dmat, axis=-1))
        w_inter = jnp.exp(inter - m_t)
        s_w = jnp.einsum('bhtd,bhsd->bhts', qb, kb) * jnp.exp(dmat - m_t[..., None])
        num = (w_inter[..., None] * jnp.einsum('bhtd,bhde->bhte', qb, c_st)
               + jnp.einsum('bhts,bhse->bhte', s_w, vb))
        den = w_inter * jnp.einsum('bhtd,bhd->bht', qb, n_st) + jnp.sum(s_w, axis=-1)
        h = num / jnp.maximum(jnp.abs(den), jnp.exp(-m_t))[..., None]
        b_end = b[..., -1]
        decay = b_end[..., None] - b + li
        m_new = jnp.maximum(b_end + m_st, jnp.max(decay, axis=-1))
        w_old = jnp.exp(b_end + m_st - m_new)
        w_in = jnp.exp(decay - m_new[..., None])
        c_new = w_old[..., None, None] * c_st + jnp.einsum('bhs,bhsd,bhse->bhde', w_in, kb, vb)
        n_new = w_old[..., None] * n_st + jnp.einsum('bhs,bhsd->bhd', w_in, kb)
        return (c_new, n_new, m_new), h

    init = (jnp.zeros((b_, h_, q.shape[-1], v.shape[-1]), jnp.float32),
            jnp.zeros((b_, h_, q.shape[-1]), jnp.float32),
            jnp.zeros((b_, h_), jnp.float32))
    _, hs = lax.scan(step, init, tuple(map(to_chunks, (q, k, v, log_i, log_f))))
    return jnp.moveaxis(hs, 0, 2).reshape(b_, h_, t_, v.shape[-1])


def mlstm_group(q, k, v, i_raw, f_raw):
    seq_len = q.shape[1]
    pad_front = (-N_META) % CHUNK
    pad_back = (-(pad_front + seq_len)) % CHUNK
    tr = lambda a: jnp.moveaxis(a.astype(jnp.float32), 1, 2)
    q, k, v = tr(q) * (DQK ** -0.5), tr(k), tr(v)
    log_i = tr(GATE_CAP * jnp.tanh(i_raw.astype(jnp.float32) / GATE_CAP))
    log_f = jax.nn.log_sigmoid(tr(GATE_CAP * jnp.tanh(f_raw.astype(jnp.float32) / GATE_CAP)))
    pad4 = ((0, 0), (0, 0), (pad_front, pad_back), (0, 0))
    pad3 = ((0, 0), (0, 0), (pad_front, pad_back))
    q, k, v = jnp.pad(q, pad4), jnp.pad(k, pad4), jnp.pad(v, pad4)
    log_i = jnp.pad(log_i, pad3, constant_values=-jnp.inf)
    log_f = jnp.pad(log_f, pad3)
    h = mlstm_chunkwise(q, k, v, log_i, log_f)
    return h[:, :, pad_front:pad_front + seq_len]


def short_conv_group(u, gate_b, gate_c, conv_w):
    a = gate_c * u
    seq_len = a.shape[1]
    ap = jnp.pad(a, ((0, 0), (CONV_K - 1, 0), (0, 0)))
    conv = sum(ap[:, j:j + seq_len] * conv_w[j] for j in range(CONV_K))
    return gate_b * conv


def setup_inputs(seed: int = 0) -> dict:
    key = jax.random.key(seed)
    ks = jax.random.split(key, 14)
    nrm = lambda k, shape, s: jax.random.normal(k, shape, jnp.float32) * s
    gain = lambda k, shape: 1.0 + 0.02 * jax.random.normal(k, shape, jnp.float32)
    b_i = nrm(ks[4], (DEPTH, MLSTM_HEADS), 0.1)
    b_f = 3.0 + nrm(ks[5], (DEPTH, MLSTM_HEADS), 0.5)
    return {
        "x": nrm(ks[0], (BATCH, SEQ, D_MODEL), 1.0),
        "meta_tokens": nrm(ks[1], (N_META, D_MODEL), 1.0),
        "norm_mix_w": gain(ks[2], (DEPTH, D_MODEL)),
        "w_in": nrm(ks[3], (DEPTH, D_MODEL, D_IN), D_MODEL ** -0.5),
        "b_gates": jnp.concatenate([b_i, b_f], axis=-1),
        "conv_w": nrm(ks[6], (DEPTH, CONV_K, CONV_W), CONV_K ** -0.5),
        "mlstm_norm_w": gain(ks[7], (DEPTH, MLSTM_W)),
        "w_out": nrm(ks[8], (DEPTH, D_MODEL, D_MODEL), D_MODEL ** -0.5),
        "norm_ffn_w": gain(ks[9], (DEPTH, D_MODEL)),
        "w_gate": nrm(ks[10], (DEPTH, D_MODEL, D_FF), D_MODEL ** -0.5),
        "w_up": nrm(ks[11], (DEPTH, D_MODEL, D_FF), D_MODEL ** -0.5),
        "w_down": nrm(ks[12], (DEPTH, D_FF, D_MODEL), D_FF ** -0.5),
        "norm_final_w": gain(ks[13], (D_MODEL,)),
    }


def reference(x, meta_tokens, norm_mix_w, w_in, b_gates, conv_w, mlstm_norm_w, w_out,
              norm_ffn_w, w_gate, w_up, w_down, norm_final_w):
    bsz = x.shape[0]
    meta = jnp.broadcast_to(meta_tokens.astype(x.dtype)[None], (bsz, N_META, D_MODEL))
    h = jnp.concatenate([meta, x], axis=1)
    seq_len = h.shape[1]
    split_points = np.cumsum(SPLIT_SIZES)[:-1].tolist()
    for l in range(DEPTH):
        hn = rmsnorm(h, norm_mix_w[l])
        proj = hn @ w_in[l]
        q, k, v, og, ig, fg, u, gb, gc = jnp.split(proj, split_points, axis=-1)
        ig = ig + b_gates[l, :MLSTM_HEADS]
        fg = fg + b_gates[l, MLSTM_HEADS:]
        hm = mlstm_group(q.reshape(bsz, seq_len, MLSTM_HEADS, DQK),
                         k.reshape(bsz, seq_len, MLSTM_HEADS, DQK),
                         v.reshape(bsz, seq_len, MLSTM_HEADS, DV), ig, fg)
        hm = rmsnorm(hm, mlstm_norm_w[l].reshape(MLSTM_HEADS, 1, DV))
        hm = jnp.moveaxis(hm, 1, 2).reshape(bsz, seq_len, MLSTM_W).astype(h.dtype)
        hm = jax.nn.sigmoid(og) * hm
        hc = short_conv_group(u, gb, gc, conv_w[l])
        h = h + jnp.concatenate([hm, hc], axis=-1) @ w_out[l]
        hf = rmsnorm(h, norm_ffn_w[l])
        h = h + (jax.nn.silu(hf @ w_gate[l]) * (hf @ w_up[l])) @ w_down[l]
    out = rmsnorm(h, norm_final_w)
    return out[:, N_META:]
```

```cpp
#include <hip/hip_runtime.h>
#include <hip/hip_cooperative_groups.h>
#include <cstdio>
#include <cstdint>
namespace cg = cooperative_groups;
namespace pg8 {
#define PG8_LAS __attribute__((address_space(3)))
typedef unsigned short bf16_t;
typedef short bf16x8 __attribute__((ext_vector_type(8)));
typedef float f32x4 __attribute__((ext_vector_type(4)));
typedef unsigned u32x4 __attribute__((ext_vector_type(4)));
constexpr int BM = 256, BK = 64, HALF = 128, HTB = HALF * BK * 2  , STAGE_BYTES = 8 * HTB, NXCD = 8, WGM = 8;

__host__ __device__ __forceinline__ int lds_byte(int r, int c) { const int st = (r >> 4) * 2 + (c >> 5), rr = r & 15, cc = c & 31, ob = rr * 64 + cc * 2; return st * 1024 + (ob ^ (((ob >> 9) & 1) << 5)); }
__host__ __device__ __forceinline__ void stage_rc(int b, int& R, int& C) { const int st = b / 1024, sb = b % 1024, swz = sb ^ (((sb >> 9) & 1) << 5); R = (st >> 1) * 16 + swz / 64; C = (st & 1) * 32 + (swz % 64) / 2; }
__host__ __device__ __forceinline__ int perm32(int rho) { const int n = rho >> 4, i = rho & 15; return 8 * (i >> 2) + 4 * n + (i & 3); }

struct Unit { int pm, pn; };
struct Gemm { const bf16_t* A; const bf16_t* Bt; int M, N, K; };

struct StaticOrder {
    int nM, nN, nwg, G, c;
    __host__ __device__ void init(int M, int N, int G_, int c_) { nM = M / BM; nN = N / BM; nwg = nM * nN; G = G_; c = c_; }
    __host__ __device__ bool next(int i, Unit& u) const {
        const long L = (long)i * G + c; if (L >= nwg) return false;
        int wgid = (int)L; { const int q = nwg / NXCD, r = nwg % NXCD, xcd = wgid % NXCD, off = wgid / NXCD; wgid = (xcd < r ? xcd * (q + 1) : r * (q + 1) + (xcd - r) * q) + off; }
        const int nig = WGM * nN, gid = wgid / nig, fm = gid * WGM, gsz = (nM - fm) < WGM ? (nM - fm) : WGM;
        u.pm = fm + ((wgid % nig) % gsz); u.pn = (wgid % nig) / gsz; return true;
    }
    __device__ __forceinline__ void a_ready(const Unit&) const {}
    __device__ __forceinline__ void done(const Unit&) const {}
};
__device__ __forceinline__ unsigned cvt_pk_bf16(float lo, float hi) { unsigned r; asm volatile("v_cvt_pk_bf16_f32 %0, %1, %2" : "=v"(r) : "v"(lo), "v"(hi)); return r; }
typedef float f32x2 __attribute__((ext_vector_type(2)));
template <class Epi, class Sched, bool ALIGN_EPI = false, bool SP2 = false>
__device__ __forceinline__ void gemm_phase(PG8_LAS unsigned char* lds, const Gemm g, const Sched& S, const Epi& E, const int wave_in) {
    int tid_; asm volatile("v_mbcnt_lo_u32_b32 %0, -1, 0\n\tv_mbcnt_hi_u32_b32 %0, -1, %0" : "=v"(tid_)); tid_ += wave_in * 64;
    const int tid = tid_, wid = __builtin_amdgcn_readfirstlane(tid >> 6), lane = tid & 63, wr = wid >> 2, wc = wid & 3, fr = lane & 15, fq = lane >> 4;
    const int K = g.K, nt = K / BK;
    unsigned voffA[2], voffB[2];
#pragma unroll
    for (int i = 0; i < 2; ++i) { int R, C; stage_rc(tid * 16 + i * 8192, R, C); const int Rb = Epi::PERM ? ((R & ~31) + perm32(R & 31)) : R;
        voffA[i] = (unsigned)(R * K + C) * 2u; voffB[i] = (unsigned)(Rb * K + C) * 2u; }
    const size_t kstep = (size_t)(BK * 2);
    const size_t hstep = (size_t)HALF * K * 2;
    const size_t tstep = 2 * hstep;
    const unsigned ldsw = (unsigned)wid * 1024u;
    const int aoff = lds_byte(wr * 64 + fr, fq * 8), boff = lds_byte(wc * 32 + fr, fq * 8);
#define PG8_SA(b, h) (((b) * 2 + (h)) * HTB)
#define PG8_SB(b, h) ((4 + (b) * 2 + (h)) * HTB)
#define PG8_STAGE(bufoff, gbase, voff) do { _Pragma("unroll") for (int _i = 0; _i < 2; ++_i) \
        __builtin_amdgcn_global_load_lds((const unsigned*)((const char*)(gbase) + (voff)[_i]), (PG8_LAS unsigned*)(lds + (bufoff) + ldsw + _i * 8192), 16, 0, 0); } while (0)
#define PG8_LDA(dst, b, h) do { _Pragma("unroll") for (int m = 0; m < 4; ++m) _Pragma("unroll") for (int k = 0; k < 2; ++k) dst[m][k] = *(const PG8_LAS bf16x8*)(lds + PG8_SA(b, h) + aoff + m * 2048 + k * 1024); } while (0)
#define PG8_LDB(dst, b, h) do { _Pragma("unroll") for (int n = 0; n < 2; ++n) _Pragma("unroll") for (int k = 0; k < 2; ++k) dst[n][k] = *(const PG8_LAS bf16x8*)(lds + PG8_SB(b, h) + boff + n * 2048 + k * 1024); } while (0)
#define PG8_MMA(ai, bj, At, Bt) do { __builtin_amdgcn_s_setprio(1); _Pragma("unroll") for (int m = 0; m < 4; ++m) _Pragma("unroll") for (int n = 0; n < 2; ++n) _Pragma("unroll") for (int k = 0; k < 2; ++k) \
        acc[ai][bj][m][n] = __builtin_amdgcn_mfma_f32_16x16x32_bf16(Bt[n][k], At[m][k], acc[ai][bj][m][n], 0, 0, 0); __builtin_amdgcn_s_setprio(0); } while (0)
#define PG8_WAIT_V(n) asm volatile("s_waitcnt vmcnt(" #n ")" ::: "memory")
#define PG8_WAIT_L(n) asm volatile("s_waitcnt lgkmcnt(" #n ")" ::: "memory")
#define PG8_BAR __builtin_amdgcn_s_barrier()
#define PG8_SCHED __builtin_amdgcn_sched_barrier(0)
    Unit cur, nxt; int ui = 0;
    if (!S.next(0, cur)) return;
    f32x4 acc[2][2][4][2];
#pragma unroll
    for (int a = 0; a < 2; ++a)
#pragma unroll
        for (int b = 0; b < 2; ++b)
#pragma unroll
            for (int m = 0; m < 4; ++m)
#pragma unroll
                for (int n = 0; n < 2; ++n) acc[a][b][m][n] = (f32x4){0.f, 0.f, 0.f, 0.f};
    bf16x8 At[4][2], B0[2][2], B1[2][2];
    const char* cA = (const char*)g.A + (size_t)cur.pm * tstep; const char* cB = (const char*)g.Bt + (size_t)cur.pn * tstep;
    S.a_ready(cur);
    if constexpr (SP2) {
        PG8_STAGE(PG8_SB(0, 0), cB, voffB); PG8_STAGE(PG8_SB(0, 1), cB + hstep, voffB); PG8_STAGE(PG8_SA(0, 0), cA, voffA); PG8_STAGE(PG8_SA(0, 1), cA + hstep, voffA);
        if (wr == 1) PG8_BAR;
        PG8_WAIT_V(2); PG8_BAR;
        PG8_STAGE(PG8_SB(1, 0), cB + kstep, voffB); PG8_STAGE(PG8_SA(1, 0), cA + kstep, voffA); PG8_STAGE(PG8_SB(1, 1), cB + hstep + kstep, voffB);
        PG8_WAIT_V(6); PG8_BAR;
    } else {
        PG8_STAGE(PG8_SB(0, 0), cB, voffB); PG8_STAGE(PG8_SA(0, 0), cA, voffA); PG8_STAGE(PG8_SB(0, 1), cB + hstep, voffB); PG8_STAGE(PG8_SA(0, 1), cA + hstep, voffA);
        if (wr == 1) PG8_BAR;
        PG8_WAIT_V(4); PG8_BAR;
        PG8_STAGE(PG8_SB(1, 0), cB + kstep, voffB); PG8_STAGE(PG8_SA(1, 0), cA + kstep, voffA); PG8_STAGE(PG8_SB(1, 1), cB + hstep + kstep, voffB);
        PG8_WAIT_V(6); PG8_BAR;
    }
    for (;;) {
        const bool has_next = S.next(ui + 1, nxt);
        const char* nA = has_next ? (const char*)g.A + (size_t)nxt.pm * tstep : cA; const char* nB = has_next ? (const char*)g.Bt + (size_t)nxt.pn * tstep : cB;
        for (int t = 0; t < nt; t += 2) {
            const bool last = (t == nt - 2);
            const char* a1 = cA + (size_t)(t + 1) * kstep;
            const char* a2 = last ? nA : cA + (size_t)(t + 2) * kstep; const char* b2 = last ? nB : cB + (size_t)(t + 2) * kstep;
            const char* a3 = a2 + kstep; const char* b3 = b2 + kstep;
            if (last && has_next) S.a_ready(nxt);
            if constexpr (SP2) {
            PG8_LDB(B0, 0, 0); PG8_LDB(B1, 0, 1); PG8_SCHED; PG8_LDA(At, 0, 0); PG8_STAGE(PG8_SA(1, 1), a1 + hstep, voffA);
            PG8_WAIT_V(8); PG8_WAIT_L(0); PG8_BAR; PG8_MMA(0, 0, At, B0); PG8_MMA(0, 1, At, B1); PG8_BAR; PG8_SCHED;
            PG8_LDA(At, 0, 1); PG8_STAGE(PG8_SB(0, 0), b2, voffB); PG8_STAGE(PG8_SB(0, 1), b2 + hstep, voffB); PG8_STAGE(PG8_SA(0, 0), a2, voffA);
            PG8_WAIT_V(8); PG8_WAIT_L(0); PG8_BAR; PG8_MMA(1, 0, At, B0); PG8_MMA(1, 1, At, B1); PG8_BAR; PG8_SCHED;
            PG8_LDB(B0, 1, 0); PG8_LDB(B1, 1, 1); PG8_SCHED; PG8_LDA(At, 1, 0); PG8_STAGE(PG8_SA(0, 1), a2 + hstep, voffA);
            PG8_WAIT_V(8); PG8_WAIT_L(0); PG8_BAR; PG8_MMA(0, 0, At, B0); PG8_MMA(0, 1, At, B1); PG8_BAR; PG8_SCHED;
            PG8_LDA(At, 1, 1); PG8_STAGE(PG8_SB(1, 0), b3, voffB); PG8_STAGE(PG8_SB(1, 1), b3 + hstep, voffB); PG8_STAGE(PG8_SA(1, 0), a3, voffA);
            PG8_WAIT_V(8); PG8_WAIT_L(0); PG8_BAR; PG8_MMA(1, 0, At, B0); PG8_MMA(1, 1, At, B1); PG8_BAR; PG8_SCHED;
            } else {
            PG8_LDB(B0, 0, 0); PG8_SCHED; PG8_LDA(At, 0, 0); PG8_STAGE(PG8_SA(1, 1), a1 + hstep, voffA);
            PG8_WAIT_L(8); PG8_BAR; PG8_WAIT_L(0); PG8_MMA(0, 0, At, B0); PG8_BAR; PG8_SCHED;
            PG8_LDB(B1, 0, 1); PG8_STAGE(PG8_SB(0, 0), b2, voffB);
            PG8_BAR; PG8_WAIT_L(0); PG8_MMA(0, 1, At, B1); PG8_BAR;
            PG8_LDA(At, 0, 1); PG8_STAGE(PG8_SA(0, 0), a2, voffA);
            PG8_BAR; PG8_WAIT_L(0); PG8_MMA(1, 0, At, B0); PG8_BAR; PG8_SCHED;
            PG8_STAGE(PG8_SB(0, 1), b2 + hstep, voffB);
            PG8_WAIT_V(6); PG8_BAR; PG8_MMA(1, 1, At, B1); PG8_BAR;
            PG8_LDB(B0, 1, 0); PG8_SCHED; PG8_LDA(At, 1, 0); PG8_STAGE(PG8_SA(0, 1), a2 + hstep, voffA);
            PG8_WAIT_L(8); PG8_BAR; PG8_WAIT_L(0); PG8_MMA(0, 0, At, B0); PG8_BAR; PG8_SCHED;
            PG8_LDB(B1, 1, 1); PG8_STAGE(PG8_SB(1, 0), b3, voffB);
            PG8_BAR; PG8_WAIT_L(0); PG8_MMA(0, 1, At, B1); PG8_BAR;
            PG8_LDA(At, 1, 1); PG8_STAGE(PG8_SA(1, 0), a3, voffA);
            PG8_BAR; PG8_WAIT_L(0); PG8_MMA(1, 0, At, B0); PG8_BAR; PG8_SCHED;
            PG8_STAGE(PG8_SB(1, 1), b3 + hstep, voffB);
            PG8_WAIT_V(6); PG8_BAR; PG8_MMA(1, 1, At, B1); PG8_BAR;
            }
        }
        if constexpr (ALIGN_EPI) { if (wr == 0) PG8_BAR; }
        if constexpr (!Epi::AFTER_DRAIN) { E(acc, cur, wr, wc, fr, fq); S.done(cur); }
        if (!has_next) break;
#pragma unroll
        for (int a = 0; a < 2; ++a)
#pragma unroll
            for (int b = 0; b < 2; ++b)
#pragma unroll
                for (int m = 0; m < 4; ++m)
#pragma unroll
                    for (int n = 0; n < 2; ++n) acc[a][b][m][n] = (f32x4){0.f, 0.f, 0.f, 0.f};
        cur = nxt; cA = nA; cB = nB; ++ui;
        if constexpr (ALIGN_EPI) { if (wr == 1) PG8_BAR; }
    }
    PG8_WAIT_V(0);
    if constexpr (!ALIGN_EPI) { if (wr == 0) PG8_BAR; }
    PG8_BAR;
    if constexpr (Epi::AFTER_DRAIN) { E.fused(acc, cur, wr, wc, fr, fq, lds, wid, lane); S.done(cur); }
#undef PG8_SA
#undef PG8_SB
#undef PG8_STAGE
#undef PG8_LDA
#undef PG8_LDB
#undef PG8_MMA
#undef PG8_WAIT_V
#undef PG8_WAIT_L
#undef PG8_BAR
#undef PG8_SCHED
}
}

#define LAS __attribute__((address_space(3)))
typedef unsigned short bf16_t;
typedef short bf16x8 __attribute__((ext_vector_type(8)));
typedef short s16x4 __attribute__((ext_vector_type(4)));
typedef float f32x4 __attribute__((ext_vector_type(4)));
typedef unsigned u32x4 __attribute__((ext_vector_type(4)));
typedef unsigned u32x2 __attribute__((ext_vector_type(2)));

constexpr int D = 2048, NB = 8, SEQ = 2048, NMETA = 16, NHEAD = 4, DV = 256, DQK = 128;
constexpr int MREAL = NB * SEQ;
constexpr int MMETA = NB * NMETA;
constexpr int MTOT = MREAL + MMETA;
constexpr int MPAD = 16640;
constexpr int DIN = 6152, NPROJ = 6144, DFF = 5632, NGU = 2 * DFF;
constexpr int C_Q = 0, C_K = 512, C_V = 1024, C_OG = 2048, C_U = 3072, C_GB = 4096, C_GC = 5120;
constexpr float EPS = 1e-6f, GATE_CAP = 15.0f;
constexpr int NCHUNK = 33;

constexpr size_t MiB = 1u << 20;
constexpr size_t SZ_WT_IN = (size_t)NPROJ * D * 2, SZ_WT_OUT = (size_t)D * D * 2, SZ_WT_GU = (size_t)NGU * D * 2, SZ_WT_DN = (size_t)D * DFF * 2;
constexpr size_t WS_WT_IN = 0, WS_WT_OUT = 48 * MiB, WS_WT_GU = 64 * MiB, WS_WT_DN = 152 * MiB;
constexpr size_t WS_XA = 196 * MiB;
constexpr size_t WS_PROJ = 261 * MiB;
constexpr size_t WS_NUM = 456 * MiB;
constexpr size_t WS_HMETA = 489 * MiB;
constexpr size_t WS_LI = 491 * MiB, WS_LF = WS_LI + MiB / 2, WS_DEN = 492 * MiB, WS_MT = WS_DEN + MiB / 2;
constexpr size_t WS_END = 493 * MiB;
static_assert(2 * SZ_WT_IN <= WS_WT_OUT - WS_WT_IN && 2 * SZ_WT_OUT <= WS_WT_GU - WS_WT_OUT && 2 * SZ_WT_GU <= WS_WT_DN - WS_WT_GU && 2 * SZ_WT_DN <= WS_XA - WS_WT_DN, "ws map");
static_assert((size_t)MPAD * D * 2 <= WS_PROJ - WS_XA && (size_t)MPAD * NPROJ * 2 <= WS_NUM - WS_PROJ && (size_t)MPAD * 1024 * 2 <= WS_HMETA - WS_NUM, "ws map");

constexpr int LDS_BYTES = 147456;
constexpr int NWAVES = 8, NTHREADS = 512;

__device__ __forceinline__ unsigned cvt_pk(float lo, float hi) { unsigned r; asm volatile("v_cvt_pk_bf16_f32 %0, %1, %2" : "=v"(r) : "v"(lo), "v"(hi)); return r; }
__device__ __forceinline__ float bf2f(unsigned short b) { return __uint_as_float(((unsigned)b) << 16); }
__device__ __forceinline__ float bflo(unsigned w) { return __uint_as_float(w << 16); }
__device__ __forceinline__ float bfhi(unsigned w) { return __uint_as_float(w & 0xffff0000u); }
__device__ __forceinline__ float wave_sum(float v) {
#pragma unroll
    for (int o = 1; o < 64; o <<= 1) v += __shfl_xor(v, o);
    return v;
}
__device__ __forceinline__ float wave_max(float v) {
#pragma unroll
    for (int o = 1; o < 64; o <<= 1) v = fmaxf(v, __shfl_xor(v, o));
    return v;
}

struct Args {
    const float *x, *meta, *nmw, *win, *bg, *cw, *mnw, *wout, *nfw, *wg, *wu, *wd, *nfin;
    float* out; unsigned char* ws; int ph_lo, ph_hi;
};
static_assert(sizeof(Args) == 15 * 8 + 8, "Args has no padding");

__device__ __forceinline__ float* hrow(const Args& a, int m) { return m < MREAL ? a.out + (size_t)m * D : (float*)(a.ws + WS_HMETA) + (size_t)(m - MREAL) * D; }

struct EpiProj {
    static constexpr bool PERM = true, AFTER_DRAIN = false;
    bf16_t* O;
    __device__ __forceinline__ void operator()(const f32x4 (&acc)[2][2][4][2], const pg8::Unit& u, int wr, int wc, int fr, int fq) const {
        const int row0 = u.pm * 256 + wr * 64 + fr, colt = u.pn * 256;
        const float sc = (colt < C_K) ? 0.08838834764831845f : 1.0f;
        const int col0 = colt + wc * 32 + 8 * fq;
#pragma unroll
        for (int ai = 0; ai < 2; ++ai)
#pragma unroll
            for (int m = 0; m < 4; ++m) { bf16_t* rowp = O + (size_t)(row0 + ai * 128 + m * 16) * NPROJ + col0;
#pragma unroll
                for (int bj = 0; bj < 2; ++bj) { const f32x4 v0 = acc[ai][bj][m][0] * sc, v1 = acc[ai][bj][m][1] * sc;
                    u32x4 w; w.x = cvt_pk(v0[0], v0[1]); w.y = cvt_pk(v0[2], v0[3]); w.z = cvt_pk(v1[0], v1[1]); w.w = cvt_pk(v1[2], v1[3]);
                    *(u32x4*)(rowp + bj * 128) = w; } }
    }
};
struct EpiResid {
    static constexpr bool PERM = false, AFTER_DRAIN = false;
    float* out; float* hmeta;
    __device__ __forceinline__ void operator()(const f32x4 (&acc)[2][2][4][2], const pg8::Unit& u, int wr, int wc, int fr, int fq) const {
        float* hb = (u.pm < MREAL / 256) ? out + (size_t)u.pm * 256 * D : hmeta;
        const int r0 = wr * 64 + fr, col0 = u.pn * 256 + wc * 32 + 4 * fq;
#pragma unroll
        for (int ai = 0; ai < 2; ++ai)
#pragma unroll
            for (int m = 0; m < 4; ++m) { float* rowp = hb + (size_t)(r0 + ai * 128 + m * 16) * D + col0;
                f32x4 old[2][2];
#pragma unroll
                for (int bj = 0; bj < 2; ++bj)
#pragma unroll
                    for (int n = 0; n < 2; ++n) old[bj][n] = *(const f32x4*)(rowp + bj * 128 + n * 16);
#pragma unroll
                for (int bj = 0; bj < 2; ++bj)
#pragma unroll
                    for (int n = 0; n < 2; ++n) *(f32x4*)(rowp + bj * 128 + n * 16) = old[bj][n] + acc[ai][bj][m][n];
            }
    }
};
struct EpiSwiglu {
    static constexpr bool PERM = true, AFTER_DRAIN = false;
    bf16_t* O;
    __device__ __forceinline__ void operator()(const f32x4 (&acc)[2][2][4][2], const pg8::Unit& u, int wr, int wc, int fr, int fq) const {
        const int row0 = u.pm * 256 + wr * 64 + fr, col0 = u.pn * 128 + wc * 32 + 8 * fq;
#pragma unroll
        for (int ai = 0; ai < 2; ++ai)
#pragma unroll
            for (int m = 0; m < 4; ++m) { bf16_t* rowp = O + (size_t)(row0 + ai * 128 + m * 16) * DFF + col0;
                float r[8];
#pragma unroll
                for (int n = 0; n < 2; ++n)
#pragma unroll
                    for (int j = 0; j < 4; ++j) { const float g = acc[ai][0][m][n][j], up = acc[ai][1][m][n][j]; r[n * 4 + j] = g * up * __builtin_amdgcn_rcpf(1.0f + __expf(-g)); }
                u32x4 w; w.x = cvt_pk(r[0], r[1]); w.y = cvt_pk(r[2], r[3]); w.z = cvt_pk(r[4], r[5]); w.w = cvt_pk(r[6], r[7]);
                *(u32x4*)rowp = w; }
    }
};

__device__ __forceinline__ void tr_item(const float* W, int ldw, int k0, int src_n0, bf16_t* WT, int K, int dst_row0, LAS float* scr, int lane) {
#pragma unroll 8
    for (int i = 0; i < 32; ++i) { const int kk = 2 * i + (lane >> 5); scr[kk * 33 + (lane & 31)] = W[(size_t)(k0 + kk) * ldw + src_n0 + (lane & 31)]; }
    asm volatile("s_waitcnt lgkmcnt(0)" ::: "memory");
    const int c = lane & 7;
#pragma unroll
    for (int j = 0; j < 4; ++j) { const int n = (lane >> 3) + 8 * j; const LAS float* s = scr + (8 * c) * 33 + n;
        u32x4 o; o.x = cvt_pk(s[0 * 33], s[1 * 33]); o.y = cvt_pk(s[2 * 33], s[3 * 33]); o.z = cvt_pk(s[4 * 33], s[5 * 33]); o.w = cvt_pk(s[6 * 33], s[7 * 33]);
        *(u32x4*)(WT + (size_t)(dst_row0 + n) * K + k0 + 8 * c) = o; }
    asm volatile("s_waitcnt lgkmcnt(0)" ::: "memory");
}
__device__ __forceinline__ void weights_phase(const Args& a, LAS unsigned char* lds, int wave, int lane) {
    LAS float* scr = (LAS float*)(lds + wave * 16384);
    const int gw = blockIdx.x * NWAVES + wave, NGW = gridDim.x * NWAVES;
    constexpr int I_IN = 32 * 192, I_OUT = 32 * 64, I_G = 32 * 176, I_DN = 88 * 64, I_LAYER = I_IN + I_OUT + 2 * I_G + I_DN;
    for (int it = gw; it < 2 * I_LAYER; it += NGW) {
        const int l = it / I_LAYER; int r = it - l * I_LAYER;
        if (r < I_IN) { const int kb = r / 192, nb = r % 192, d0 = nb * 32; tr_item(a.win + (size_t)l * D * DIN, DIN, kb * 64, d0 + (d0 >= 3072 ? 8 : 0), (bf16_t*)(a.ws + WS_WT_IN + l * SZ_WT_IN), D, d0, scr, lane); continue; } r -= I_IN;
        if (r < I_OUT) { const int kb = r / 64, nb = r % 64; tr_item(a.wout + (size_t)l * D * D, D, kb * 64, nb * 32, (bf16_t*)(a.ws + WS_WT_OUT + l * SZ_WT_OUT), D, nb * 32, scr, lane); continue; } r -= I_OUT;
        if (r < I_G) { const int kb = r / 176, nb = r % 176, n0 = nb * 32; tr_item(a.wg + (size_t)l * D * DFF, DFF, kb * 64, n0, (bf16_t*)(a.ws + WS_WT_GU + l * SZ_WT_GU), D, (n0 >> 7) * 256 + (n0 & 127), scr, lane); continue; } r -= I_G;
        if (r < I_G) { const int kb = r / 176, nb = r % 176, n0 = nb * 32; tr_item(a.wu + (size_t)l * D * DFF, DFF, kb * 64, n0, (bf16_t*)(a.ws + WS_WT_GU + l * SZ_WT_GU), D, (n0 >> 7) * 256 + 128 + (n0 & 127), scr, lane); continue; } r -= I_G;
        { const int kb = r / 64, nb = r % 64; tr_item(a.wd + (size_t)l * DFF * D, D, kb * 64, nb * 32, (bf16_t*)(a.ws + WS_WT_DN + l * SZ_WT_DN), DFF, nb * 32, scr, lane); }
    }
}

template <int MODE>
__device__ __forceinline__ void norm_phase(const Args& a, int layer, LAS unsigned char* lds, int wave, int lane) {
    const float* nw = MODE <= 1 ? a.nmw + layer * D : (MODE == 2 ? a.nfw + layer * D : a.nfin);
    LAS float* WG = (LAS float*)lds;
    if (MODE <= 1) {
        const float* wsrc = a.win + (size_t)layer * D * DIN + 3072;
        for (int k = wave * 64 + lane; k < D; k += NTHREADS) { const f32x4 g0 = *(const f32x4*)(wsrc + (size_t)k * DIN), g1 = *(const f32x4*)(wsrc + (size_t)k * DIN + 4);
            WG[0 * D + k] = g0[0]; WG[1 * D + k] = g0[1]; WG[2 * D + k] = g0[2]; WG[3 * D + k] = g0[3]; WG[4 * D + k] = g1[0]; WG[5 * D + k] = g1[1]; WG[6 * D + k] = g1[2]; WG[7 * D + k] = g1[3]; }
        __syncthreads();
    }
    bf16_t* XA = (bf16_t*)(a.ws + WS_XA); float* LI = (float*)(a.ws + WS_LI); float* LF = (float*)(a.ws + WS_LF);
    const int gw = blockIdx.x * NWAVES + wave, NGW = gridDim.x * NWAVES;
    f32x4 w[8];
#pragma unroll
    for (int j = 0; j < 8; ++j) w[j] = *((const f32x4*)nw + lane + 64 * j);
    for (int m = gw; m < (MODE == 3 ? MREAL : MTOT); m += NGW) {
        const float* src = MODE == 0 ? (m < MREAL ? a.x + (size_t)m * D : a.meta + (size_t)((m - MREAL) & 15) * D) : hrow(a, m);
        f32x4 v[8]; float ss = 0.f;
#pragma unroll
        for (int j = 0; j < 8; ++j) { v[j] = *((const f32x4*)src + lane + 64 * j); ss += (v[j][0] * v[j][0] + v[j][1] * v[j][1]) + (v[j][2] * v[j][2] + v[j][3] * v[j][3]); }
        if (MODE == 0) { float* hp = hrow(a, m);
#pragma unroll
            for (int j = 0; j < 8; ++j) *((f32x4*)hp + lane + 64 * j) = v[j]; }
        const float rstd = rsqrtf(wave_sum(ss) * (1.0f / D) + EPS);
#pragma unroll
        for (int j = 0; j < 8; ++j) v[j] = v[j] * rstd * w[j];
        if (MODE == 3) { float* op = a.out + (size_t)m * D;
#pragma unroll
            for (int j = 0; j < 8; ++j) *((f32x4*)op + lane + 64 * j) = v[j];
        } else { bf16_t* op = XA + (size_t)m * D;
#pragma unroll
            for (int j = 0; j < 8; ++j) { u32x2 o; o.x = cvt_pk(v[j][0], v[j][1]); o.y = cvt_pk(v[j][2], v[j][3]); *((u32x2*)op + lane + 64 * j) = o; } }
        if (MODE <= 1) {
            float mine = 0.f;
#pragma unroll
            for (int g = 0; g < 8; ++g) { float s = 0.f;
#pragma unroll
                for (int j = 0; j < 8; ++j) { const f32x4 wg = *((const LAS f32x4*)(WG + g * D) + lane + 64 * j); s += (v[j][0] * wg[0] + v[j][1] * wg[1]) + (v[j][2] * wg[2] + v[j][3] * wg[3]); }
                s = wave_sum(s); mine = (lane == g) ? s : mine; }
            if (lane < 8) { const float raw = mine + a.bg[layer * 8 + lane]; const float e2 = __expf(raw * (2.0f / GATE_CAP)); const float cp = GATE_CAP * (e2 - 1.0f) / (e2 + 1.0f);
                if (lane < 4) LI[m * 4 + lane] = cp; else LF[m * 4 + lane - 4] = fminf(cp, 0.f) - __logf(1.0f + __expf(-fabsf(cp))); }
        }
    }
}

__device__ __forceinline__ bf16x8 pack8(const f32x4& x, const f32x4& y) {
    u32x4 w; w.x = cvt_pk(x[0], x[1]); w.y = cvt_pk(x[2], x[3]); w.z = cvt_pk(y[0], y[1]); w.w = cvt_pk(y[2], y[3]); return __builtin_bit_cast(bf16x8, w);
}
typedef short v4i16_t __attribute__((ext_vector_type(4)));
__device__ __forceinline__ s16x4 lds_tr(LAS unsigned char* p) { return __builtin_bit_cast(s16x4, __builtin_amdgcn_ds_read_tr16_b64_v4i16((LAS v4i16_t*)p)); }
#define MFMA16(x, y, c) __builtin_amdgcn_mfma_f32_16x16x32_bf16((x), (y), (c), 0, 0, 0)
constexpr int KIMG_STRIDE = 288, KIMG_BYTES = 64 * KIMG_STRIDE, MWAVE_BYTES = KIMG_BYTES + 1024;
constexpr int MLSTM_WAVES = 4;

__device__ __forceinline__ void mlstm_item(const Args& a, int bh, int sl, LAS unsigned char* kimg, int lane) {
    const bf16_t* proj = (const bf16_t*)(a.ws + WS_PROJ);
    const float* LI = (const float*)(a.ws + WS_LI); const float* LF = (const float*)(a.ws + WS_LF);
    bf16_t* NUM = (bf16_t*)(a.ws + WS_NUM); float* DEN = (float*)(a.ws + WS_DEN); float* MT = (float*)(a.ws + WS_MT);
    LAS float* sc = (LAS float*)(kimg + KIMG_BYTES);
    const int b = bh >> 2, hd = bh & 3, fr = lane & 15, fq = lane >> 4;
    const bool den_item = (sl == 16);
    const int vcol = C_V + hd * 256 + (den_item ? 0 : sl * 16) + fr;
    f32x4 C[8];
#pragma unroll
    for (int i = 0; i < 8; ++i) C[i] = (f32x4){0.f, 0.f, 0.f, 0.f};
    float m_st = 0.f;
#pragma unroll 1
    for (int c = 0; c < NCHUNK; ++c) {
#define ROWOF(p) (c == 0 ? (MREAL + b * 16 + ((p) < 48 ? 0 : (p) - 48)) : (b * SEQ + (c - 1) * 64 + (p)))
        float w_old, m_new;
        {
            const int rl = ROWOF(lane);
            float lf = LF[rl * 4 + hd], li = LI[rl * 4 + hd];
            if (c == 0 && lane < 48) { lf = 0.f; li = -1e30f; }
            float bc = lf;
#pragma unroll
            for (int o = 1; o < 64; o <<= 1) { const float t = __shfl_up(bc, o); bc += (lane >= o) ? t : 0.f; }
            const float b_end = __shfl(bc, 63);
            const float decay = b_end - bc + li;
            m_new = fmaxf(b_end + m_st, wave_max(decay));
            w_old = __expf(b_end + m_st - m_new);
            sc[lane] = li - bc; sc[64 + lane] = __expf(decay - m_new); sc[128 + lane] = bc;
        }
#pragma unroll
        for (int xb = 0; xb < 4; ++xb) { const bf16_t* rp = proj + (size_t)ROWOF(xb * 16 + fr) * NPROJ + C_K + hd * 128 + fq * 4; LAS unsigned char* wp = kimg + (xb * 16 + fr) * KIMG_STRIDE + fq * 8;
#pragma unroll
            for (int kc = 0; kc < 4; ++kc) { const s16x4 lo = *(const s16x4*)(rp + 32 * kc), hi = *(const s16x4*)(rp + 32 * kc + 16); *(LAS s16x4*)(wp + 64 * kc) = lo; *(LAS s16x4*)(wp + 64 * kc + 32) = hi; } }
        asm volatile("s_waitcnt lgkmcnt(0)" ::: "memory");
        bf16x8 vf[2], wvf[2];
#pragma unroll
        for (int ks = 0; ks < 2; ++ks) { float vv[8];
#pragma unroll
            for (int h = 0; h < 2; ++h) { const f32x4 wi = *(const LAS f32x4*)(sc + 64 + 32 * ks + 16 * h + 4 * fq);
#pragma unroll
                for (int q = 0; q < 4; ++q) { const int s = 32 * ks + 16 * h + 4 * fq + q;
                    const unsigned short raw = den_item ? (unsigned short)(fr == 0 ? 0x3F80 : 0) : proj[(size_t)ROWOF(s) * NPROJ + vcol];
                    vf[ks][4 * h + q] = (short)raw; vv[4 * h + q] = bf2f(raw) * wi[q]; } }
            wvf[ks] = pack8((f32x4){vv[0], vv[1], vv[2], vv[3]}, (f32x4){vv[4], vv[5], vv[6], vv[7]}); }
        bf16x8 cf[4];
#pragma unroll
        for (int kc = 0; kc < 4; ++kc) cf[kc] = pack8(C[2 * kc], C[2 * kc + 1]);
#pragma unroll
        for (int tb = 0; tb < 4; ++tb) {
            const int t = tb * 16 + fr;
            bf16x8 qf[4];
            { const bf16_t* rp = proj + (size_t)ROWOF(t) * NPROJ + C_Q + hd * 128 + fq * 4;
#pragma unroll
              for (int kc = 0; kc < 4; ++kc) { const s16x4 lo = *(const s16x4*)(rp + 32 * kc), hi = *(const s16x4*)(rp + 32 * kc + 16); qf[kc] = __builtin_shufflevector(lo, hi, 0, 1, 2, 3, 4, 5, 6, 7); } }
            f32x4 S[4];
#pragma unroll
            for (int sb = 0; sb < 4; ++sb) { f32x4 acc = (f32x4){0.f, 0.f, 0.f, 0.f}; const LAS unsigned char* kp = kimg + (sb * 16 + fr) * KIMG_STRIDE + fq * 8;
#pragma unroll
                for (int kc = 0; kc < 4; ++kc) { const s16x4 lo = *(const LAS s16x4*)(kp + 64 * kc), hi = *(const LAS s16x4*)(kp + 64 * kc + 32);
                    acc = MFMA16(__builtin_shufflevector(lo, hi, 0, 1, 2, 3, 4, 5, 6, 7), qf[kc], acc); }
                S[sb] = acc; }
            const float bt = sc[128 + t];
            f32x4 gs[4];
#pragma unroll
            for (int sb = 0; sb < 4; ++sb) gs[sb] = *(const LAS f32x4*)(sc + sb * 16 + 4 * fq);
            float dmax = -1e30f;
#pragma unroll
            for (int sb = 0; sb < 4; ++sb)
#pragma unroll
                for (int jj = 0; jj < 4; ++jj) { const int s = sb * 16 + fq * 4 + jj; const float d = (s <= t) ? bt + gs[sb][jj] : -1e30f; dmax = fmaxf(dmax, d); }
            dmax = fmaxf(dmax, __shfl_xor(dmax, 16)); dmax = fmaxf(dmax, __shfl_xor(dmax, 32));
            const float inter = bt + m_st, mt = fmaxf(inter, dmax);
            sc[192 + t] = __expf(inter - mt);
#pragma unroll
            for (int sb = 0; sb < 4; ++sb)
#pragma unroll
                for (int jj = 0; jj < 4; ++jj) { const int s = sb * 16 + fq * 4 + jj; const float e = (s <= t) ? __expf(bt + gs[sb][jj] - mt) : 0.f; S[sb][jj] *= e; }
            f32x4 nm = (f32x4){0.f, 0.f, 0.f, 0.f};
#pragma unroll
            for (int kc = 0; kc < 4; ++kc) nm = MFMA16(qf[kc], cf[kc], nm);
            nm = nm * *(const LAS f32x4*)(sc + 192 + tb * 16 + 4 * fq);
#pragma unroll
            for (int ks = 0; ks < 2; ++ks) nm = MFMA16(pack8(S[2 * ks], S[2 * ks + 1]), vf[ks], nm);
#pragma unroll
            for (int jj = 0; jj < 4; ++jj) { const int tt = tb * 16 + fq * 4 + jj;
                if (c > 0 || tt >= 48) { const int row = ROWOF(tt);
                    if (!den_item) NUM[(size_t)row * 1024 + hd * 256 + sl * 16 + fr] = (bf16_t)(cvt_pk(nm[jj], 0.f) & 0xffffu);
                    else if (fr == 0) DEN[row * 4 + hd] = nm[jj]; } }
            if (den_item && fq == 0 && (c > 0 || t >= 48)) MT[ROWOF(t) * 4 + hd] = mt;
        }
#pragma unroll
        for (int dt = 0; dt < 8; ++dt) { f32x4 cc = C[dt] * w_old;
#pragma unroll
            for (int ks = 0; ks < 2; ++ks) { LAS unsigned char* tp = kimg + (32 * ks + 4 * fq + (fr >> 2)) * KIMG_STRIDE + (dt * 16 + 4 * (fr & 3)) * 2;
                const s16x4 lo = lds_tr(tp), hi = lds_tr(tp + 16 * KIMG_STRIDE);
                cc = MFMA16(__builtin_shufflevector(lo, hi, 0, 1, 2, 3, 4, 5, 6, 7), wvf[ks], cc); }
            C[dt] = cc; }
        m_st = m_new;
        asm volatile("s_waitcnt lgkmcnt(0)" ::: "memory");
#undef ROWOF
    }
}
__device__ __forceinline__ void mlstm_phase(const Args& a, LAS unsigned char* lds, int wave, int lane) {
    if (wave >= MLSTM_WAVES) return;
    LAS unsigned char* kimg = lds + wave * MWAVE_BYTES;
    for (int it = wave * (int)gridDim.x + (int)blockIdx.x; it < 32 * 17; it += MLSTM_WAVES * (int)gridDim.x) mlstm_item(a, it / 17, it % 17, kimg, lane);
}

__device__ __forceinline__ void cat_phase(const Args& a, int layer, int wave, int lane) {
    const bf16_t* proj = (const bf16_t*)(a.ws + WS_PROJ); const bf16_t* NUM = (const bf16_t*)(a.ws + WS_NUM);
    const float* DEN = (const float*)(a.ws + WS_DEN); const float* MT = (const float*)(a.ws + WS_MT);
    bf16_t* XA = (bf16_t*)(a.ws + WS_XA);
    const float* mnw = a.mnw + layer * 1024; const float* cw = a.cw + layer * 3 * 1024;
    const int gw = blockIdx.x * NWAVES + wave, NGW = gridDim.x * NWAVES;
    for (int m = gw; m < MTOT; m += NGW) {
        int p1, p2;
        if (m < MREAL) { const int t = m & (SEQ - 1), b = m >> 11; p1 = t >= 1 ? m - 1 : MREAL + b * 16 + 15; p2 = t >= 2 ? m - 2 : MREAL + b * 16 + 14 + t; }
        else { const int j = (m - MREAL) & 15; p1 = j >= 1 ? m - 1 : -1; p2 = j >= 2 ? m - 2 : -1; }
        const bf16_t* pr = proj + (size_t)m * NPROJ; const bf16_t* pr1 = proj + (size_t)(p1 < 0 ? m : p1) * NPROJ; const bf16_t* pr2 = proj + (size_t)(p2 < 0 ? m : p2) * NPROJ;
        const float z1 = p1 < 0 ? 0.f : 1.f, z2 = p2 < 0 ? 0.f : 1.f;
#pragma unroll
        for (int j = 0; j < 4; ++j) {
            const int c = lane * 4 + 256 * j;
            const u32x2 nv = *(const u32x2*)(NUM + (size_t)m * 1024 + c);
            const float den = DEN[m * 4 + j], mt = MT[m * 4 + j];
            const float sc = 1.0f / fmaxf(fabsf(den), __expf(-mt));
            float h0 = bflo(nv.x) * sc, h1 = bfhi(nv.x) * sc, h2 = bflo(nv.y) * sc, h3 = bfhi(nv.y) * sc;
            const float r = rsqrtf(wave_sum((h0 * h0 + h1 * h1) + (h2 * h2 + h3 * h3)) * (1.0f / DV) + EPS);
            const f32x4 w4 = *(const f32x4*)(mnw + c);
            const u32x2 ogv = *(const u32x2*)(pr + C_OG + c);
            const float s0 = 1.0f / (1.0f + __expf(-bflo(ogv.x))), s1 = 1.0f / (1.0f + __expf(-bfhi(ogv.x))), s2 = 1.0f / (1.0f + __expf(-bflo(ogv.y))), s3 = 1.0f / (1.0f + __expf(-bfhi(ogv.y)));
            u32x2 o; o.x = cvt_pk(s0 * h0 * r * w4[0], s1 * h1 * r * w4[1]); o.y = cvt_pk(s2 * h2 * r * w4[2], s3 * h3 * r * w4[3]);
            *(u32x2*)(XA + (size_t)m * D + c) = o;
            const u32x2 u0 = *(const u32x2*)(pr + C_U + c), g0 = *(const u32x2*)(pr + C_GC + c), gb = *(const u32x2*)(pr + C_GB + c);
            const u32x2 u1 = *(const u32x2*)(pr1 + C_U + c), g1 = *(const u32x2*)(pr1 + C_GC + c), u2 = *(const u32x2*)(pr2 + C_U + c), g2 = *(const u32x2*)(pr2 + C_GC + c);
            const f32x4 k0 = *(const f32x4*)(cw + c), k1 = *(const f32x4*)(cw + 1024 + c), k2 = *(const f32x4*)(cw + 2048 + c);
            float cv[4];
            cv[0] = z2 * bflo(u2.x) * bflo(g2.x) * k0[0] + z1 * bflo(u1.x) * bflo(g1.x) * k1[0] + bflo(u0.x) * bflo(g0.x) * k2[0];
            cv[1] = z2 * bfhi(u2.x) * bfhi(g2.x) * k0[1] + z1 * bfhi(u1.x) * bfhi(g1.x) * k1[1] + bfhi(u0.x) * bfhi(g0.x) * k2[1];
            cv[2] = z2 * bflo(u2.y) * bflo(g2.y) * k0[2] + z1 * bflo(u1.y) * bflo(g1.y) * k1[2] + bflo(u0.y) * bflo(g0.y) * k2[2];
            cv[3] = z2 * bfhi(u2.y) * bfhi(g2.y) * k0[3] + z1 * bfhi(u1.y) * bfhi(g1.y) * k1[3] + bfhi(u0.y) * bfhi(g0.y) * k2[3];
            u32x2 oc; oc.x = cvt_pk(bflo(gb.x) * cv[0], bfhi(gb.x) * cv[1]); oc.y = cvt_pk(bflo(gb.y) * cv[2], bfhi(gb.y) * cv[3]);
            *(u32x2*)(XA + (size_t)m * D + 1024 + c) = oc;
        }
    }
}

#ifndef MK_PER_PHASE
#define MK_PER_PHASE 0
#endif

__device__ __forceinline__ Args launder(const Args& s) { Args r = s;
    asm volatile("" : "+s"(r.x), "+s"(r.meta), "+s"(r.nmw), "+s"(r.win), "+s"(r.bg), "+s"(r.cw), "+s"(r.mnw), "+s"(r.wout), "+s"(r.nfw), "+s"(r.wg), "+s"(r.wu), "+s"(r.wd), "+s"(r.nfin), "+s"(r.out), "+s"(r.ws));
    return r; }
constexpr int N_PHASES = 17;

__global__ void __launch_bounds__(NTHREADS, 2) hymba_fwd(Args a_in) {
    extern __shared__ __attribute__((aligned(16))) unsigned char lds_raw[];
    LAS unsigned char* lds = (LAS unsigned char*)lds_raw;
    const int wave = __builtin_amdgcn_readfirstlane(threadIdx.x >> 6);
#define LANE() ({ int l_; asm volatile("v_mbcnt_lo_u32_b32 %0, -1, 0\n\tv_mbcnt_hi_u32_b32 %0, -1, %0" : "=v"(l_)); l_; })
    const int G = gridDim.x, bid = blockIdx.x;
    const int lo = a_in.ph_lo, hi = a_in.ph_hi;
#define IN(k) (lo <= (k) && (k) < hi)
#define SEAM(k) do { if (IN(k) && IN((k) + 1)) { cg::this_grid().sync(); } } while (0)
    if (IN(0)) { const Args a = launder(a_in); weights_phase(a, lds, wave, LANE()); __syncthreads(); norm_phase<0>(a, 0, lds, wave, LANE()); __syncthreads(); }
    SEAM(0);
#pragma unroll
    for (int l = 0; l < 2; ++l) {
        const int p0 = 1 + 8 * l;
        if (IN(p0 + 0)) { const Args a = launder(a_in); pg8::Gemm g{(const bf16_t*)(a.ws + WS_XA), (const bf16_t*)(a.ws + WS_WT_IN + l * SZ_WT_IN), MPAD, NPROJ, D}; pg8::StaticOrder S; S.init(MPAD, NPROJ, G, bid);
            EpiProj E{(bf16_t*)(a.ws + WS_PROJ)}; pg8::gemm_phase<EpiProj, pg8::StaticOrder, true, true>(lds, g, S, E, wave); }
        SEAM(p0 + 0);
        if (IN(p0 + 1)) { const Args a = launder(a_in); mlstm_phase(a, lds, wave, LANE()); __syncthreads(); }
        SEAM(p0 + 1);
        if (IN(p0 + 2)) { const Args a = launder(a_in); cat_phase(a, l, wave, LANE()); }
        SEAM(p0 + 2);
        if (IN(p0 + 3)) { const Args a = launder(a_in); pg8::Gemm g{(const bf16_t*)(a.ws + WS_XA), (const bf16_t*)(a.ws + WS_WT_OUT + l * SZ_WT_OUT), MPAD, D, D}; pg8::StaticOrder S; S.init(MPAD, D, G, bid);
            EpiResid E{a.out, (float*)(a.ws + WS_HMETA)}; pg8::gemm_phase<EpiResid, pg8::StaticOrder, true, true>(lds, g, S, E, wave); }
        SEAM(p0 + 3);
        if (IN(p0 + 4)) { const Args a = launder(a_in); norm_phase<2>(a, l, lds, wave, LANE()); }
        SEAM(p0 + 4);
        if (IN(p0 + 5)) { const Args a = launder(a_in); pg8::Gemm g{(const bf16_t*)(a.ws + WS_XA), (const bf16_t*)(a.ws + WS_WT_GU + l * SZ_WT_GU), MPAD, NGU, D}; pg8::StaticOrder S; S.init(MPAD, NGU, G, bid);
            EpiSwiglu E{(bf16_t*)(a.ws + WS_PROJ)}; pg8::gemm_phase<EpiSwiglu, pg8::StaticOrder, true, true>(lds, g, S, E, wave); }
        SEAM(p0 + 5);
        if (IN(p0 + 6)) { const Args a = launder(a_in); pg8::Gemm g{(const bf16_t*)(a.ws + WS_PROJ), (const bf16_t*)(a.ws + WS_WT_DN + l * SZ_WT_DN), MPAD, D, DFF}; pg8::StaticOrder S; S.init(MPAD, D, G, bid);
            EpiResid E{a.out, (float*)(a.ws + WS_HMETA)}; pg8::gemm_phase<EpiResid, pg8::StaticOrder, true, true>(lds, g, S, E, wave); }
        SEAM(p0 + 6);
        if (IN(p0 + 7)) { const Args a = launder(a_in); if (l == 0) { norm_phase<1>(a, 1, lds, wave, LANE()); __syncthreads(); } else norm_phase<3>(a, 0, lds, wave, LANE()); }
        if (l == 0) SEAM(p0 + 7);
    }
#undef IN
#undef SEAM
}

extern "C" void kernel_launch(void* const* d_in, const int* in_sizes, int n_in, void* d_out, int out_size, void* d_ws, size_t ws_size, hipStream_t stream) {
    static int grid = 0;
    if (grid == 0) {
        if (n_in != 13 || in_sizes[0] != MREAL * D || out_size != MREAL * D || ws_size < WS_END) {
            fprintf(stderr, "kernel_launch: unexpected shapes (n_in %d, in0 %d, out %d, ws %zu; need ws >= %zu); nothing launched\n", n_in, n_in > 0 ? in_sizes[0] : -1, out_size, ws_size, (size_t)WS_END); grid = -1; return; }
        int dev = 0, cus = 0, per_cu = 0;
        hipGetDevice(&dev); hipDeviceGetAttribute(&cus, hipDeviceAttributeMultiprocessorCount, dev);
        if (hipFuncSetAttribute((const void*)hymba_fwd, hipFuncAttributeMaxDynamicSharedMemorySize, LDS_BYTES) != hipSuccess) { fprintf(stderr, "kernel_launch: hipFuncSetAttribute failed\n"); grid = -1; return; }
        if (hipOccupancyMaxActiveBlocksPerMultiprocessor(&per_cu, (const void*)hymba_fwd, NTHREADS, LDS_BYTES) != hipSuccess || per_cu < 1) { fprintf(stderr, "kernel_launch: occupancy query says %d\n", per_cu); per_cu = 1; }
        (void)hipGetLastError();
        grid = cus * per_cu;
    }
    if (grid < 0) return;
    Args a{};
    a.x = (const float*)d_in[0]; a.meta = (const float*)d_in[1]; a.nmw = (const float*)d_in[2]; a.win = (const float*)d_in[3]; a.bg = (const float*)d_in[4]; a.cw = (const float*)d_in[5];
    a.mnw = (const float*)d_in[6]; a.wout = (const float*)d_in[7]; a.nfw = (const float*)d_in[8]; a.wg = (const float*)d_in[9]; a.wu = (const float*)d_in[10]; a.wd = (const float*)d_in[11]; a.nfin = (const float*)d_in[12];
    a.out = (float*)d_out; a.ws = (unsigned char*)d_ws;
#if MK_PER_PHASE
    for (int p = 0; p < N_PHASES; ++p) { a.ph_lo = p; a.ph_hi = p + 1; hipLaunchKernelGGL(hymba_fwd, dim3(grid), dim3(NTHREADS), LDS_BYTES, stream, a); }
#else
    a.ph_lo = 0; a.ph_hi = N_PHASES;
    void* args[] = {&a};
    hipError_t e = hipLaunchCooperativeKernel((const void*)hymba_fwd, dim3(grid), dim3(NTHREADS), args, LDS_BYTES, stream);
    if (e != hipSuccess) fprintf(stderr, "kernel_launch: cooperative launch failed: %s (grid %d)\n", hipGetErrorString(e), grid);
#endif
}
```

```cpp
#include <hip/hip_runtime.h>
#include <hip/hip_cooperative_groups.h>
#include <cstdio>
#include <cstdint>
namespace cg = cooperative_groups;
namespace pg8 {
#define PG8_LAS __attribute__((address_space(3)))
typedef unsigned short bf16_t;
typedef short bf16x8 __attribute__((ext_vector_type(8)));
typedef float f32x4 __attribute__((ext_vector_type(4)));
typedef unsigned u32x4 __attribute__((ext_vector_type(4)));
constexpr int BM = 256, BK = 64, HALF = 128, HTB = HALF * BK * 2  , STAGE_BYTES = 8 * HTB, NXCD = 8, WGM = 8;

__host__ __device__ __forceinline__ int lds_byte(int r, int c) { const int st = (r >> 4) * 2 + (c >> 5), rr = r & 15, cc = c & 31, ob = rr * 64 + cc * 2; return st * 1024 + (ob ^ (((ob >> 9) & 1) << 5)); }
__host__ __device__ __forceinline__ void stage_rc(int b, int& R, int& C) { const int st = b / 1024, sb = b % 1024, swz = sb ^ (((sb >> 9) & 1) << 5); R = (st >> 1) * 16 + swz / 64; C = (st & 1) * 32 + (swz % 64) / 2; }
__host__ __device__ __forceinline__ int perm32(int rho) { const int n = rho >> 4, i = rho & 15; return 8 * (i >> 2) + 4 * n + (i & 3); }

struct Unit { int pm, pn; };
struct Gemm { const bf16_t* A; const bf16_t* Bt; int M, N, K; };

struct StaticOrder {
    int nM, nN, nwg, G, c;
    __host__ __device__ void init(int M, int N, int G_, int c_) { nM = M / BM; nN = N / BM; nwg = nM * nN; G = G_; c = c_; }
    __host__ __device__ bool next(int i, Unit& u) const {
        const long L = (long)i * G + c; if (L >= nwg) return false;
        int wgid = (int)L; { const int q = nwg / NXCD, r = nwg % NXCD, xcd = wgid % NXCD, off = wgid / NXCD; wgid = (xcd < r ? xcd * (q + 1) : r * (q + 1) + (xcd - r) * q) + off; }
        const int nig = WGM * nN, gid = wgid / nig, fm = gid * WGM, gsz = (nM - fm) < WGM ? (nM - fm) : WGM;
        u.pm = fm + ((wgid % nig) % gsz); u.pn = (wgid % nig) / gsz; return true;
    }
    __device__ __forceinline__ void a_ready(const Unit&) const {}
    __device__ __forceinline__ void done(const Unit&) const {}
};
__device__ __forceinline__ unsigned cvt_pk_bf16(float lo, float hi) { unsigned r; asm volatile("v_cvt_pk_bf16_f32 %0, %1, %2" : "=v"(r) : "v"(lo), "v"(hi)); return r; }
typedef float f32x2 __attribute__((ext_vector_type(2)));
template <class Epi, class Sched, bool ALIGN_EPI = false, bool SP2 = false>
__device__ __forceinline__ void gemm_phase(PG8_LAS unsigned char* lds, const Gemm g, const Sched& S, const Epi& E, const int wave_in) {
    int tid_; asm volatile("v_mbcnt_lo_u32_b32 %0, -1, 0\n\tv_mbcnt_hi_u32_b32 %0, -1, %0" : "=v"(tid_)); tid_ += wave_in * 64;
    const int tid = tid_, wid = __builtin_amdgcn_readfirstlane(tid >> 6), lane = tid & 63, wr = wid >> 2, wc = wid & 3, fr = lane & 15, fq = lane >> 4;
    const int K = g.K, nt = K / BK;
    unsigned voffA[2], voffB[2];
#pragma unroll
    for (int i = 0; i < 2; ++i) { int R, C; stage_rc(tid * 16 + i * 8192, R, C); const int Rb = Epi::PERM ? ((R & ~31) + perm32(R & 31)) : R;
        voffA[i] = (unsigned)(R * K + C) * 2u; voffB[i] = (unsigned)(Rb * K + C) * 2u; }
    const size_t kstep = (size_t)(BK * 2);
    const size_t hstep = (size_t)HALF * K * 2;
    const size_t tstep = 2 * hstep;
    const unsigned ldsw = (unsigned)wid * 1024u;
    const int aoff = lds_byte(wr * 64 + fr, fq * 8), boff = lds_byte(wc * 32 + fr, fq * 8);
#define PG8_SA(b, h) (((b) * 2 + (h)) * HTB)
#define PG8_SB(b, h) ((4 + (b) * 2 + (h)) * HTB)
#define PG8_STAGE(bufoff, gbase, voff) do { _Pragma("unroll") for (int _i = 0; _i < 2; ++_i) \
        __builtin_amdgcn_global_load_lds((const unsigned*)((const char*)(gbase) + (voff)[_i]), (PG8_LAS unsigned*)(lds + (bufoff) + ldsw + _i * 8192), 16, 0, 0); } while (0)
#define PG8_LDA(dst, b, h) do { _Pragma("unroll") for (int m = 0; m < 4; ++m) _Pragma("unroll") for (int k = 0; k < 2; ++k) dst[m][k] = *(const PG8_LAS bf16x8*)(lds + PG8_SA(b, h) + aoff + m * 2048 + k * 1024); } while (0)
#define PG8_LDB(dst, b, h) do { _Pragma("unroll") for (int n = 0; n < 2; ++n) _Pragma("unroll") for (int k = 0; k < 2; ++k) dst[n][k] = *(const PG8_LAS bf16x8*)(lds + PG8_SB(b, h) + boff + n * 2048 + k * 1024); } while (0)
#define PG8_MMA(ai, bj, At, Bt) do { __builtin_amdgcn_s_setprio(1); _Pragma("unroll") for (int m = 0; m < 4; ++m) _Pragma("unroll") for (int n = 0; n < 2; ++n) _Pragma("unroll") for (int k = 0; k < 2; ++k) \
        acc[ai][bj][m][n] = __builtin_amdgcn_mfma_f32_16x16x32_bf16(Bt[n][k], At[m][k], acc[ai][bj][m][n], 0, 0, 0); __builtin_amdgcn_s_setprio(0); } while (0)
#define PG8_WAIT_V(n) asm volatile("s_waitcnt vmcnt(" #n ")" ::: "memory")
#define PG8_WAIT_L(n) asm volatile("s_waitcnt lgkmcnt(" #n ")" ::: "memory")
#define PG8_BAR __builtin_amdgcn_s_barrier()
#define PG8_SCHED __builtin_amdgcn_sched_barrier(0)
    Unit cur, nxt; int ui = 0;
    if (!S.next(0, cur)) return;
    f32x4 acc[2][2][4][2];
#pragma unroll
    for (int a = 0; a < 2; ++a)
#pragma unroll
        for (int b = 0; b < 2; ++b)
#pragma unroll
            for (int m = 0; m < 4; ++m)
#pragma unroll
                for (int n = 0; n < 2; ++n) acc[a][b][m][n] = (f32x4){0.f, 0.f, 0.f, 0.f};
    bf16x8 At[4][2], B0[2][2], B1[2][2];
    const char* cA = (const char*)g.A + (size_t)cur.pm * tstep; const char* cB = (const char*)g.Bt + (size_t)cur.pn * tstep;
    S.a_ready(cur);
    if constexpr (SP2) {
        PG8_STAGE(PG8_SB(0, 0), cB, voffB); PG8_STAGE(PG8_SB(0, 1), cB + hstep, voffB); PG8_STAGE(PG8_SA(0, 0), cA, voffA); PG8_STAGE(PG8_SA(0, 1), cA + hstep, voffA);
        if (wr == 1) PG8_BAR;
        PG8_WAIT_V(2); PG8_BAR;
        PG8_STAGE(PG8_SB(1, 0), cB + kstep, voffB); PG8_STAGE(PG8_SA(1, 0), cA + kstep, voffA); PG8_STAGE(PG8_SB(1, 1), cB + hstep + kstep, voffB);
        PG8_WAIT_V(6); PG8_BAR;
    } else {
        PG8_STAGE(PG8_SB(0, 0), cB, voffB); PG8_STAGE(PG8_SA(0, 0), cA, voffA); PG8_STAGE(PG8_SB(0, 1), cB + hstep, voffB); PG8_STAGE(PG8_SA(0, 1), cA + hstep, voffA);
        if (wr == 1) PG8_BAR;
        PG8_WAIT_V(4); PG8_BAR;
        PG8_STAGE(PG8_SB(1, 0), cB + kstep, voffB); PG8_STAGE(PG8_SA(1, 0), cA + kstep, voffA); PG8_STAGE(PG8_SB(1, 1), cB + hstep + kstep, voffB);
        PG8_WAIT_V(6); PG8_BAR;
    }
    for (;;) {
        const bool has_next = S.next(ui + 1, nxt);
        const char* nA = has_next ? (const char*)g.A + (size_t)nxt.pm * tstep : cA; const char* nB = has_next ? (const char*)g.Bt + (size_t)nxt.pn * tstep : cB;
        for (int t = 0; t < nt; t += 2) {
            const bool last = (t == nt - 2);
            const char* a1 = cA + (size_t)(t + 1) * kstep;
            const char* a2 = last ? nA : cA + (size_t)(t + 2) * kstep; const char* b2 = last ? nB : cB + (size_t)(t + 2) * kstep;
            const char* a3 = a2 + kstep; const char* b3 = b2 + kstep;
            if (last && has_next) S.a_ready(nxt);
            if constexpr (SP2) {
            PG8_LDB(B0, 0, 0); PG8_LDB(B1, 0, 1); PG8_SCHED; PG8_LDA(At, 0, 0); PG8_STAGE(PG8_SA(1, 1), a1 + hstep, voffA);
            PG8_WAIT_V(8); PG8_WAIT_L(0); PG8_BAR; PG8_MMA(0, 0, At, B0); PG8_MMA(0, 1, At, B1); PG8_BAR; PG8_SCHED;
            PG8_LDA(At, 0, 1); PG8_STAGE(PG8_SB(0, 0), b2, voffB); PG8_STAGE(PG8_SB(0, 1), b2 + hstep, voffB); PG8_STAGE(PG8_SA(0, 0), a2, voffA);
            PG8_WAIT_V(8); PG8_WAIT_L(0); PG8_BAR; PG8_MMA(1, 0, At, B0); PG8_MMA(1, 1, At, B1); PG8_BAR; PG8_SCHED;
            PG8_LDB(B0, 1, 0); PG8_LDB(B1, 1, 1); PG8_SCHED; PG8_LDA(At, 1, 0); PG8_STAGE(PG8_SA(0, 1), a2 + hstep, voffA);
            PG8_WAIT_V(8); PG8_WAIT_L(0); PG8_BAR; PG8_MMA(0, 0, At, B0); PG8_MMA(0, 1, At, B1); PG8_BAR; PG8_SCHED;
            PG8_LDA(At, 1, 1); PG8_STAGE(PG8_SB(1, 0), b3, voffB); PG8_STAGE(PG8_SB(1, 1), b3 + hstep, voffB); PG8_STAGE(PG8_SA(1, 0), a3, voffA);
            PG8_WAIT_V(8); PG8_WAIT_L(0); PG8_BAR; PG8_MMA(1, 0, At, B0); PG8_MMA(1, 1, At, B1); PG8_BAR; PG8_SCHED;
            } else {
            PG8_LDB(B0, 0, 0); PG8_SCHED; PG8_LDA(At, 0, 0); PG8_STAGE(PG8_SA(1, 1), a1 + hstep, voffA);
            PG8_WAIT_L(8); PG8_BAR; PG8_WAIT_L(0); PG8_MMA(0, 0, At, B0); PG8_BAR; PG8_SCHED;
            PG8_LDB(B1, 0, 1); PG8_STAGE(PG8_SB(0, 0), b2, voffB);
            PG8_BAR; PG8_WAIT_L(0); PG8_MMA(0, 1, At, B1); PG8_BAR;
            PG8_LDA(At, 0, 1); PG8_STAGE(PG8_SA(0, 0), a2, voffA);
            PG8_BAR; PG8_WAIT_L(0); PG8_MMA(1, 0, At, B0); PG8_BAR; PG8_SCHED;
            PG8_STAGE(PG8_SB(0, 1), b2 + hstep, voffB);
            PG8_WAIT_V(6); PG8_BAR; PG8_MMA(1, 1, At, B1); PG8_BAR;
            PG8_LDB(B0, 1, 0); PG8_SCHED; PG8_LDA(At, 1, 0); PG8_STAGE(PG8_SA(0, 1), a2 + hstep, voffA);
            PG8_WAIT_L(8); PG8_BAR; PG8_WAIT_L(0); PG8_MMA(0, 0, At, B0); PG8_BAR; PG8_SCHED;
            PG8_LDB(B1, 1, 1); PG8_STAGE(PG8_SB(1, 0), b3, voffB);
            PG8_BAR; PG8_WAIT_L(0); PG8_MMA(0, 1, At, B1); PG8_BAR;
            PG8_LDA(At, 1, 1); PG8_STAGE(PG8_SA(1, 0), a3, voffA);
            PG8_BAR; PG8_WAIT_L(0); PG8_MMA(1, 0, At, B0); PG8_BAR; PG8_SCHED;
            PG8_STAGE(PG8_SB(1, 1), b3 + hstep, voffB);
            PG8_WAIT_V(6); PG8_BAR; PG8_MMA(1, 1, At, B1); PG8_BAR;
            }
        }
        if constexpr (ALIGN_EPI) { if (wr == 0) PG8_BAR; }
        if constexpr (!Epi::AFTER_DRAIN) { E(acc, cur, wr, wc, fr, fq); S.done(cur); }
        if (!has_next) break;
#pragma unroll
        for (int a = 0; a < 2; ++a)
#pragma unroll
            for (int b = 0; b < 2; ++b)
#pragma unroll
                for (int m = 0; m < 4; ++m)
#pragma unroll
                    for (int n = 0; n < 2; ++n) acc[a][b][m][n] = (f32x4){0.f, 0.f, 0.f, 0.f};
        cur = nxt; cA = nA; cB = nB; ++ui;
        if constexpr (ALIGN_EPI) { if (wr == 1) PG8_BAR; }
    }
    PG8_WAIT_V(0);
    if constexpr (!ALIGN_EPI) { if (wr == 0) PG8_BAR; }
    PG8_BAR;
    if constexpr (Epi::AFTER_DRAIN) { E.fused(acc, cur, wr, wc, fr, fq, lds, wid, lane); S.done(cur); }
#undef PG8_SA
#undef PG8_SB
#undef PG8_STAGE
#undef PG8_LDA
#undef PG8_LDB
#undef PG8_MMA
#undef PG8_WAIT_V
#undef PG8_WAIT_L
#undef PG8_BAR
#undef PG8_SCHED
}
}

#define LAS __attribute__((address_space(3)))
typedef unsigned short bf16_t;
typedef short bf16x8 __attribute__((ext_vector_type(8)));
typedef short s16x4 __attribute__((ext_vector_type(4)));
typedef float f32x4 __attribute__((ext_vector_type(4)));
typedef unsigned u32x4 __attribute__((ext_vector_type(4)));
typedef unsigned u32x2 __attribute__((ext_vector_type(2)));

constexpr int D = 2048, NB = 8, SEQ = 2048, NMETA = 16, NHEAD = 4, DV = 256, DQK = 128;
constexpr int MREAL = NB * SEQ;
constexpr int MMETA = NB * NMETA;
constexpr int MTOT = MREAL + MMETA;
constexpr int MPAD = 16640;
constexpr int DIN = 6152, NPROJ = 6144, DFF = 5632, NGU = 2 * DFF;
constexpr int C_Q = 0, C_K = 512, C_V = 1024, C_OG = 2048, C_U = 3072, C_GB = 4096, C_GC = 5120;
constexpr float EPS = 1e-6f, GATE_CAP = 15.0f;
constexpr int NCHUNK = 33;

constexpr size_t MiB = 1u << 20;
constexpr size_t SZ_WT_IN = (size_t)NPROJ * D * 2, SZ_WT_OUT = (size_t)D * D * 2, SZ_WT_GU = (size_t)NGU * D * 2, SZ_WT_DN = (size_t)D * DFF * 2;
constexpr size_t WS_WT_IN = 0, WS_WT_OUT = 48 * MiB, WS_WT_GU = 64 * MiB, WS_WT_DN = 152 * MiB;
constexpr size_t WS_XA = 196 * MiB;
constexpr size_t WS_PROJ = 261 * MiB;
constexpr size_t WS_NUM = 456 * MiB;
constexpr size_t WS_HMETA = 489 * MiB;
constexpr size_t WS_LI = 491 * MiB, WS_LF = WS_LI + MiB / 2, WS_DEN = 492 * MiB, WS_MT = WS_DEN + MiB / 2;
constexpr size_t WS_CTL = 493 * MiB, CTL_BYTES = 65536;
constexpr size_t WS_END = 494 * MiB;
static_assert(2 * SZ_WT_IN <= WS_WT_OUT - WS_WT_IN && 2 * SZ_WT_OUT <= WS_WT_GU - WS_WT_OUT && 2 * SZ_WT_GU <= WS_WT_DN - WS_WT_GU && 2 * SZ_WT_DN <= WS_XA - WS_WT_DN, "ws map");
static_assert((size_t)MPAD * D * 2 <= WS_PROJ - WS_XA && (size_t)MPAD * NPROJ * 2 <= WS_NUM - WS_PROJ && (size_t)MPAD * 1024 * 2 <= WS_HMETA - WS_NUM, "ws map");

constexpr int LDS_BYTES = 147456;
constexpr int NWAVES = 8, NTHREADS = 512;

__device__ __forceinline__ unsigned cvt_pk(float lo, float hi) { unsigned r; asm volatile("v_cvt_pk_bf16_f32 %0, %1, %2" : "=v"(r) : "v"(lo), "v"(hi)); return r; }
__device__ __forceinline__ float bf2f(unsigned short b) { return __uint_as_float(((unsigned)b) << 16); }
__device__ __forceinline__ float bflo(unsigned w) { return __uint_as_float(w << 16); }
__device__ __forceinline__ float bfhi(unsigned w) { return __uint_as_float(w & 0xffff0000u); }
__device__ __forceinline__ float wave_sum(float v) {
#pragma unroll
    for (int o = 1; o < 64; o <<= 1) v += __shfl_xor(v, o);
    return v;
}
__device__ __forceinline__ float wave_max(float v) {
#pragma unroll
    for (int o = 1; o < 64; o <<= 1) v = fmaxf(v, __shfl_xor(v, o));
    return v;
}

struct Args {
    const float *x, *meta, *nmw, *win, *bg, *cw, *mnw, *wout, *nfw, *wg, *wu, *wd, *nfin;
    float* out; unsigned char* ws; int ph_lo, ph_hi;
};
static_assert(sizeof(Args) == 15 * 8 + 8, "Args has no padding");

__device__ __forceinline__ float* hrow(const Args& a, int m) { return m < MREAL ? a.out + (size_t)m * D : (float*)(a.ws + WS_HMETA) + (size_t)(m - MREAL) * D; }

struct EpiProj {
    static constexpr bool PERM = true, AFTER_DRAIN = false;
    bf16_t* O;
    __device__ __forceinline__ void operator()(const f32x4 (&acc)[2][2][4][2], const pg8::Unit& u, int wr, int wc, int fr, int fq) const {
        const int row0 = u.pm * 256 + wr * 64 + fr, colt = u.pn * 256;
        const float sc = (colt < C_K) ? 0.08838834764831845f : 1.0f;
        const int col0 = colt + wc * 32 + 8 * fq;
#pragma unroll
        for (int ai = 0; ai < 2; ++ai)
#pragma unroll
            for (int m = 0; m < 4; ++m) { bf16_t* rowp = O + (size_t)(row0 + ai * 128 + m * 16) * NPROJ + col0;
#pragma unroll
                for (int bj = 0; bj < 2; ++bj) { const f32x4 v0 = acc[ai][bj][m][0] * sc, v1 = acc[ai][bj][m][1] * sc;
                    u32x4 w; w.x = cvt_pk(v0[0], v0[1]); w.y = cvt_pk(v0[2], v0[3]); w.z = cvt_pk(v1[0], v1[1]); w.w = cvt_pk(v1[2], v1[3]);
                    *(u32x4*)(rowp + bj * 128) = w; } }
    }
};
struct EpiResid {
    static constexpr bool PERM = false, AFTER_DRAIN = false;
    float* out; float* hmeta;
    __device__ __forceinline__ void operator()(const f32x4 (&acc)[2][2][4][2], const pg8::Unit& u, int wr, int wc, int fr, int fq) const {
        float* hb = (u.pm < MREAL / 256) ? out + (size_t)u.pm * 256 * D : hmeta;
        const int r0 = wr * 64 + fr, col0 = u.pn * 256 + wc * 32 + 4 * fq;
#pragma unroll
        for (int ai = 0; ai < 2; ++ai)
#pragma unroll
            for (int m = 0; m < 4; ++m) { float* rowp = hb + (size_t)(r0 + ai * 128 + m * 16) * D + col0;
                f32x4 old[2][2];
#pragma unroll
                for (int bj = 0; bj < 2; ++bj)
#pragma unroll
                    for (int n = 0; n < 2; ++n) old[bj][n] = *(const f32x4*)(rowp + bj * 128 + n * 16);
#pragma unroll
                for (int bj = 0; bj < 2; ++bj)
#pragma unroll
                    for (int n = 0; n < 2; ++n) *(f32x4*)(rowp + bj * 128 + n * 16) = old[bj][n] + acc[ai][bj][m][n];
            }
    }
};
struct EpiSwiglu {
    static constexpr bool PERM = true, AFTER_DRAIN = false;
    bf16_t* O;
    __device__ __forceinline__ void operator()(const f32x4 (&acc)[2][2][4][2], const pg8::Unit& u, int wr, int wc, int fr, int fq) const {
        const int row0 = u.pm * 256 + wr * 64 + fr, col0 = u.pn * 128 + wc * 32 + 8 * fq;
#pragma unroll
        for (int ai = 0; ai < 2; ++ai)
#pragma unroll
            for (int m = 0; m < 4; ++m) { bf16_t* rowp = O + (size_t)(row0 + ai * 128 + m * 16) * DFF + col0;
                float r[8];
#pragma unroll
                for (int n = 0; n < 2; ++n)
#pragma unroll
                    for (int j = 0; j < 4; ++j) { const float g = acc[ai][0][m][n][j], up = acc[ai][1][m][n][j]; r[n * 4 + j] = g * up * __builtin_amdgcn_rcpf(1.0f + __expf(-g)); }
                u32x4 w; w.x = cvt_pk(r[0], r[1]); w.y = cvt_pk(r[2], r[3]); w.z = cvt_pk(r[4], r[5]); w.w = cvt_pk(r[6], r[7]);
                *(u32x4*)rowp = w; }
    }
};

#define RLX_AGENT __ATOMIC_RELAXED, __HIP_MEMORY_SCOPE_AGENT
#define XB_TMO      128
#define XB_XCNT(j)  (256  + 64 * (j))
#define XB_XSUB(j)  (1280 + 64 * (j))
#define XB_XGEN(j)  (2304 + 64 * (j))
#define XB_TOP      3328
#define XB_TOPGEN   3392
#define XCD_BAR_WORDS 3456
#define XB_SPIN_CAP (1u << 18)

__device__ __forceinline__ unsigned xb_ld(unsigned* p)              { return __hip_atomic_load(p, __ATOMIC_RELAXED, __HIP_MEMORY_SCOPE_AGENT); }
__device__ __forceinline__ unsigned xb_add(unsigned* p, unsigned v) { return __hip_atomic_fetch_add(p, v, __ATOMIC_RELAXED, __HIP_MEMORY_SCOPE_AGENT); }
__device__ __forceinline__ unsigned xb_xcc_id() { return (unsigned)__builtin_amdgcn_s_getreg((3 << 11) | 20) & 0xFu; }
#define XB_SPIN(cond, bar) do { unsigned _sp = 0; while (cond) { __builtin_amdgcn_s_sleep(1); \
    if ((++_sp & 255u) == 0u) { if (xb_ld(&(bar)[XB_TMO])) break; if (_sp > XB_SPIN_CAP) { atomicAdd(&(bar)[XB_TMO], 1u); break; } } } } while (0)

struct XcdBarrier {
    unsigned* bar; unsigned x;
    volatile LAS unsigned* st;
};

__device__ __forceinline__ XcdBarrier xcd_barrier_post(unsigned* bar, volatile LAS unsigned* st) {
    XcdBarrier b; b.bar = bar; b.x = xb_xcc_id(); b.st = st;
    if (threadIdx.x == 0) (void)xb_add(&bar[XB_XCNT(b.x)], 1u);
    return b;
}
__device__ __forceinline__ void xcd_barrier_complete(unsigned* bar, unsigned x, unsigned& nloc, unsigned& nx) {
    const unsigned G = gridDim.x * gridDim.y * gridDim.z;
    unsigned sum, cnt, mine, sp = 0u;
    for (;;) {
        sum = 0u; cnt = 0u; mine = 0u;
#pragma unroll
        for (unsigned j = 0; j < 16; ++j) { const unsigned c = xb_ld(&bar[XB_XCNT(j)]); sum += c; cnt += (c > 0u) ? 1u : 0u; mine = (j == x) ? c : mine; }
        if (sum == G) break;
        __builtin_amdgcn_s_sleep(1);
        if ((++sp & 255u) == 0u) { if (xb_ld(&bar[XB_TMO])) break; if (sp > XB_SPIN_CAP) { atomicAdd(&bar[XB_TMO], 1u); break; } }
    }
    nloc = mine > 0u ? mine : 1u; nx = cnt > 0u ? cnt : 1u;
}

__device__ __forceinline__ void xcd_barrier(const XcdBarrier& b) {
    asm volatile("s_waitcnt vmcnt(0)" ::: "memory");
    __syncthreads();
    if (threadIdx.x == 0) {
        unsigned* bar = b.bar;
        __builtin_amdgcn_s_waitcnt(0);
        unsigned nloc = b.st[0], nx = b.st[1];
        if (nloc == 0u) { xcd_barrier_complete(bar, b.x, nloc, nx); b.st[0] = nloc; b.st[1] = nx; }
        const unsigned old = xb_add(&bar[XB_XSUB(b.x)], 1u);
        const unsigned gen = old / nloc;
        if (old + 1u == (gen + 1u) * nloc) {
            __builtin_amdgcn_fence(__ATOMIC_RELEASE, "agent");
            asm volatile("s_waitcnt vmcnt(0)" ::: "memory");
            const unsigned og = xb_add(&bar[XB_TOP], 1u);
            const unsigned tg = og / nx;
            if (og + 1u == (tg + 1u) * nx) xb_add(&bar[XB_TOPGEN], 1u);
            else XB_SPIN(xb_ld(&bar[XB_TOPGEN]) == tg, bar);
            __builtin_amdgcn_fence(__ATOMIC_ACQUIRE, "agent");
            xb_add(&bar[XB_XGEN(b.x)], 1u);
            asm volatile("s_waitcnt vmcnt(0)" ::: "memory");
        } else {
            XB_SPIN(xb_ld(&bar[XB_XGEN(b.x)]) == gen, bar);
            __builtin_amdgcn_fence(__ATOMIC_ACQUIRE, "agent");
            asm volatile("s_waitcnt vmcnt(0)" ::: "memory");
        }
    }
    __syncthreads();
}


__device__ __forceinline__ void tr_item(const float* W, int ldw, int k0, int src_n0, bf16_t* WT, int K, int dst_row0, LAS float* scr, int lane) {
#pragma unroll 8
    for (int i = 0; i < 32; ++i) { const int kk = 2 * i + (lane >> 5); scr[kk * 33 + (lane & 31)] = W[(size_t)(k0 + kk) * ldw + src_n0 + (lane & 31)]; }
    asm volatile("s_waitcnt lgkmcnt(0)" ::: "memory");
    const int c = lane & 7;
#pragma unroll
    for (int j = 0; j < 4; ++j) { const int n = (lane >> 3) + 8 * j; const LAS float* s = scr + (8 * c) * 33 + n;
        u32x4 o; o.x = cvt_pk(s[0 * 33], s[1 * 33]); o.y = cvt_pk(s[2 * 33], s[3 * 33]); o.z = cvt_pk(s[4 * 33], s[5 * 33]); o.w = cvt_pk(s[6 * 33], s[7 * 33]);
        *(u32x4*)(WT + (size_t)(dst_row0 + n) * K + k0 + 8 * c) = o; }
    asm volatile("s_waitcnt lgkmcnt(0)" ::: "memory");
}
__device__ __forceinline__ void weights_phase(const Args& a, LAS unsigned char* lds, int wave, int lane) {
    LAS float* scr = (LAS float*)(lds + wave * 16384);
    const int gw = blockIdx.x * NWAVES + wave, NGW = gridDim.x * NWAVES;
    constexpr int I_IN = 32 * 192, I_OUT = 32 * 64, I_G = 32 * 176, I_DN = 88 * 64, I_LAYER = I_IN + I_OUT + 2 * I_G + I_DN;
    for (int it = gw; it < 2 * I_LAYER; it += NGW) {
        const int l = it / I_LAYER; int r = it - l * I_LAYER;
        if (r < I_IN) { const int kb = r / 192, nb = r % 192, d0 = nb * 32; tr_item(a.win + (size_t)l * D * DIN, DIN, kb * 64, d0 + (d0 >= 3072 ? 8 : 0), (bf16_t*)(a.ws + WS_WT_IN + l * SZ_WT_IN), D, d0, scr, lane); continue; } r -= I_IN;
        if (r < I_OUT) { const int kb = r / 64, nb = r % 64; tr_item(a.wout + (size_t)l * D * D, D, kb * 64, nb * 32, (bf16_t*)(a.ws + WS_WT_OUT + l * SZ_WT_OUT), D, nb * 32, scr, lane); continue; } r -= I_OUT;
        if (r < I_G) { const int kb = r / 176, nb = r % 176, n0 = nb * 32; tr_item(a.wg + (size_t)l * D * DFF, DFF, kb * 64, n0, (bf16_t*)(a.ws + WS_WT_GU + l * SZ_WT_GU), D, (n0 >> 7) * 256 + (n0 & 127), scr, lane); continue; } r -= I_G;
        if (r < I_G) { const int kb = r / 176, nb = r % 176, n0 = nb * 32; tr_item(a.wu + (size_t)l * D * DFF, DFF, kb * 64, n0, (bf16_t*)(a.ws + WS_WT_GU + l * SZ_WT_GU), D, (n0 >> 7) * 256 + 128 + (n0 & 127), scr, lane); continue; } r -= I_G;
        { const int kb = r / 64, nb = r % 64; tr_item(a.wd + (size_t)l * DFF * D, D, kb * 64, nb * 32, (bf16_t*)(a.ws + WS_WT_DN + l * SZ_WT_DN), DFF, nb * 32, scr, lane); }
    }
}

template <int MODE>
__device__ __forceinline__ void norm_phase(const Args& a, int layer, LAS unsigned char* lds, int wave, int lane) {
    const float* nw = MODE <= 1 ? a.nmw + layer * D : (MODE == 2 ? a.nfw + layer * D : a.nfin);
    LAS float* WG = (LAS float*)lds;
    if (MODE <= 1) {
        const float* wsrc = a.win + (size_t)layer * D * DIN + 3072;
        for (int k = wave * 64 + lane; k < D; k += NTHREADS) { const f32x4 g0 = *(const f32x4*)(wsrc + (size_t)k * DIN), g1 = *(const f32x4*)(wsrc + (size_t)k * DIN + 4);
            WG[0 * D + k] = g0[0]; WG[1 * D + k] = g0[1]; WG[2 * D + k] = g0[2]; WG[3 * D + k] = g0[3]; WG[4 * D + k] = g1[0]; WG[5 * D + k] = g1[1]; WG[6 * D + k] = g1[2]; WG[7 * D + k] = g1[3]; }
        __syncthreads();
    }
    bf16_t* XA = (bf16_t*)(a.ws + WS_XA); float* LI = (float*)(a.ws + WS_LI); float* LF = (float*)(a.ws + WS_LF);
    const int gw = blockIdx.x * NWAVES + wave, NGW = gridDim.x * NWAVES;
    f32x4 w[8];
#pragma unroll
    for (int j = 0; j < 8; ++j) w[j] = *((const f32x4*)nw + lane + 64 * j);
    for (int m = gw; m < (MODE == 3 ? MREAL : MTOT); m += NGW) {
        const float* src = MODE == 0 ? (m < MREAL ? a.x + (size_t)m * D : a.meta + (size_t)((m - MREAL) & 15) * D) : hrow(a, m);
        f32x4 v[8]; float ss = 0.f;
#pragma unroll
        for (int j = 0; j < 8; ++j) { v[j] = *((const f32x4*)src + lane + 64 * j); ss += (v[j][0] * v[j][0] + v[j][1] * v[j][1]) + (v[j][2] * v[j][2] + v[j][3] * v[j][3]); }
        if (MODE == 0) { float* hp = hrow(a, m);
#pragma unroll
            for (int j = 0; j < 8; ++j) *((f32x4*)hp + lane + 64 * j) = v[j]; }
        const float rstd = rsqrtf(wave_sum(ss) * (1.0f / D) + EPS);
#pragma unroll
        for (int j = 0; j < 8; ++j) v[j] = v[j] * rstd * w[j];
        if (MODE == 3) { float* op = a.out + (size_t)m * D;
#pragma unroll
            for (int j = 0; j < 8; ++j) *((f32x4*)op + lane + 64 * j) = v[j];
        } else { bf16_t* op = XA + (size_t)m * D;
#pragma unroll
            for (int j = 0; j < 8; ++j) { u32x2 o; o.x = cvt_pk(v[j][0], v[j][1]); o.y = cvt_pk(v[j][2], v[j][3]); *((u32x2*)op + lane + 64 * j) = o; } }
        if (MODE <= 1) {
            float mine = 0.f;
#pragma unroll
            for (int g = 0; g < 8; ++g) { float s = 0.f;
#pragma unroll
                for (int j = 0; j < 8; ++j) { const f32x4 wg = *((const LAS f32x4*)(WG + g * D) + lane + 64 * j); s += (v[j][0] * wg[0] + v[j][1] * wg[1]) + (v[j][2] * wg[2] + v[j][3] * wg[3]); }
                s = wave_sum(s); mine = (lane == g) ? s : mine; }
            if (lane < 8) { const float raw = mine + a.bg[layer * 8 + lane]; const float e2 = __expf(raw * (2.0f / GATE_CAP)); const float cp = GATE_CAP * (e2 - 1.0f) / (e2 + 1.0f);
                if (lane < 4) LI[m * 4 + lane] = cp; else LF[m * 4 + lane - 4] = fminf(cp, 0.f) - __logf(1.0f + __expf(-fabsf(cp))); }
        }
    }
}

__device__ __forceinline__ bf16x8 pack8(const f32x4& x, const f32x4& y) {
    u32x4 w; w.x = cvt_pk(x[0], x[1]); w.y = cvt_pk(x[2], x[3]); w.z = cvt_pk(y[0], y[1]); w.w = cvt_pk(y[2], y[3]); return __builtin_bit_cast(bf16x8, w);
}
typedef short v4i16_t __attribute__((ext_vector_type(4)));
__device__ __forceinline__ s16x4 lds_tr(LAS unsigned char* p) { return __builtin_bit_cast(s16x4, __builtin_amdgcn_ds_read_tr16_b64_v4i16((LAS v4i16_t*)p)); }
#define MFMA16(x, y, c) __builtin_amdgcn_mfma_f32_16x16x32_bf16((x), (y), (c), 0, 0, 0)
constexpr int KIMG_STRIDE = 288, KIMG_BYTES = 64 * KIMG_STRIDE, MWAVE_BYTES = KIMG_BYTES + 1024;
constexpr int MLSTM_WAVES = 4;

__device__ __forceinline__ void mlstm_item(const Args& a, int bh, int sl, LAS unsigned char* kimg, int lane) {
    const bf16_t* proj = (const bf16_t*)(a.ws + WS_PROJ);
    const float* LI = (const float*)(a.ws + WS_LI); const float* LF = (const float*)(a.ws + WS_LF);
    bf16_t* NUM = (bf16_t*)(a.ws + WS_NUM); float* DEN = (float*)(a.ws + WS_DEN); float* MT = (float*)(a.ws + WS_MT);
    LAS float* sc = (LAS float*)(kimg + KIMG_BYTES);
    const int b = bh >> 2, hd = bh & 3, fr = lane & 15, fq = lane >> 4;
    const bool den_item = (sl == 16);
    const int vcol = C_V + hd * 256 + (den_item ? 0 : sl * 16) + fr;
    f32x4 C[8];
#pragma unroll
    for (int i = 0; i < 8; ++i) C[i] = (f32x4){0.f, 0.f, 0.f, 0.f};
    float m_st = 0.f;
#pragma unroll 1
    for (int c = 0; c < NCHUNK; ++c) {
#define ROWOF(p) (c == 0 ? (MREAL + b * 16 + ((p) < 48 ? 0 : (p) - 48)) : (b * SEQ + (c - 1) * 64 + (p)))
        float w_old, m_new;
        {
            const int rl = ROWOF(lane);
            float lf = LF[rl * 4 + hd], li = LI[rl * 4 + hd];
            if (c == 0 && lane < 48) { lf = 0.f; li = -1e30f; }
            float bc = lf;
#pragma unroll
            for (int o = 1; o < 64; o <<= 1) { const float t = __shfl_up(bc, o); bc += (lane >= o) ? t : 0.f; }
            const float b_end = __shfl(bc, 63);
            const float decay = b_end - bc + li;
            m_new = fmaxf(b_end + m_st, wave_max(decay));
            w_old = __expf(b_end + m_st - m_new);
            sc[lane] = li - bc; sc[64 + lane] = __expf(decay - m_new); sc[128 + lane] = bc;
        }
#pragma unroll
        for (int xb = 0; xb < 4; ++xb) { const bf16_t* rp = proj + (size_t)ROWOF(xb * 16 + fr) * NPROJ + C_K + hd * 128 + fq * 4; LAS unsigned char* wp = kimg + (xb * 16 + fr) * KIMG_STRIDE + fq * 8;
#pragma unroll
            for (int kc = 0; kc < 4; ++kc) { const s16x4 lo = *(const s16x4*)(rp + 32 * kc), hi = *(const s16x4*)(rp + 32 * kc + 16); *(LAS s16x4*)(wp + 64 * kc) = lo; *(LAS s16x4*)(wp + 64 * kc + 32) = hi; } }
        asm volatile("s_waitcnt lgkmcnt(0)" ::: "memory");
        bf16x8 vf[2], wvf[2];
#pragma unroll
        for (int ks = 0; ks < 2; ++ks) { float vv[8];
#pragma unroll
            for (int h = 0; h < 2; ++h) { const f32x4 wi = *(const LAS f32x4*)(sc + 64 + 32 * ks + 16 * h + 4 * fq);
#pragma unroll
                for (int q = 0; q < 4; ++q) { const int s = 32 * ks + 16 * h + 4 * fq + q;
                    const unsigned short raw = den_item ? (unsigned short)(fr == 0 ? 0x3F80 : 0) : proj[(size_t)ROWOF(s) * NPROJ + vcol];
                    vf[ks][4 * h + q] = (short)raw; vv[4 * h + q] = bf2f(raw) * wi[q]; } }
            wvf[ks] = pack8((f32x4){vv[0], vv[1], vv[2], vv[3]}, (f32x4){vv[4], vv[5], vv[6], vv[7]}); }
        bf16x8 cf[4];
#pragma unroll
        for (int kc = 0; kc < 4; ++kc) cf[kc] = pack8(C[2 * kc], C[2 * kc + 1]);
#pragma unroll
        for (int tb = 0; tb < 4; ++tb) {
            const int t = tb * 16 + fr;
            bf16x8 qf[4];
            { const bf16_t* rp = proj + (size_t)ROWOF(t) * NPROJ + C_Q + hd * 128 + fq * 4;
#pragma unroll
              for (int kc = 0; kc < 4; ++kc) { const s16x4 lo = *(const s16x4*)(rp + 32 * kc), hi = *(const s16x4*)(rp + 32 * kc + 16); qf[kc] = __builtin_shufflevector(lo, hi, 0, 1, 2, 3, 4, 5, 6, 7); } }
            f32x4 S[4];
#pragma unroll
            for (int sb = 0; sb < 4; ++sb) { f32x4 acc = (f32x4){0.f, 0.f, 0.f, 0.f}; const LAS unsigned char* kp = kimg + (sb * 16 + fr) * KIMG_STRIDE + fq * 8;
#pragma unroll
                for (int kc = 0; kc < 4; ++kc) { const s16x4 lo = *(const LAS s16x4*)(kp + 64 * kc), hi = *(const LAS s16x4*)(kp + 64 * kc + 32);
                    acc = MFMA16(__builtin_shufflevector(lo, hi, 0, 1, 2, 3, 4, 5, 6, 7), qf[kc], acc); }
                S[sb] = acc; }
            const float bt = sc[128 + t];
            f32x4 gs[4];
#pragma unroll
            for (int sb = 0; sb < 4; ++sb) gs[sb] = *(const LAS f32x4*)(sc + sb * 16 + 4 * fq);
            float dmax = -1e30f;
#pragma unroll
            for (int sb = 0; sb < 4; ++sb)
#pragma unroll
                for (int jj = 0; jj < 4; ++jj) { const int s = sb * 16 + fq * 4 + jj; const float d = (s <= t) ? bt + gs[sb][jj] : -1e30f; dmax = fmaxf(dmax, d); }
            dmax = fmaxf(dmax, __shfl_xor(dmax, 16)); dmax = fmaxf(dmax, __shfl_xor(dmax, 32));
            const float inter = bt + m_st, mt = fmaxf(inter, dmax);
            sc[192 + t] = __expf(inter - mt);
#pragma unroll
            for (int sb = 0; sb < 4; ++sb)
#pragma unroll
                for (int jj = 0; jj < 4; ++jj) { const int s = sb * 16 + fq * 4 + jj; const float e = (s <= t) ? __expf(bt + gs[sb][jj] - mt) : 0.f; S[sb][jj] *= e; }
            f32x4 nm = (f32x4){0.f, 0.f, 0.f, 0.f};
#pragma unroll
            for (int kc = 0; kc < 4; ++kc) nm = MFMA16(qf[kc], cf[kc], nm);
            nm = nm * *(const LAS f32x4*)(sc + 192 + tb * 16 + 4 * fq);
#pragma unroll
            for (int ks = 0; ks < 2; ++ks) nm = MFMA16(pack8(S[2 * ks], S[2 * ks + 1]), vf[ks], nm);
#pragma unroll
            for (int jj = 0; jj < 4; ++jj) { const int tt = tb * 16 + fq * 4 + jj;
                if (c > 0 || tt >= 48) { const int row = ROWOF(tt);
                    if (!den_item) NUM[(size_t)row * 1024 + hd * 256 + sl * 16 + fr] = (bf16_t)(cvt_pk(nm[jj], 0.f) & 0xffffu);
                    else if (fr == 0) DEN[row * 4 + hd] = nm[jj]; } }
            if (den_item && fq == 0 && (c > 0 || t >= 48)) MT[ROWOF(t) * 4 + hd] = mt;
        }
#pragma unroll
        for (int dt = 0; dt < 8; ++dt) { f32x4 cc = C[dt] * w_old;
#pragma unroll
            for (int ks = 0; ks < 2; ++ks) { LAS unsigned char* tp = kimg + (32 * ks + 4 * fq + (fr >> 2)) * KIMG_STRIDE + (dt * 16 + 4 * (fr & 3)) * 2;
                const s16x4 lo = lds_tr(tp), hi = lds_tr(tp + 16 * KIMG_STRIDE);
                cc = MFMA16(__builtin_shufflevector(lo, hi, 0, 1, 2, 3, 4, 5, 6, 7), wvf[ks], cc); }
            C[dt] = cc; }
        m_st = m_new;
        asm volatile("s_waitcnt lgkmcnt(0)" ::: "memory");
#undef ROWOF
    }
}
__device__ __forceinline__ void mlstm_phase(const Args& a, LAS unsigned char* lds, int wave, int lane) {
    if (wave >= MLSTM_WAVES) return;
    LAS unsigned char* kimg = lds + wave * MWAVE_BYTES;
    for (int it = wave * (int)gridDim.x + (int)blockIdx.x; it < 32 * 17; it += MLSTM_WAVES * (int)gridDim.x) mlstm_item(a, it / 17, it % 17, kimg, lane);
}

__device__ __forceinline__ void cat_phase(const Args& a, int layer, int wave, int lane) {
    const bf16_t* proj = (const bf16_t*)(a.ws + WS_PROJ); const bf16_t* NUM = (const bf16_t*)(a.ws + WS_NUM);
    const float* DEN = (const float*)(a.ws + WS_DEN); const float* MT = (const float*)(a.ws + WS_MT);
    bf16_t* XA = (bf16_t*)(a.ws + WS_XA);
    const float* mnw = a.mnw + layer * 1024; const float* cw = a.cw + layer * 3 * 1024;
    const int gw = blockIdx.x * NWAVES + wave, NGW = gridDim.x * NWAVES;
    for (int m = gw; m < MTOT; m += NGW) {
        int p1, p2;
        if (m < MREAL) { const int t = m & (SEQ - 1), b = m >> 11; p1 = t >= 1 ? m - 1 : MREAL + b * 16 + 15; p2 = t >= 2 ? m - 2 : MREAL + b * 16 + 14 + t; }
        else { const int j = (m - MREAL) & 15; p1 = j >= 1 ? m - 1 : -1; p2 = j >= 2 ? m - 2 : -1; }
        const bf16_t* pr = proj + (size_t)m * NPROJ; const bf16_t* pr1 = proj + (size_t)(p1 < 0 ? m : p1) * NPROJ; const bf16_t* pr2 = proj + (size_t)(p2 < 0 ? m : p2) * NPROJ;
        const float z1 = p1 < 0 ? 0.f : 1.f, z2 = p2 < 0 ? 0.f : 1.f;
#pragma unroll
        for (int j = 0; j < 4; ++j) {
            const int c = lane * 4 + 256 * j;
            const u32x2 nv = *(const u32x2*)(NUM + (size_t)m * 1024 + c);
            const float den = DEN[m * 4 + j], mt = MT[m * 4 + j];
            const float sc = 1.0f / fmaxf(fabsf(den), __expf(-mt));
            float h0 = bflo(nv.x) * sc, h1 = bfhi(nv.x) * sc, h2 = bflo(nv.y) * sc, h3 = bfhi(nv.y) * sc;
            const float r = rsqrtf(wave_sum((h0 * h0 + h1 * h1) + (h2 * h2 + h3 * h3)) * (1.0f / DV) + EPS);
            const f32x4 w4 = *(const f32x4*)(mnw + c);
            const u32x2 ogv = *(const u32x2*)(pr + C_OG + c);
            const float s0 = 1.0f / (1.0f + __expf(-bflo(ogv.x))), s1 = 1.0f / (1.0f + __expf(-bfhi(ogv.x))), s2 = 1.0f / (1.0f + __expf(-bflo(ogv.y))), s3 = 1.0f / (1.0f + __expf(-bfhi(ogv.y)));
            u32x2 o; o.x = cvt_pk(s0 * h0 * r * w4[0], s1 * h1 * r * w4[1]); o.y = cvt_pk(s2 * h2 * r * w4[2], s3 * h3 * r * w4[3]);
            *(u32x2*)(XA + (size_t)m * D + c) = o;
            const u32x2 u0 = *(const u32x2*)(pr + C_U + c), g0 = *(const u32x2*)(pr + C_GC + c), gb = *(const u32x2*)(pr + C_GB + c);
            const u32x2 u1 = *(const u32x2*)(pr1 + C_U + c), g1 = *(const u32x2*)(pr1 + C_GC + c), u2 = *(const u32x2*)(pr2 + C_U + c), g2 = *(const u32x2*)(pr2 + C_GC + c);
            const f32x4 k0 = *(const f32x4*)(cw + c), k1 = *(const f32x4*)(cw + 1024 + c), k2 = *(const f32x4*)(cw + 2048 + c);
            float cv[4];
            cv[0] = z2 * bflo(u2.x) * bflo(g2.x) * k0[0] + z1 * bflo(u1.x) * bflo(g1.x) * k1[0] + bflo(u0.x) * bflo(g0.x) * k2[0];
            cv[1] = z2 * bfhi(u2.x) * bfhi(g2.x) * k0[1] + z1 * bfhi(u1.x) * bfhi(g1.x) * k1[1] + bfhi(u0.x) * bfhi(g0.x) * k2[1];
            cv[2] = z2 * bflo(u2.y) * bflo(g2.y) * k0[2] + z1 * bflo(u1.y) * bflo(g1.y) * k1[2] + bflo(u0.y) * bflo(g0.y) * k2[2];
            cv[3] = z2 * bfhi(u2.y) * bfhi(g2.y) * k0[3] + z1 * bfhi(u1.y) * bfhi(g1.y) * k1[3] + bfhi(u0.y) * bfhi(g0.y) * k2[3];
            u32x2 oc; oc.x = cvt_pk(bflo(gb.x) * cv[0], bfhi(gb.x) * cv[1]); oc.y = cvt_pk(bflo(gb.y) * cv[2], bfhi(gb.y) * cv[3]);
            *(u32x2*)(XA + (size_t)m * D + 1024 + c) = oc;
        }
    }
}

#ifndef MK_PER_PHASE
#define MK_PER_PHASE 0
#endif

__device__ __forceinline__ Args launder(const Args& s) { Args r = s;
    asm volatile("" : "+s"(r.x), "+s"(r.meta), "+s"(r.nmw), "+s"(r.win), "+s"(r.bg), "+s"(r.cw), "+s"(r.mnw), "+s"(r.wout), "+s"(r.nfw), "+s"(r.wg), "+s"(r.wu), "+s"(r.wd), "+s"(r.nfin), "+s"(r.out), "+s"(r.ws));
    return r; }
constexpr int N_PHASES = 17;

__global__ void __launch_bounds__(NTHREADS, 2) hymba_fwd(Args a_in) {
    extern __shared__ __attribute__((aligned(16))) unsigned char lds_raw[];
    LAS unsigned char* lds = (LAS unsigned char*)lds_raw;
    const int wave = __builtin_amdgcn_readfirstlane(threadIdx.x >> 6);
#define LANE() ({ int l_; asm volatile("v_mbcnt_lo_u32_b32 %0, -1, 0\n\tv_mbcnt_hi_u32_b32 %0, -1, %0" : "=v"(l_)); l_; })
    const int G = gridDim.x, bid = blockIdx.x;
    const int lo = a_in.ph_lo, hi = a_in.ph_hi;
    volatile LAS unsigned* MISC = (volatile LAS unsigned*)(lds + 131072);
    XcdBarrier bar; bar.bar = (unsigned*)(a_in.ws + WS_CTL); bar.x = 0; bar.st = MISC + 8;
    if (hi - lo > 1) { if (threadIdx.x < 64) MISC[threadIdx.x] = 0u; __syncthreads(); bar = xcd_barrier_post((unsigned*)(a_in.ws + WS_CTL), MISC + 8); }
#define IN(k) (lo <= (k) && (k) < hi)
#ifndef PROBE
#define PROBE 0
#endif
#define DUP(n) for (int rep_ = 0; rep_ < ((PROBE == (n)) ? 2 : 1); ++rep_)
#define SEAM(k) do { if (IN(k) && IN((k) + 1)) { if ((k) == 0) cg::this_grid().sync(); else xcd_barrier(bar); if (PROBE == 9) xcd_barrier(bar); } } while (0)
    if (IN(0)) { const Args a = launder(a_in); DUP(1) { weights_phase(a, lds, wave, LANE()); __syncthreads(); } norm_phase<0>(a, 0, lds, wave, LANE()); __syncthreads(); }
    SEAM(0);
#pragma unroll
    for (int l = 0; l < 2; ++l) {
        const int p0 = 1 + 8 * l;
        if (IN(p0 + 0)) DUP(2) { const Args a = launder(a_in); pg8::Gemm g{(const bf16_t*)(a.ws + WS_XA), (const bf16_t*)(a.ws + WS_WT_IN + l * SZ_WT_IN), MPAD, NPROJ, D}; pg8::StaticOrder S; S.init(MPAD, NPROJ, G, bid);
            EpiProj E{(bf16_t*)(a.ws + WS_PROJ)}; pg8::gemm_phase<EpiProj, pg8::StaticOrder, true, true>(lds, g, S, E, wave); }
        SEAM(p0 + 0);
        if (IN(p0 + 1)) DUP(3) { const Args a = launder(a_in); mlstm_phase(a, lds, wave, LANE()); __syncthreads(); }
        SEAM(p0 + 1);
        if (IN(p0 + 2)) DUP(4) { const Args a = launder(a_in); cat_phase(a, l, wave, LANE()); }
        SEAM(p0 + 2);
        if (IN(p0 + 3)) { const Args a = launder(a_in); pg8::Gemm g{(const bf16_t*)(a.ws + WS_XA), (const bf16_t*)(a.ws + WS_WT_OUT + l * SZ_WT_OUT), MPAD, D, D}; pg8::StaticOrder S; S.init(MPAD, D, G, bid);
            EpiResid E{a.out, (float*)(a.ws + WS_HMETA)}; pg8::gemm_phase<EpiResid, pg8::StaticOrder, true, true>(lds, g, S, E, wave); }
        SEAM(p0 + 3);
        if (IN(p0 + 4)) DUP(5) { const Args a = launder(a_in); norm_phase<2>(a, l, lds, wave, LANE()); }
        SEAM(p0 + 4);
        if (IN(p0 + 5)) DUP(6) { const Args a = launder(a_in); pg8::Gemm g{(const bf16_t*)(a.ws + WS_XA), (const bf16_t*)(a.ws + WS_WT_GU + l * SZ_WT_GU), MPAD, NGU, D}; pg8::StaticOrder S; S.init(MPAD, NGU, G, bid);
            EpiSwiglu E{(bf16_t*)(a.ws + WS_PROJ)}; pg8::gemm_phase<EpiSwiglu, pg8::StaticOrder, true, true>(lds, g, S, E, wave); }
        SEAM(p0 + 5);
        if (IN(p0 + 6)) { const Args a = launder(a_in); pg8::Gemm g{(const bf16_t*)(a.ws + WS_PROJ), (const bf16_t*)(a.ws + WS_WT_DN + l * SZ_WT_DN), MPAD, D, DFF}; pg8::StaticOrder S; S.init(MPAD, D, G, bid);
            EpiResid E{a.out, (float*)(a.ws + WS_HMETA)}; pg8::gemm_phase<EpiResid, pg8::StaticOrder, true, true>(lds, g, S, E, wave); }
        SEAM(p0 + 6);
        if (IN(p0 + 7)) { const Args a = launder(a_in); if (l == 0) { norm_phase<1>(a, 1, lds, wave, LANE()); __syncthreads(); } else norm_phase<3>(a, 0, lds, wave, LANE()); }
        if (l == 0) SEAM(p0 + 7);
    }
#undef IN
#undef SEAM
}

extern "C" void kernel_launch(void* const* d_in, const int* in_sizes, int n_in, void* d_out, int out_size, void* d_ws, size_t ws_size, hipStream_t stream) {
    static int grid = 0;
    if (grid == 0) {
        if (n_in != 13 || in_sizes[0] != MREAL * D || out_size != MREAL * D || ws_size < WS_END) {
            fprintf(stderr, "kernel_launch: unexpected shapes (n_in %d, in0 %d, out %d, ws %zu; need ws >= %zu); nothing launched\n", n_in, n_in > 0 ? in_sizes[0] : -1, out_size, ws_size, (size_t)WS_END); grid = -1; return; }
        int dev = 0, cus = 0, per_cu = 0;
        hipGetDevice(&dev); hipDeviceGetAttribute(&cus, hipDeviceAttributeMultiprocessorCount, dev);
        if (hipFuncSetAttribute((const void*)hymba_fwd, hipFuncAttributeMaxDynamicSharedMemorySize, LDS_BYTES) != hipSuccess) { fprintf(stderr, "kernel_launch: hipFuncSetAttribute failed\n"); grid = -1; return; }
        if (hipOccupancyMaxActiveBlocksPerMultiprocessor(&per_cu, (const void*)hymba_fwd, NTHREADS, LDS_BYTES) != hipSuccess || per_cu < 1) { fprintf(stderr, "kernel_launch: occupancy query says %d\n", per_cu); per_cu = 1; }
        (void)hipGetLastError();
        grid = cus * per_cu;
    }
    if (grid < 0) return;
    Args a{};
    a.x = (const float*)d_in[0]; a.meta = (const float*)d_in[1]; a.nmw = (const float*)d_in[2]; a.win = (const float*)d_in[3]; a.bg = (const float*)d_in[4]; a.cw = (const float*)d_in[5];
    a.mnw = (const float*)d_in[6]; a.wout = (const float*)d_in[7]; a.nfw = (const float*)d_in[8]; a.wg = (const float*)d_in[9]; a.wu = (const float*)d_in[10]; a.wd = (const float*)d_in[11]; a.nfin = (const float*)d_in[12];
    a.out = (float*)d_out; a.ws = (unsigned char*)d_ws;
#if MK_PER_PHASE
    for (int p = 0; p < N_PHASES; ++p) { a.ph_lo = p; a.ph_hi = p + 1; hipLaunchKernelGGL(hymba_fwd, dim3(grid), dim3(NTHREADS), LDS_BYTES, stream, a); }
#else
    a.ph_lo = 0; a.ph_hi = N_PHASES;
    if (hipMemsetAsync((char*)d_ws + WS_CTL, 0, CTL_BYTES, stream) != hipSuccess) { fprintf(stderr, "kernel_launch: memset failed\n"); return; }
    void* args[] = {&a};
    hipError_t e = hipLaunchCooperativeKernel((const void*)hymba_fwd, dim3(grid), dim3(NTHREADS), args, LDS_BYTES, stream);
    if (e != hipSuccess) fprintf(stderr, "kernel_launch: cooperative launch failed: %s (grid %d)\n", hipGetErrorString(e), grid);
#endif
}
```

```cpp
#include <hip/hip_runtime.h>
#include <hip/hip_cooperative_groups.h>
#include <cstdio>
#include <cstdint>
namespace cg = cooperative_groups;
namespace pg8 {
#define PG8_LAS __attribute__((address_space(3)))
typedef unsigned short bf16_t;
typedef short bf16x8 __attribute__((ext_vector_type(8)));
typedef float f32x4 __attribute__((ext_vector_type(4)));
typedef unsigned u32x4 __attribute__((ext_vector_type(4)));
constexpr int BM = 256, BK = 64, HALF = 128, HTB = HALF * BK * 2  , STAGE_BYTES = 8 * HTB, NXCD = 8, WGM = 8;

__host__ __device__ __forceinline__ int lds_byte(int r, int c) { const int st = (r >> 4) * 2 + (c >> 5), rr = r & 15, cc = c & 31, ob = rr * 64 + cc * 2; return st * 1024 + (ob ^ (((ob >> 9) & 1) << 5)); }
__host__ __device__ __forceinline__ void stage_rc(int b, int& R, int& C) { const int st = b / 1024, sb = b % 1024, swz = sb ^ (((sb >> 9) & 1) << 5); R = (st >> 1) * 16 + swz / 64; C = (st & 1) * 32 + (swz % 64) / 2; }
__host__ __device__ __forceinline__ int perm32(int rho) { const int n = rho >> 4, i = rho & 15; return 8 * (i >> 2) + 4 * n + (i & 3); }

struct Unit { int pm, pn; };
struct Gemm { const bf16_t* A; const bf16_t* Bt; int M, N, K; };

struct StaticOrder {
    int nM, nN, nwg, G, c;
    __host__ __device__ void init(int M, int N, int G_, int c_) { nM = M / BM; nN = N / BM; nwg = nM * nN; G = G_; c = c_; }
    __host__ __device__ bool next(int i, Unit& u) const {
        const long L = (long)i * G + c; if (L >= nwg) return false;
        int wgid = (int)L; { const int q = nwg / NXCD, r = nwg % NXCD, xcd = wgid % NXCD, off = wgid / NXCD; wgid = (xcd < r ? xcd * (q + 1) : r * (q + 1) + (xcd - r) * q) + off; }
        const int nig = WGM * nN, gid = wgid / nig, fm = gid * WGM, gsz = (nM - fm) < WGM ? (nM - fm) : WGM;
        u.pm = fm + ((wgid % nig) % gsz); u.pn = (wgid % nig) / gsz; return true;
    }
    __device__ __forceinline__ void a_ready(const Unit&) const {}
    __device__ __forceinline__ void done(const Unit&) const {}
};
__device__ __forceinline__ unsigned cvt_pk_bf16(float lo, float hi) { unsigned r; asm volatile("v_cvt_pk_bf16_f32 %0, %1, %2" : "=v"(r) : "v"(lo), "v"(hi)); return r; }
typedef float f32x2 __attribute__((ext_vector_type(2)));
template <class Epi, class Sched, bool ALIGN_EPI = false, bool SP2 = false>
__device__ __forceinline__ void gemm_phase(PG8_LAS unsigned char* lds, const Gemm g, const Sched& S, const Epi& E, const int wave_in) {
    int tid_; asm volatile("v_mbcnt_lo_u32_b32 %0, -1, 0\n\tv_mbcnt_hi_u32_b32 %0, -1, %0" : "=v"(tid_)); tid_ += wave_in * 64;
    const int tid = tid_, wid = __builtin_amdgcn_readfirstlane(tid >> 6), lane = tid & 63, wr = wid >> 2, wc = wid & 3, fr = lane & 15, fq = lane >> 4;
    const int K = g.K, nt = K / BK;
    unsigned voffA[2], voffB[2];
#pragma unroll
    for (int i = 0; i < 2; ++i) { int R, C; stage_rc(tid * 16 + i * 8192, R, C); const int Rb = Epi::PERM ? ((R & ~31) + perm32(R & 31)) : R;
        voffA[i] = (unsigned)(R * K + C) * 2u; voffB[i] = (unsigned)(Rb * K + C) * 2u; }
    const size_t kstep = (size_t)(BK * 2);
    const size_t hstep = (size_t)HALF * K * 2;
    const size_t tstep = 2 * hstep;
    const unsigned ldsw = (unsigned)wid * 1024u;
    const int aoff = lds_byte(wr * 64 + fr, fq * 8), boff = lds_byte(wc * 32 + fr, fq * 8);
#define PG8_SA(b, h) (((b) * 2 + (h)) * HTB)
#define PG8_SB(b, h) ((4 + (b) * 2 + (h)) * HTB)
#define PG8_STAGE(bufoff, gbase, voff) do { _Pragma("unroll") for (int _i = 0; _i < 2; ++_i) \
        __builtin_amdgcn_global_load_lds((const unsigned*)((const char*)(gbase) + (voff)[_i]), (PG8_LAS unsigned*)(lds + (bufoff) + ldsw + _i * 8192), 16, 0, 0); } while (0)
#define PG8_LDA(dst, b, h) do { _Pragma("unroll") for (int m = 0; m < 4; ++m) _Pragma("unroll") for (int k = 0; k < 2; ++k) dst[m][k] = *(const PG8_LAS bf16x8*)(lds + PG8_SA(b, h) + aoff + m * 2048 + k * 1024); } while (0)
#define PG8_LDB(dst, b, h) do { _Pragma("unroll") for (int n = 0; n < 2; ++n) _Pragma("unroll") for (int k = 0; k < 2; ++k) dst[n][k] = *(const PG8_LAS bf16x8*)(lds + PG8_SB(b, h) + boff + n * 2048 + k * 1024); } while (0)
#define PG8_MMA(ai, bj, At, Bt) do { __builtin_amdgcn_s_setprio(1); _Pragma("unroll") for (int m = 0; m < 4; ++m) _Pragma("unroll") for (int n = 0; n < 2; ++n) _Pragma("unroll") for (int k = 0; k < 2; ++k) \
        acc[ai][bj][m][n] = __builtin_amdgcn_mfma_f32_16x16x32_bf16(Bt[n][k], At[m][k], acc[ai][bj][m][n], 0, 0, 0); __builtin_amdgcn_s_setprio(0); } while (0)
#define PG8_WAIT_V(n) asm volatile("s_waitcnt vmcnt(" #n ")" ::: "memory")
#define PG8_WAIT_L(n) asm volatile("s_waitcnt lgkmcnt(" #n ")" ::: "memory")
#define PG8_BAR __builtin_amdgcn_s_barrier()
#define PG8_SCHED __builtin_amdgcn_sched_barrier(0)
    Unit cur, nxt; int ui = 0;
    if (!S.next(0, cur)) return;
    f32x4 acc[2][2][4][2];
#pragma unroll
    for (int a = 0; a < 2; ++a)
#pragma unroll
        for (int b = 0; b < 2; ++b)
#pragma unroll
            for (int m = 0; m < 4; ++m)
#pragma unroll
                for (int n = 0; n < 2; ++n) acc[a][b][m][n] = (f32x4){0.f, 0.f, 0.f, 0.f};
    bf16x8 At[4][2], B0[2][2], B1[2][2];
    const char* cA = (const char*)g.A + (size_t)cur.pm * tstep; const char* cB = (const char*)g.Bt + (size_t)cur.pn * tstep;
    S.a_ready(cur);
    if constexpr (SP2) {
        PG8_STAGE(PG8_SB(0, 0), cB, voffB); PG8_STAGE(PG8_SB(0, 1), cB + hstep, voffB); PG8_STAGE(PG8_SA(0, 0), cA, voffA); PG8_STAGE(PG8_SA(0, 1), cA + hstep, voffA);
        if (wr == 1) PG8_BAR;
        PG8_WAIT_V(2); PG8_BAR;
        PG8_STAGE(PG8_SB(1, 0), cB + kstep, voffB); PG8_STAGE(PG8_SA(1, 0), cA + kstep, voffA); PG8_STAGE(PG8_SB(1, 1), cB + hstep + kstep, voffB);
        PG8_WAIT_V(6); PG8_BAR;
    } else {
        PG8_STAGE(PG8_SB(0, 0), cB, voffB); PG8_STAGE(PG8_SA(0, 0), cA, voffA); PG8_STAGE(PG8_SB(0, 1), cB + hstep, voffB); PG8_STAGE(PG8_SA(0, 1), cA + hstep, voffA);
        if (wr == 1) PG8_BAR;
        PG8_WAIT_V(4); PG8_BAR;
        PG8_STAGE(PG8_SB(1, 0), cB + kstep, voffB); PG8_STAGE(PG8_SA(1, 0), cA + kstep, voffA); PG8_STAGE(PG8_SB(1, 1), cB + hstep + kstep, voffB);
        PG8_WAIT_V(6); PG8_BAR;
    }
    for (;;) {
        const bool has_next = S.next(ui + 1, nxt);
        const char* nA = has_next ? (const char*)g.A + (size_t)nxt.pm * tstep : cA; const char* nB = has_next ? (const char*)g.Bt + (size_t)nxt.pn * tstep : cB;
        for (int t = 0; t < nt; t += 2) {
            const bool last = (t == nt - 2);
            const char* a1 = cA + (size_t)(t + 1) * kstep;
            const char* a2 = last ? nA : cA + (size_t)(t + 2) * kstep; const char* b2 = last ? nB : cB + (size_t)(t + 2) * kstep;
            const char* a3 = a2 + kstep; const char* b3 = b2 + kstep;
            if (last && has_next) S.a_ready(nxt);
            if constexpr (SP2) {
            PG8_LDB(B0, 0, 0); PG8_LDB(B1, 0, 1); PG8_SCHED; PG8_LDA(At, 0, 0); PG8_STAGE(PG8_SA(1, 1), a1 + hstep, voffA);
            PG8_WAIT_V(8); PG8_WAIT_L(0); PG8_BAR; PG8_MMA(0, 0, At, B0); PG8_MMA(0, 1, At, B1); PG8_BAR; PG8_SCHED;
            PG8_LDA(At, 0, 1); PG8_STAGE(PG8_SB(0, 0), b2, voffB); PG8_STAGE(PG8_SB(0, 1), b2 + hstep, voffB); PG8_STAGE(PG8_SA(0, 0), a2, voffA);
            PG8_WAIT_V(8); PG8_WAIT_L(0); PG8_BAR; PG8_MMA(1, 0, At, B0); PG8_MMA(1, 1, At, B1); PG8_BAR; PG8_SCHED;
            PG8_LDB(B0, 1, 0); PG8_LDB(B1, 1, 1); PG8_SCHED; PG8_LDA(At, 1, 0); PG8_STAGE(PG8_SA(0, 1), a2 + hstep, voffA);
            PG8_WAIT_V(8); PG8_WAIT_L(0); PG8_BAR; PG8_MMA(0, 0, At, B0); PG8_MMA(0, 1, At, B1); PG8_BAR; PG8_SCHED;
            PG8_LDA(At, 1, 1); PG8_STAGE(PG8_SB(1, 0), b3, voffB); PG8_STAGE(PG8_SB(1, 1), b3 + hstep, voffB); PG8_STAGE(PG8_SA(1, 0), a3, voffA);
            PG8_WAIT_V(8); PG8_WAIT_L(0); PG8_BAR; PG8_MMA(1, 0, At, B0); PG8_MMA(1, 1, At, B1); PG8_BAR; PG8_SCHED;
            } else {
            PG8_LDB(B0, 0, 0); PG8_SCHED; PG8_LDA(At, 0, 0); PG8_STAGE(PG8_SA(1, 1), a1 + hstep, voffA);
            PG8_WAIT_L(8); PG8_BAR; PG8_WAIT_L(0); PG8_MMA(0, 0, At, B0); PG8_BAR; PG8_SCHED;
            PG8_LDB(B1, 0, 1); PG8_STAGE(PG8_SB(0, 0), b2, voffB);
            PG8_BAR; PG8_WAIT_L(0); PG8_MMA(0, 1, At, B1); PG8_BAR;
            PG8_LDA(At, 0, 1); PG8_STAGE(PG8_SA(0, 0), a2, voffA);
            PG8_BAR; PG8_WAIT_L(0); PG8_MMA(1, 0, At, B0); PG8_BAR; PG8_SCHED;
            PG8_STAGE(PG8_SB(0, 1), b2 + hstep, voffB);
            PG8_WAIT_V(6); PG8_BAR; PG8_MMA(1, 1, At, B1); PG8_BAR;
            PG8_LDB(B0, 1, 0); PG8_SCHED; PG8_LDA(At, 1, 0); PG8_STAGE(PG8_SA(0, 1), a2 + hstep, voffA);
            PG8_WAIT_L(8); PG8_BAR; PG8_WAIT_L(0); PG8_MMA(0, 0, At, B0); PG8_BAR; PG8_SCHED;
            PG8_LDB(B1, 1, 1); PG8_STAGE(PG8_SB(1, 0), b3, voffB);
            PG8_BAR; PG8_WAIT_L(0); PG8_MMA(0, 1, At, B1); PG8_BAR;
            PG8_LDA(At, 1, 1); PG8_STAGE(PG8_SA(1, 0), a3, voffA);
            PG8_BAR; PG8_WAIT_L(0); PG8_MMA(1, 0, At, B0); PG8_BAR; PG8_SCHED;
            PG8_STAGE(PG8_SB(1, 1), b3 + hstep, voffB);
            PG8_WAIT_V(6); PG8_BAR; PG8_MMA(1, 1, At, B1); PG8_BAR;
            }
        }
        if constexpr (ALIGN_EPI) { if (wr == 0) PG8_BAR; }
        if constexpr (!Epi::AFTER_DRAIN) { E(acc, cur, wr, wc, fr, fq); S.done(cur); }
        if (!has_next) break;
#pragma unroll
        for (int a = 0; a < 2; ++a)
#pragma unroll
            for (int b = 0; b < 2; ++b)
#pragma unroll
                for (int m = 0; m < 4; ++m)
#pragma unroll
                    for (int n = 0; n < 2; ++n) acc[a][b][m][n] = (f32x4){0.f, 0.f, 0.f, 0.f};
        cur = nxt; cA = nA; cB = nB; ++ui;
        if constexpr (ALIGN_EPI) { if (wr == 1) PG8_BAR; }
    }
    PG8_WAIT_V(0);
    if constexpr (!ALIGN_EPI) { if (wr == 0) PG8_BAR; }
    PG8_BAR;
    if constexpr (Epi::AFTER_DRAIN) { E.fused(acc, cur, wr, wc, fr, fq, lds, wid, lane); S.done(cur); }
#undef PG8_SA
#undef PG8_SB
#undef PG8_STAGE
#undef PG8_LDA
#undef PG8_LDB
#undef PG8_MMA
#undef PG8_WAIT_V
#undef PG8_WAIT_L
#undef PG8_BAR
#undef PG8_SCHED
}
}

#define LAS __attribute__((address_space(3)))
typedef unsigned short bf16_t;
typedef short bf16x8 __attribute__((ext_vector_type(8)));
typedef short s16x4 __attribute__((ext_vector_type(4)));
typedef float f32x4 __attribute__((ext_vector_type(4)));
typedef unsigned u32x4 __attribute__((ext_vector_type(4)));
typedef unsigned u32x2 __attribute__((ext_vector_type(2)));

constexpr int D = 2048, NB = 8, SEQ = 2048, NMETA = 16, NHEAD = 4, DV = 256, DQK = 128;
constexpr int MREAL = NB * SEQ;
constexpr int MMETA = NB * NMETA;
constexpr int MTOT = MREAL + MMETA;
constexpr int MPAD = 16640;
constexpr int DIN = 6152, NPROJ = 6144, DFF = 5632, NGU = 2 * DFF;
constexpr int C_Q = 0, C_K = 512, C_V = 1024, C_OG = 2048, C_U = 3072, C_GB = 4096, C_GC = 5120;
constexpr float EPS = 1e-6f, GATE_CAP = 15.0f;
constexpr int NCHUNK = 33;

constexpr size_t MiB = 1u << 20;
constexpr size_t SZ_WT_IN = (size_t)NPROJ * D * 2, SZ_WT_OUT = (size_t)D * D * 2, SZ_WT_GU = (size_t)NGU * D * 2, SZ_WT_DN = (size_t)D * DFF * 2;
constexpr size_t WS_WT_IN = 0, WS_WT_OUT = 48 * MiB, WS_WT_GU = 64 * MiB, WS_WT_DN = 152 * MiB;
constexpr size_t WS_XA = 196 * MiB;
constexpr size_t WS_PROJ = 261 * MiB;
constexpr size_t WS_NUM = 456 * MiB;
constexpr size_t WS_HMETA = 489 * MiB;
constexpr size_t WS_LI = 491 * MiB, WS_LF = WS_LI + MiB / 2, WS_DEN = 492 * MiB, WS_MT = WS_DEN + MiB / 2;
constexpr size_t WS_CTL = 493 * MiB, CTL_BYTES = 65536;
constexpr size_t WS_END = 494 * MiB;
static_assert(2 * SZ_WT_IN <= WS_WT_OUT - WS_WT_IN && 2 * SZ_WT_OUT <= WS_WT_GU - WS_WT_OUT && 2 * SZ_WT_GU <= WS_WT_DN - WS_WT_GU && 2 * SZ_WT_DN <= WS_XA - WS_WT_DN, "ws map");
static_assert((size_t)MPAD * D * 2 <= WS_PROJ - WS_XA && (size_t)MPAD * NPROJ * 2 <= WS_NUM - WS_PROJ && (size_t)MPAD * 1024 * 2 <= WS_HMETA - WS_NUM, "ws map");

constexpr int LDS_BYTES = 147456;
constexpr int NWAVES = 8, NTHREADS = 512;

__device__ __forceinline__ unsigned cvt_pk(float lo, float hi) { unsigned r; asm volatile("v_cvt_pk_bf16_f32 %0, %1, %2" : "=v"(r) : "v"(lo), "v"(hi)); return r; }
__device__ __forceinline__ float bf2f(unsigned short b) { return __uint_as_float(((unsigned)b) << 16); }
__device__ __forceinline__ float bflo(unsigned w) { return __uint_as_float(w << 16); }
__device__ __forceinline__ float bfhi(unsigned w) { return __uint_as_float(w & 0xffff0000u); }
__device__ __forceinline__ float wave_sum(float v) {
#pragma unroll
    for (int o = 1; o < 64; o <<= 1) v += __shfl_xor(v, o);
    return v;
}
__device__ __forceinline__ float wave_max(float v) {
#pragma unroll
    for (int o = 1; o < 64; o <<= 1) v = fmaxf(v, __shfl_xor(v, o));
    return v;
}

struct Args {
    const float *x, *meta, *nmw, *win, *bg, *cw, *mnw, *wout, *nfw, *wg, *wu, *wd, *nfin;
    float* out; unsigned char* ws; int ph_lo, ph_hi;
};
static_assert(sizeof(Args) == 15 * 8 + 8, "Args has no padding");

#define GAS __attribute__((address_space(1)))
struct PArgs {
    const GAS float *x, *meta, *nmw, *win, *bg, *cw, *mnw, *wout, *nfw, *wg, *wu, *wd, *nfin;
    GAS float* out; GAS unsigned char* ws;
};
__device__ __forceinline__ GAS float* hrow(const PArgs& a, int m) { return m < MREAL ? a.out + (size_t)m * D : (GAS float*)(a.ws + WS_HMETA) + (size_t)(m - MREAL) * D; }

struct EpiProj {
    static constexpr bool PERM = true, AFTER_DRAIN = false;
    GAS bf16_t* O;
    __device__ __forceinline__ void operator()(const f32x4 (&acc)[2][2][4][2], const pg8::Unit& u, int wr, int wc, int fr, int fq) const {
        const int row0 = u.pm * 256 + wr * 64 + fr, colt = u.pn * 256;
        const float sc = (colt < C_K) ? 0.08838834764831845f : 1.0f;
        const int col0 = colt + wc * 32 + 8 * fq;
#pragma unroll
        for (int ai = 0; ai < 2; ++ai)
#pragma unroll
            for (int m = 0; m < 4; ++m) { GAS bf16_t* rowp = O + (size_t)(row0 + ai * 128 + m * 16) * NPROJ + col0;
#pragma unroll
                for (int bj = 0; bj < 2; ++bj) { const f32x4 v0 = acc[ai][bj][m][0] * sc, v1 = acc[ai][bj][m][1] * sc;
                    u32x4 w; w.x = cvt_pk(v0[0], v0[1]); w.y = cvt_pk(v0[2], v0[3]); w.z = cvt_pk(v1[0], v1[1]); w.w = cvt_pk(v1[2], v1[3]);
                    *(GAS u32x4*)(rowp + bj * 128) = w; } }
    }
};
struct EpiResid {
    static constexpr bool PERM = false, AFTER_DRAIN = false;
    GAS float* out; GAS float* hmeta;
    __device__ __forceinline__ void operator()(const f32x4 (&acc)[2][2][4][2], const pg8::Unit& u, int wr, int wc, int fr, int fq) const {
        GAS float* hb = (u.pm < MREAL / 256) ? out + (size_t)u.pm * 256 * D : hmeta;
        const int r0 = wr * 64 + fr, col0 = u.pn * 256 + wc * 32 + 4 * fq;
#pragma unroll
        for (int ai = 0; ai < 2; ++ai)
#pragma unroll
            for (int m = 0; m < 4; ++m) { GAS float* rowp = hb + (size_t)(r0 + ai * 128 + m * 16) * D + col0;
                f32x4 old[2][2];
#pragma unroll
                for (int bj = 0; bj < 2; ++bj)
#pragma unroll
                    for (int n = 0; n < 2; ++n) old[bj][n] = *(const GAS f32x4*)(rowp + bj * 128 + n * 16);
#pragma unroll
                for (int bj = 0; bj < 2; ++bj)
#pragma unroll
                    for (int n = 0; n < 2; ++n) *(GAS f32x4*)(rowp + bj * 128 + n * 16) = old[bj][n] + acc[ai][bj][m][n];
            }
    }
};
struct EpiSwiglu {
    static constexpr bool PERM = true, AFTER_DRAIN = false;
    GAS bf16_t* O;
    __device__ __forceinline__ void operator()(const f32x4 (&acc)[2][2][4][2], const pg8::Unit& u, int wr, int wc, int fr, int fq) const {
        const int row0 = u.pm * 256 + wr * 64 + fr, col0 = u.pn * 128 + wc * 32 + 8 * fq;
#pragma unroll
        for (int ai = 0; ai < 2; ++ai)
#pragma unroll
            for (int m = 0; m < 4; ++m) { GAS bf16_t* rowp = O + (size_t)(row0 + ai * 128 + m * 16) * DFF + col0;
                float r[8];
#pragma unroll
                for (int n = 0; n < 2; ++n)
#pragma unroll
                    for (int j = 0; j < 4; ++j) { const float g = acc[ai][0][m][n][j], up = acc[ai][1][m][n][j]; r[n * 4 + j] = g * up * __builtin_amdgcn_rcpf(1.0f + __expf(-g)); }
                u32x4 w; w.x = cvt_pk(r[0], r[1]); w.y = cvt_pk(r[2], r[3]); w.z = cvt_pk(r[4], r[5]); w.w = cvt_pk(r[6], r[7]);
                *(GAS u32x4*)rowp = w; }
    }
};

#define RLX_AGENT __ATOMIC_RELAXED, __HIP_MEMORY_SCOPE_AGENT
#define XB_TMO      128
#define XB_XCNT(j)  (256  + 64 * (j))
#define XB_XSUB(j)  (1280 + 64 * (j))
#define XB_XGEN(j)  (2304 + 64 * (j))
#define XB_TOP      3328
#define XB_TOPGEN   3392
#define XCD_BAR_WORDS 3456
#define XB_SPIN_CAP (1u << 18)

__device__ __forceinline__ unsigned xb_ld(unsigned* p)              { return __hip_atomic_load(p, __ATOMIC_RELAXED, __HIP_MEMORY_SCOPE_AGENT); }
__device__ __forceinline__ unsigned xb_add(unsigned* p, unsigned v) { return __hip_atomic_fetch_add(p, v, __ATOMIC_RELAXED, __HIP_MEMORY_SCOPE_AGENT); }
__device__ __forceinline__ unsigned xb_xcc_id() { return (unsigned)__builtin_amdgcn_s_getreg((3 << 11) | 20) & 0xFu; }
#define XB_SPIN(cond, bar) do { unsigned _sp = 0; while (cond) { __builtin_amdgcn_s_sleep(1); \
    if ((++_sp & 255u) == 0u) { if (xb_ld(&(bar)[XB_TMO])) break; if (_sp > XB_SPIN_CAP) { atomicAdd(&(bar)[XB_TMO], 1u); break; } } } } while (0)

struct XcdBarrier {
    unsigned* bar; unsigned x;
    volatile LAS unsigned* st;
};

__device__ __forceinline__ XcdBarrier xcd_barrier_post(unsigned* bar, volatile LAS unsigned* st) {
    XcdBarrier b; b.bar = bar; b.x = xb_xcc_id(); b.st = st;
    if (threadIdx.x == 0) (void)xb_add(&bar[XB_XCNT(b.x)], 1u);
    return b;
}
__device__ __forceinline__ void xcd_barrier_complete(unsigned* bar, unsigned x, unsigned& nloc, unsigned& nx) {
    const unsigned G = gridDim.x * gridDim.y * gridDim.z;
    unsigned sum, cnt, mine, sp = 0u;
    for (;;) {
        sum = 0u; cnt = 0u; mine = 0u;
#pragma unroll
        for (unsigned j = 0; j < 16; ++j) { const unsigned c = xb_ld(&bar[XB_XCNT(j)]); sum += c; cnt += (c > 0u) ? 1u : 0u; mine = (j == x) ? c : mine; }
        if (sum == G) break;
        __builtin_amdgcn_s_sleep(1);
        if ((++sp & 255u) == 0u) { if (xb_ld(&bar[XB_TMO])) break; if (sp > XB_SPIN_CAP) { atomicAdd(&bar[XB_TMO], 1u); break; } }
    }
    nloc = mine > 0u ? mine : 1u; nx = cnt > 0u ? cnt : 1u;
}

__device__ __forceinline__ void xcd_barrier(const XcdBarrier& b) {
    asm volatile("s_waitcnt vmcnt(0)" ::: "memory");
    __syncthreads();
    if (threadIdx.x == 0) {
        unsigned* bar = b.bar;
        __builtin_amdgcn_s_waitcnt(0);
        unsigned nloc = b.st[0], nx = b.st[1];
        if (nloc == 0u) { xcd_barrier_complete(bar, b.x, nloc, nx); b.st[0] = nloc; b.st[1] = nx; }
        const unsigned old = xb_add(&bar[XB_XSUB(b.x)], 1u);
        const unsigned gen = old / nloc;
        if (old + 1u == (gen + 1u) * nloc) {
            __builtin_amdgcn_fence(__ATOMIC_RELEASE, "agent");
            asm volatile("s_waitcnt vmcnt(0)" ::: "memory");
            const unsigned og = xb_add(&bar[XB_TOP], 1u);
            const unsigned tg = og / nx;
            if (og + 1u == (tg + 1u) * nx) xb_add(&bar[XB_TOPGEN], 1u);
            else XB_SPIN(xb_ld(&bar[XB_TOPGEN]) == tg, bar);
            __builtin_amdgcn_fence(__ATOMIC_ACQUIRE, "agent");
            xb_add(&bar[XB_XGEN(b.x)], 1u);
            asm volatile("s_waitcnt vmcnt(0)" ::: "memory");
        } else {
            XB_SPIN(xb_ld(&bar[XB_XGEN(b.x)]) == gen, bar);
            __builtin_amdgcn_fence(__ATOMIC_ACQUIRE, "agent");
            asm volatile("s_waitcnt vmcnt(0)" ::: "memory");
        }
    }
    __syncthreads();
}


__device__ __forceinline__ void tr_item(const GAS float* W, int ldw, int k0, int src_n0, GAS bf16_t* WT, int K, int dst_row0, LAS float* scr, int lane) {
#pragma unroll 8
    for (int i = 0; i < 32; ++i) { const int kk = 2 * i + (lane >> 5); scr[kk * 33 + (lane & 31)] = W[(size_t)(k0 + kk) * ldw + src_n0 + (lane & 31)]; }
    asm volatile("s_waitcnt lgkmcnt(0)" ::: "memory");
    const int c = lane & 7;
#pragma unroll
    for (int j = 0; j < 4; ++j) { const int n = (lane >> 3) + 8 * j; const LAS float* s = scr + (8 * c) * 33 + n;
        u32x4 o; o.x = cvt_pk(s[0 * 33], s[1 * 33]); o.y = cvt_pk(s[2 * 33], s[3 * 33]); o.z = cvt_pk(s[4 * 33], s[5 * 33]); o.w = cvt_pk(s[6 * 33], s[7 * 33]);
        *(GAS u32x4*)(WT + (size_t)(dst_row0 + n) * K + k0 + 8 * c) = o; }
    asm volatile("s_waitcnt lgkmcnt(0)" ::: "memory");
}
__device__ __forceinline__ void weights_phase(const PArgs& a, LAS unsigned char* lds, int wave, int lane) {
    LAS float* scr = (LAS float*)(lds + wave * 16384);
    const int gw = blockIdx.x * NWAVES + wave, NGW = gridDim.x * NWAVES;
    constexpr int I_IN = 32 * 192, I_OUT = 32 * 64, I_G = 32 * 176, I_DN = 88 * 64, I_LAYER = I_IN + I_OUT + 2 * I_G + I_DN;
    for (int it = gw; it < 2 * I_LAYER; it += NGW) {
        const int l = it / I_LAYER; int r = it - l * I_LAYER;
        if (r < I_IN) { const int kb = r / 192, nb = r % 192, d0 = nb * 32; tr_item(a.win + (size_t)l * D * DIN, DIN, kb * 64, d0 + (d0 >= 3072 ? 8 : 0), (GAS bf16_t*)(a.ws + WS_WT_IN + l * SZ_WT_IN), D, d0, scr, lane); continue; } r -= I_IN;
        if (r < I_OUT) { const int kb = r / 64, nb = r % 64; tr_item(a.wout + (size_t)l * D * D, D, kb * 64, nb * 32, (GAS bf16_t*)(a.ws + WS_WT_OUT + l * SZ_WT_OUT), D, nb * 32, scr, lane); continue; } r -= I_OUT;
        if (r < I_G) { const int kb = r / 176, nb = r % 176, n0 = nb * 32; tr_item(a.wg + (size_t)l * D * DFF, DFF, kb * 64, n0, (GAS bf16_t*)(a.ws + WS_WT_GU + l * SZ_WT_GU), D, (n0 >> 7) * 256 + (n0 & 127), scr, lane); continue; } r -= I_G;
        if (r < I_G) { const int kb = r / 176, nb = r % 176, n0 = nb * 32; tr_item(a.wu + (size_t)l * D * DFF, DFF, kb * 64, n0, (GAS bf16_t*)(a.ws + WS_WT_GU + l * SZ_WT_GU), D, (n0 >> 7) * 256 + 128 + (n0 & 127), scr, lane); continue; } r -= I_G;
        { const int kb = r / 64, nb = r % 64; tr_item(a.wd + (size_t)l * DFF * D, D, kb * 64, nb * 32, (GAS bf16_t*)(a.ws + WS_WT_DN + l * SZ_WT_DN), DFF, nb * 32, scr, lane); }
    }
}

template <int MODE>
__device__ __forceinline__ void norm_phase(const PArgs& a, int layer, LAS unsigned char* lds, int wave, int lane) {
    const GAS float* nw = MODE <= 1 ? a.nmw + layer * D : (MODE == 2 ? a.nfw + layer * D : a.nfin);
    LAS float* WG = (LAS float*)lds;
    if (MODE <= 1) {
        const GAS float* wsrc = a.win + (size_t)layer * D * DIN + 3072;
        for (int k = wave * 64 + lane; k < D; k += NTHREADS) { const f32x4 g0 = *(const GAS f32x4*)(wsrc + (size_t)k * DIN), g1 = *(const GAS f32x4*)(wsrc + (size_t)k * DIN + 4);
            WG[0 * D + k] = g0[0]; WG[1 * D + k] = g0[1]; WG[2 * D + k] = g0[2]; WG[3 * D + k] = g0[3]; WG[4 * D + k] = g1[0]; WG[5 * D + k] = g1[1]; WG[6 * D + k] = g1[2]; WG[7 * D + k] = g1[3]; }
        __syncthreads();
    }
    GAS bf16_t* XA = (GAS bf16_t*)(a.ws + WS_XA); GAS float* LI = (GAS float*)(a.ws + WS_LI); GAS float* LF = (GAS float*)(a.ws + WS_LF);
    const int gw = blockIdx.x * NWAVES + wave, NGW = gridDim.x * NWAVES;
    f32x4 w[8];
#pragma unroll
    for (int j = 0; j < 8; ++j) w[j] = *((const GAS f32x4*)nw + lane + 64 * j);
    for (int m = gw; m < (MODE == 3 ? MREAL : MTOT); m += NGW) {
        const GAS float* src = MODE == 0 ? (m < MREAL ? a.x + (size_t)m * D : a.meta + (size_t)((m - MREAL) & 15) * D) : hrow(a, m);
        f32x4 v[8]; float ss = 0.f;
#pragma unroll
        for (int j = 0; j < 8; ++j) { v[j] = *((const GAS f32x4*)src + lane + 64 * j); ss += (v[j][0] * v[j][0] + v[j][1] * v[j][1]) + (v[j][2] * v[j][2] + v[j][3] * v[j][3]); }
        if (MODE == 0) { GAS float* hp = hrow(a, m);
#pragma unroll
            for (int j = 0; j < 8; ++j) *((GAS f32x4*)hp + lane + 64 * j) = v[j]; }
        const float rstd = rsqrtf(wave_sum(ss) * (1.0f / D) + EPS);
#pragma unroll
        for (int j = 0; j < 8; ++j) v[j] = v[j] * rstd * w[j];
        if (MODE == 3) { GAS float* op = a.out + (size_t)m * D;
#pragma unroll
            for (int j = 0; j < 8; ++j) *((GAS f32x4*)op + lane + 64 * j) = v[j];
        } else { GAS bf16_t* op = XA + (size_t)m * D;
#pragma unroll
            for (int j = 0; j < 8; ++j) { u32x2 o; o.x = cvt_pk(v[j][0], v[j][1]); o.y = cvt_pk(v[j][2], v[j][3]); *((GAS u32x2*)op + lane + 64 * j) = o; } }
        if (MODE <= 1) {
            float mine = 0.f;
#pragma unroll
            for (int g = 0; g < 8; ++g) { float s = 0.f;
#pragma unroll
                for (int j = 0; j < 8; ++j) { const f32x4 wg = *((const LAS f32x4*)(WG + g * D) + lane + 64 * j); s += (v[j][0] * wg[0] + v[j][1] * wg[1]) + (v[j][2] * wg[2] + v[j][3] * wg[3]); }
                s = wave_sum(s); mine = (lane == g) ? s : mine; }
            if (lane < 8) { const float raw = mine + a.bg[layer * 8 + lane]; const float e2 = __expf(raw * (2.0f / GATE_CAP)); const float cp = GATE_CAP * (e2 - 1.0f) / (e2 + 1.0f);
                if (lane < 4) LI[m * 4 + lane] = cp; else LF[m * 4 + lane - 4] = fminf(cp, 0.f) - __logf(1.0f + __expf(-fabsf(cp))); }
        }
    }
}

__device__ __forceinline__ bf16x8 pack8(const f32x4& x, const f32x4& y) {
    u32x4 w; w.x = cvt_pk(x[0], x[1]); w.y = cvt_pk(x[2], x[3]); w.z = cvt_pk(y[0], y[1]); w.w = cvt_pk(y[2], y[3]); return __builtin_bit_cast(bf16x8, w);
}
typedef short v4i16_t __attribute__((ext_vector_type(4)));
__device__ __forceinline__ s16x4 lds_tr(LAS unsigned char* p) { return __builtin_bit_cast(s16x4, __builtin_amdgcn_ds_read_tr16_b64_v4i16((LAS v4i16_t*)p)); }
#define MFMA16(x, y, c) __builtin_amdgcn_mfma_f32_16x16x32_bf16((x), (y), (c), 0, 0, 0)
constexpr int KIMG_STRIDE = 288, KIMG_BYTES = 64 * KIMG_STRIDE, MWAVE_BYTES = 2 * KIMG_BYTES + 1024;
constexpr int MLSTM_WAVES = 3;

__device__ __forceinline__ void mlstm_item(const PArgs& a, int bh, int sl, LAS unsigned char* kbase, int lane_in) {
    const GAS bf16_t* proj = (const GAS bf16_t*)(a.ws + WS_PROJ);
    const GAS float* LI = (const GAS float*)(a.ws + WS_LI); const GAS float* LF = (const GAS float*)(a.ws + WS_LF);
    GAS bf16_t* NUM = (GAS bf16_t*)(a.ws + WS_NUM); GAS float* DEN = (GAS float*)(a.ws + WS_DEN); GAS float* MT = (GAS float*)(a.ws + WS_MT);
    LAS float* sc = (LAS float*)(kbase + 2 * KIMG_BYTES);
    const int b = bh >> 2, hd = bh & 3;
    const bool den_item = (sl == 16);
    int lane = lane_in; asm volatile("" : "+v"(lane));
    int fr = lane & 15, fq = lane >> 4;
    int vcol = C_V + hd * 256 + (den_item ? 0 : sl * 16) + fr;
    f32x4 C[8];
#pragma unroll
    for (int i = 0; i < 8; ++i) C[i] = (f32x4){0.f, 0.f, 0.f, 0.f};
    float m_st = 0.f;
#define ROWOF(cc, p) ((cc) == 0 ? (MREAL + b * 16 + ((p) < 48 ? 0 : (p) - 48)) : (b * SEQ + ((cc) - 1) * 64 + (p)))
    unsigned vpre[8]; float lfpre, lipre; bf16x8 qpre[4];
#define K_DMA(cc, buf) do { LAS unsigned char* kd_ = kbase + (buf) * KIMG_BYTES; \
        _Pragma("unroll") for (int j = 0; j < 18; ++j) { const int g_ = j * 64 + lane, row_ = g_ / 18, col_ = g_ - row_ * 18; \
            const GAS bf16_t* src_ = proj + (size_t)ROWOF(cc, row_) * NPROJ + C_K + hd * 128 + (col_ < 16 ? col_ : 15) * 8; \
            __builtin_amdgcn_global_load_lds((const GAS unsigned*)src_, (LAS unsigned*)(kd_ + j * 1024), 16, 0, 0); } } while (0)
#define LOAD_CHUNK(cc) do { \
        _Pragma("unroll") for (int i = 0; i < 8; ++i) { const int s0_ = 32 * (i >> 2) + 16 * ((i >> 1) & 1) + 4 * fq + 2 * (i & 1); \
            const unsigned lo_ = den_item ? 0u : (unsigned)proj[(size_t)ROWOF(cc, s0_) * NPROJ + vcol], hi_ = den_item ? 0u : (unsigned)proj[(size_t)ROWOF(cc, s0_ + 1) * NPROJ + vcol]; vpre[i] = lo_ | (hi_ << 16); } \
        { const int rl_ = ROWOF(cc, lane); lfpre = LF[rl_ * 4 + hd]; lipre = LI[rl_ * 4 + hd]; } } while (0)
#define LOAD_Q(cc, tb_) do { const GAS bf16_t* rp_ = proj + (size_t)ROWOF(cc, (tb_) * 16 + fr) * NPROJ + C_Q + hd * 128 + fq * 4; \
        _Pragma("unroll") for (int kc = 0; kc < 4; ++kc) { const s16x4 lo_ = *(const GAS s16x4*)(rp_ + 32 * kc), hi_ = *(const GAS s16x4*)(rp_ + 32 * kc + 16); qpre[kc] = __builtin_shufflevector(lo_, hi_, 0, 1, 2, 3, 4, 5, 6, 7); } } while (0)
    K_DMA(0, 0); LOAD_CHUNK(0); LOAD_Q(0, 0);
    asm volatile("s_waitcnt vmcnt(0)" ::: "memory");
#pragma unroll 1
    for (int c = 0; c < NCHUNK; ++c) {
        const int cn = c + 1 < NCHUNK ? c + 1 : c;
        asm volatile("" : "+v"(lane)); fr = lane & 15; fq = lane >> 4; vcol = C_V + hd * 256 + (den_item ? 0 : sl * 16) + fr;
        float w_old, m_new;
        {
            float lf = lfpre, li = lipre;
            if (c == 0 && lane < 48) { lf = 0.f; li = -1e30f; }
            float bc = lf;
#pragma unroll
            for (int o = 1; o < 64; o <<= 1) { const float t = __shfl_up(bc, o); bc += (lane >= o) ? t : 0.f; }
            const float b_end = __shfl(bc, 63);
            const float decay = b_end - bc + li;
            m_new = fmaxf(b_end + m_st, wave_max(decay));
            w_old = __expf(b_end + m_st - m_new);
            sc[lane] = li - bc; sc[64 + lane] = __expf(decay - m_new); sc[128 + lane] = bc;
        }
        LAS unsigned char* kimg = kbase + (c & 1) * KIMG_BYTES;
        K_DMA(cn, (c + 1) & 1);
        unsigned vraw[8];
#pragma unroll
        for (int i = 0; i < 8; ++i) vraw[i] = vpre[i];
        asm volatile("s_waitcnt lgkmcnt(0)" ::: "memory");
        LOAD_CHUNK(cn);
        bf16x8 vf[2], wvf[2];
#pragma unroll
        for (int ks = 0; ks < 2; ++ks) { float vv[8]; u32x4 vw;
#pragma unroll
            for (int h = 0; h < 2; ++h) { const f32x4 wi = *(const LAS f32x4*)(sc + 64 + 32 * ks + 16 * h + 4 * fq);
                unsigned w0 = vraw[4 * ks + 2 * h], w1 = vraw[4 * ks + 2 * h + 1];
                if (den_item) { w0 = w1 = (fr == 0) ? 0x3F803F80u : 0u; }
                vw[2 * h] = w0; vw[2 * h + 1] = w1;
                vv[4 * h + 0] = bflo(w0) * wi[0]; vv[4 * h + 1] = bfhi(w0) * wi[1]; vv[4 * h + 2] = bflo(w1) * wi[2]; vv[4 * h + 3] = bfhi(w1) * wi[3]; }
            vf[ks] = __builtin_bit_cast(bf16x8, vw);
            wvf[ks] = pack8((f32x4){vv[0], vv[1], vv[2], vv[3]}, (f32x4){vv[4], vv[5], vv[6], vv[7]}); }
        bf16x8 cf[4];
#pragma unroll
        for (int kc = 0; kc < 4; ++kc) cf[kc] = pack8(C[2 * kc], C[2 * kc + 1]);
#pragma unroll
        for (int tb = 0; tb < 4; ++tb) {
            const int t = tb * 16 + fr;
            bf16x8 qf[4];
#pragma unroll
            for (int kc = 0; kc < 4; ++kc) qf[kc] = qpre[kc];
            if (tb < 3) LOAD_Q(c, tb + 1); else LOAD_Q(cn, 0);
            f32x4 S[4];
#pragma unroll
            for (int sb = 0; sb < 4; ++sb) { f32x4 acc = (f32x4){0.f, 0.f, 0.f, 0.f}; const LAS unsigned char* kp = kimg + (sb * 16 + fr) * KIMG_STRIDE + fq * 8;
#pragma unroll
                for (int kc = 0; kc < 4; ++kc) { const s16x4 lo = *(const LAS s16x4*)(kp + 64 * kc), hi = *(const LAS s16x4*)(kp + 64 * kc + 32);
                    acc = MFMA16(__builtin_shufflevector(lo, hi, 0, 1, 2, 3, 4, 5, 6, 7), qf[kc], acc); }
                S[sb] = acc; }
            const float bt = sc[128 + t];
            f32x4 gs[4];
#pragma unroll
            for (int sb = 0; sb < 4; ++sb) gs[sb] = *(const LAS f32x4*)(sc + sb * 16 + 4 * fq);
            float dmax = -1e30f;
#pragma unroll
            for (int sb = 0; sb < 4; ++sb)
#pragma unroll
                for (int jj = 0; jj < 4; ++jj) { const int s = sb * 16 + fq * 4 + jj; const float d = (s <= t) ? bt + gs[sb][jj] : -1e30f; dmax = fmaxf(dmax, d); }
            dmax = fmaxf(dmax, __shfl_xor(dmax, 16)); dmax = fmaxf(dmax, __shfl_xor(dmax, 32));
            const float inter = bt + m_st, mt = fmaxf(inter, dmax);
            sc[192 + t] = __expf(inter - mt);
#pragma unroll
            for (int sb = 0; sb < 4; ++sb)
#pragma unroll
                for (int jj = 0; jj < 4; ++jj) { const int s = sb * 16 + fq * 4 + jj; const float e = (s <= t) ? __expf(bt + gs[sb][jj] - mt) : 0.f; S[sb][jj] *= e; }
            f32x4 nm = (f32x4){0.f, 0.f, 0.f, 0.f};
#pragma unroll
            for (int kc = 0; kc < 4; ++kc) nm = MFMA16(qf[kc], cf[kc], nm);
            nm = nm * *(const LAS f32x4*)(sc + 192 + tb * 16 + 4 * fq);
#pragma unroll
            for (int ks = 0; ks < 2; ++ks) nm = MFMA16(pack8(S[2 * ks], S[2 * ks + 1]), vf[ks], nm);
            if (tb == 2) asm volatile("s_waitcnt vmcnt(0)" ::: "memory");
#pragma unroll
            for (int jj = 0; jj < 4; ++jj) { const int tt = tb * 16 + fq * 4 + jj;
                if (c > 0 || tt >= 48) { const int row = ROWOF(c, tt);
                    if (!den_item) NUM[(size_t)row * 1024 + hd * 256 + sl * 16 + fr] = (bf16_t)(cvt_pk(nm[jj], 0.f) & 0xffffu);
                    else if (fr == 0) DEN[row * 4 + hd] = nm[jj]; } }
            if (den_item && fq == 0 && (c > 0 || t >= 48)) MT[ROWOF(c, t) * 4 + hd] = mt;
        }
#pragma unroll
        for (int dt = 0; dt < 8; ++dt) { f32x4 cc = C[dt] * w_old;
#pragma unroll
            for (int ks = 0; ks < 2; ++ks) { LAS unsigned char* tp = kimg + (32 * ks + 4 * fq + (fr >> 2)) * KIMG_STRIDE + (dt * 16 + 4 * (fr & 3)) * 2;
                const s16x4 lo = lds_tr(tp), hi = lds_tr(tp + 16 * KIMG_STRIDE);
                cc = MFMA16(__builtin_shufflevector(lo, hi, 0, 1, 2, 3, 4, 5, 6, 7), wvf[ks], cc); }
            C[dt] = cc; }
        m_st = m_new;
        asm volatile("s_waitcnt lgkmcnt(0)" ::: "memory");
    }
#undef ROWOF
#undef LOAD_CHUNK
#undef K_DMA
#undef LOAD_Q
}
__device__ __forceinline__ void mlstm_phase(const PArgs& a, LAS unsigned char* lds, int wave, int lane) {
    if (wave >= MLSTM_WAVES) return;
    LAS unsigned char* kbase = lds + wave * MWAVE_BYTES;
    for (int it = wave * (int)gridDim.x + (int)blockIdx.x; it < 32 * 17; it += MLSTM_WAVES * (int)gridDim.x) mlstm_item(a, it / 17, it % 17, kbase, lane);
}

__device__ __forceinline__ void cat_phase(const PArgs& a, int layer, int wave, int lane) {
    const GAS bf16_t* proj = (const GAS bf16_t*)(a.ws + WS_PROJ); const GAS bf16_t* NUM = (const GAS bf16_t*)(a.ws + WS_NUM);
    const GAS float* DEN = (const GAS float*)(a.ws + WS_DEN); const GAS float* MT = (const GAS float*)(a.ws + WS_MT);
    GAS bf16_t* XA = (GAS bf16_t*)(a.ws + WS_XA);
    const GAS float* mnw = a.mnw + layer * 1024; const GAS float* cw = a.cw + layer * 3 * 1024;
    const int gw = blockIdx.x * NWAVES + wave, NGW = gridDim.x * NWAVES;
    for (int m = gw; m < MTOT; m += NGW) {
        int p1, p2;
        if (m < MREAL) { const int t = m & (SEQ - 1), b = m >> 11; p1 = t >= 1 ? m - 1 : MREAL + b * 16 + 15; p2 = t >= 2 ? m - 2 : MREAL + b * 16 + 14 + t; }
        else { const int j = (m - MREAL) & 15; p1 = j >= 1 ? m - 1 : -1; p2 = j >= 2 ? m - 2 : -1; }
        const GAS bf16_t* pr = proj + (size_t)m * NPROJ; const GAS bf16_t* pr1 = proj + (size_t)(p1 < 0 ? m : p1) * NPROJ; const GAS bf16_t* pr2 = proj + (size_t)(p2 < 0 ? m : p2) * NPROJ;
        const float z1 = p1 < 0 ? 0.f : 1.f, z2 = p2 < 0 ? 0.f : 1.f;
#pragma unroll
        for (int j = 0; j < 4; ++j) {
            const int c = lane * 4 + 256 * j;
            const u32x2 nv = *(const GAS u32x2*)(NUM + (size_t)m * 1024 + c);
            const float den = DEN[m * 4 + j], mt = MT[m * 4 + j];
            const float sc = 1.0f / fmaxf(fabsf(den), __expf(-mt));
            float h0 = bflo(nv.x) * sc, h1 = bfhi(nv.x) * sc, h2 = bflo(nv.y) * sc, h3 = bfhi(nv.y) * sc;
            const float r = rsqrtf(wave_sum((h0 * h0 + h1 * h1) + (h2 * h2 + h3 * h3)) * (1.0f / DV) + EPS);
            const f32x4 w4 = *(const GAS f32x4*)(mnw + c);
            const u32x2 ogv = *(const GAS u32x2*)(pr + C_OG + c);
            const float s0 = 1.0f / (1.0f + __expf(-bflo(ogv.x))), s1 = 1.0f / (1.0f + __expf(-bfhi(ogv.x))), s2 = 1.0f / (1.0f + __expf(-bflo(ogv.y))), s3 = 1.0f / (1.0f + __expf(-bfhi(ogv.y)));
            u32x2 o; o.x = cvt_pk(s0 * h0 * r * w4[0], s1 * h1 * r * w4[1]); o.y = cvt_pk(s2 * h2 * r * w4[2], s3 * h3 * r * w4[3]);
            *(GAS u32x2*)(XA + (size_t)m * D + c) = o;
            const u32x2 u0 = *(const GAS u32x2*)(pr + C_U + c), g0 = *(const GAS u32x2*)(pr + C_GC + c), gb = *(const GAS u32x2*)(pr + C_GB + c);
            const u32x2 u1 = *(const GAS u32x2*)(pr1 + C_U + c), g1 = *(const GAS u32x2*)(pr1 + C_GC + c), u2 = *(const GAS u32x2*)(pr2 + C_U + c), g2 = *(const GAS u32x2*)(pr2 + C_GC + c);
            const f32x4 k0 = *(const GAS f32x4*)(cw + c), k1 = *(const GAS f32x4*)(cw + 1024 + c), k2 = *(const GAS f32x4*)(cw + 2048 + c);
            float cv[4];
            cv[0] = z2 * bflo(u2.x) * bflo(g2.x) * k0[0] + z1 * bflo(u1.x) * bflo(g1.x) * k1[0] + bflo(u0.x) * bflo(g0.x) * k2[0];
            cv[1] = z2 * bfhi(u2.x) * bfhi(g2.x) * k0[1] + z1 * bfhi(u1.x) * bfhi(g1.x) * k1[1] + bfhi(u0.x) * bfhi(g0.x) * k2[1];
            cv[2] = z2 * bflo(u2.y) * bflo(g2.y) * k0[2] + z1 * bflo(u1.y) * bflo(g1.y) * k1[2] + bflo(u0.y) * bflo(g0.y) * k2[2];
            cv[3] = z2 * bfhi(u2.y) * bfhi(g2.y) * k0[3] + z1 * bfhi(u1.y) * bfhi(g1.y) * k1[3] + bfhi(u0.y) * bfhi(g0.y) * k2[3];
            u32x2 oc; oc.x = cvt_pk(bflo(gb.x) * cv[0], bfhi(gb.x) * cv[1]); oc.y = cvt_pk(bflo(gb.y) * cv[2], bfhi(gb.y) * cv[3]);
            *(GAS u32x2*)(XA + (size_t)m * D + 1024 + c) = oc;
        }
    }
}

#ifndef MK_PER_PHASE
#define MK_PER_PHASE 0
#endif

__device__ __forceinline__ PArgs launder(const Args& s) { Args r = s;
    asm volatile("" : "+s"(r.x), "+s"(r.meta), "+s"(r.nmw), "+s"(r.win), "+s"(r.bg), "+s"(r.cw), "+s"(r.mnw), "+s"(r.wout), "+s"(r.nfw), "+s"(r.wg), "+s"(r.wu), "+s"(r.wd), "+s"(r.nfin), "+s"(r.out), "+s"(r.ws));
    PArgs q; q.x = (const GAS float*)r.x; q.meta = (const GAS float*)r.meta; q.nmw = (const GAS float*)r.nmw; q.win = (const GAS float*)r.win; q.bg = (const GAS float*)r.bg; q.cw = (const GAS float*)r.cw;
    q.mnw = (const GAS float*)r.mnw; q.wout = (const GAS float*)r.wout; q.nfw = (const GAS float*)r.nfw; q.wg = (const GAS float*)r.wg; q.wu = (const GAS float*)r.wu; q.wd = (const GAS float*)r.wd; q.nfin = (const GAS float*)r.nfin;
    q.out = (GAS float*)r.out; q.ws = (GAS unsigned char*)r.ws;
    return q; }
constexpr int N_PHASES = 17;

__global__ void __launch_bounds__(NTHREADS, 2) hymba_fwd(Args a_in) {
    extern __shared__ __attribute__((aligned(16))) unsigned char lds_raw[];
    LAS unsigned char* lds = (LAS unsigned char*)lds_raw;
    const int wave = __builtin_amdgcn_readfirstlane(threadIdx.x >> 6);
#define LANE() ({ int l_; asm volatile("v_mbcnt_lo_u32_b32 %0, -1, 0\n\tv_mbcnt_hi_u32_b32 %0, -1, %0" : "=v"(l_)); l_; })
    const int G = gridDim.x, bid = blockIdx.x;
    const int lo = a_in.ph_lo, hi = a_in.ph_hi;
    volatile LAS unsigned* MISC = (volatile LAS unsigned*)(lds + 131072);
    XcdBarrier bar; bar.bar = (unsigned*)(a_in.ws + WS_CTL); bar.x = 0; bar.st = MISC + 8;
    if (hi - lo > 1) { if (threadIdx.x < 64) MISC[threadIdx.x] = 0u; __syncthreads(); bar = xcd_barrier_post((unsigned*)(a_in.ws + WS_CTL), MISC + 8); }
#define IN(k) (lo <= (k) && (k) < hi)
#ifndef PROBE
#define PROBE 0
#endif
#define DUP(n) for (int rep_ = 0; rep_ < ((PROBE == (n)) ? 2 : 1); ++rep_)
#define SEAM(k) do { if (IN(k) && IN((k) + 1)) { if ((k) == 0) cg::this_grid().sync(); else xcd_barrier(bar); if (PROBE == 9) xcd_barrier(bar); } } while (0)
    if (IN(0)) { const PArgs a = launder(a_in); DUP(1) { weights_phase(a, lds, wave, LANE()); __syncthreads(); } norm_phase<0>(a, 0, lds, wave, LANE()); __syncthreads(); }
    SEAM(0);
#pragma unroll
    for (int l = 0; l < 2; ++l) {
        const int p0 = 1 + 8 * l;
        if (IN(p0 + 0)) DUP(2) { const PArgs a = launder(a_in); pg8::Gemm g{(const bf16_t*)(const unsigned char*)(a.ws + WS_XA), (const bf16_t*)(const unsigned char*)(a.ws + WS_WT_IN + l * SZ_WT_IN), MPAD, NPROJ, D}; pg8::StaticOrder S; S.init(MPAD, NPROJ, G, bid);
            EpiProj E{(GAS bf16_t*)(a.ws + WS_PROJ)}; pg8::gemm_phase<EpiProj, pg8::StaticOrder, true, true>(lds, g, S, E, wave); }
        SEAM(p0 + 0);
        if (IN(p0 + 1)) DUP(3) { const PArgs a = launder(a_in); mlstm_phase(a, lds, wave, LANE()); __syncthreads(); }
        SEAM(p0 + 1);
        if (IN(p0 + 2)) DUP(4) { const PArgs a = launder(a_in); cat_phase(a, l, wave, LANE()); }
        SEAM(p0 + 2);
        if (IN(p0 + 3)) { const PArgs a = launder(a_in); pg8::Gemm g{(const bf16_t*)(const unsigned char*)(a.ws + WS_XA), (const bf16_t*)(const unsigned char*)(a.ws + WS_WT_OUT + l * SZ_WT_OUT), MPAD, D, D}; pg8::StaticOrder S; S.init(MPAD, D, G, bid);
            EpiResid E{a.out, (GAS float*)(a.ws + WS_HMETA)}; pg8::gemm_phase<EpiResid, pg8::StaticOrder, true, true>(lds, g, S, E, wave); }
        SEAM(p0 + 3);
        if (IN(p0 + 4)) DUP(5) { const PArgs a = launder(a_in); norm_phase<2>(a, l, lds, wave, LANE()); }
        SEAM(p0 + 4);
        if (IN(p0 + 5)) DUP(6) { const PArgs a = launder(a_in); pg8::Gemm g{(const bf16_t*)(const unsigned char*)(a.ws + WS_XA), (const bf16_t*)(const unsigned char*)(a.ws + WS_WT_GU + l * SZ_WT_GU), MPAD, NGU, D}; pg8::StaticOrder S; S.init(MPAD, NGU, G, bid);
            EpiSwiglu E{(GAS bf16_t*)(a.ws + WS_PROJ)}; pg8::gemm_phase<EpiSwiglu, pg8::StaticOrder, true, true>(lds, g, S, E, wave); }
        SEAM(p0 + 5);
        if (IN(p0 + 6)) { const PArgs a = launder(a_in); pg8::Gemm g{(const bf16_t*)(const unsigned char*)(a.ws + WS_PROJ), (const bf16_t*)(const unsigned char*)(a.ws + WS_WT_DN + l * SZ_WT_DN), MPAD, D, DFF}; pg8::StaticOrder S; S.init(MPAD, D, G, bid);
            EpiResid E{a.out, (GAS float*)(a.ws + WS_HMETA)}; pg8::gemm_phase<EpiResid, pg8::StaticOrder, true, true>(lds, g, S, E, wave); }
        SEAM(p0 + 6);
        if (IN(p0 + 7)) { const PArgs a = launder(a_in); if (l == 0) { norm_phase<1>(a, 1, lds, wave, LANE()); __syncthreads(); } else norm_phase<3>(a, 0, lds, wave, LANE()); }
        if (l == 0) SEAM(p0 + 7);
    }
#undef IN
#undef SEAM
}

extern "C" void kernel_launch(void* const* d_in, const int* in_sizes, int n_in, void* d_out, int out_size, void* d_ws, size_t ws_size, hipStream_t stream) {
    static int grid = 0;
    if (grid == 0) {
        if (n_in != 13 || in_sizes[0] != MREAL * D || out_size != MREAL * D || ws_size < WS_END) {
            fprintf(stderr, "kernel_launch: unexpected shapes (n_in %d, in0 %d, out %d, ws %zu; need ws >= %zu); nothing launched\n", n_in, n_in > 0 ? in_sizes[0] : -1, out_size, ws_size, (size_t)WS_END); grid = -1; return; }
        int dev = 0, cus = 0, per_cu = 0;
        hipGetDevice(&dev); hipDeviceGetAttribute(&cus, hipDeviceAttributeMultiprocessorCount, dev);
        if (hipFuncSetAttribute((const void*)hymba_fwd, hipFuncAttributeMaxDynamicSharedMemorySize, LDS_BYTES) != hipSuccess) { fprintf(stderr, "kernel_launch: hipFuncSetAttribute failed\n"); grid = -1; return; }
        if (hipOccupancyMaxActiveBlocksPerMultiprocessor(&per_cu, (const void*)hymba_fwd, NTHREADS, LDS_BYTES) != hipSuccess || per_cu < 1) { fprintf(stderr, "kernel_launch: occupancy query says %d\n", per_cu); per_cu = 1; }
        (void)hipGetLastError();
        grid = cus * per_cu;
    }
    if (grid < 0) return;
    Args a{};
    a.x = (const float*)d_in[0]; a.meta = (const float*)d_in[1]; a.nmw = (const float*)d_in[2]; a.win = (const float*)d_in[3]; a.bg = (const float*)d_in[4]; a.cw = (const float*)d_in[5];
    a.mnw = (const float*)d_in[6]; a.wout = (const float*)d_in[7]; a.nfw = (const float*)d_in[8]; a.wg = (const float*)d_in[9]; a.wu = (const float*)d_in[10]; a.wd = (const float*)d_in[11]; a.nfin = (const float*)d_in[12];
    a.out = (float*)d_out; a.ws = (unsigned char*)d_ws;
#if MK_PER_PHASE
    for (int p = 0; p < N_PHASES; ++p) { a.ph_lo = p; a.ph_hi = p + 1; hipLaunchKernelGGL(hymba_fwd, dim3(grid), dim3(NTHREADS), LDS_BYTES, stream, a); }
#else
    a.ph_lo = 0; a.ph_hi = N_PHASES;
    if (hipMemsetAsync((char*)d_ws + WS_CTL, 0, CTL_BYTES, stream) != hipSuccess) { fprintf(stderr, "kernel_launch: memset failed\n"); return; }
    void* args[] = {&a};
    hipError_t e = hipLaunchCooperativeKernel((const void*)hymba_fwd, dim3(grid), dim3(NTHREADS), args, LDS_BYTES, stream);
    if (e != hipSuccess) fprintf(stderr, "kernel_launch: cooperative launch failed: %s (grid %d)\n", hipGetErrorString(e), grid);
#endif
}
```

```cpp
#include <hip/hip_runtime.h>
#include <hip/hip_cooperative_groups.h>
#include <cstdio>
#include <cstdint>
namespace cg = cooperative_groups;
namespace pg8 {
#define PG8_LAS __attribute__((address_space(3)))
typedef unsigned short bf16_t;
typedef short bf16x8 __attribute__((ext_vector_type(8)));
typedef float f32x4 __attribute__((ext_vector_type(4)));
typedef unsigned u32x4 __attribute__((ext_vector_type(4)));
constexpr int BM = 256, BK = 64, HALF = 128, HTB = HALF * BK * 2  , STAGE_BYTES = 8 * HTB, NXCD = 8, WGM = 8;

__host__ __device__ __forceinline__ int lds_byte(int r, int c) { const int st = (r >> 4) * 2 + (c >> 5), rr = r & 15, cc = c & 31, ob = rr * 64 + cc * 2; return st * 1024 + (ob ^ (((ob >> 9) & 1) << 5)); }
__host__ __device__ __forceinline__ void stage_rc(int b, int& R, int& C) { const int st = b / 1024, sb = b % 1024, swz = sb ^ (((sb >> 9) & 1) << 5); R = (st >> 1) * 16 + swz / 64; C = (st & 1) * 32 + (swz % 64) / 2; }
__host__ __device__ __forceinline__ int perm32(int rho) { const int n = rho >> 4, i = rho & 15; return 8 * (i >> 2) + 4 * n + (i & 3); }

struct Unit { int pm, pn; };
struct Gemm { const bf16_t* A; const bf16_t* Bt; int M, N, K; };

struct StaticOrder {
    int nM, nN, nwg, G, c;
    __host__ __device__ void init(int M, int N, int G_, int c_) { nM = M / BM; nN = N / BM; nwg = nM * nN; G = G_; c = c_; }
    __host__ __device__ bool next(int i, Unit& u) const {
        const long L = (long)i * G + c; if (L >= nwg) return false;
        int wgid = (int)L; { const int q = nwg / NXCD, r = nwg % NXCD, xcd = wgid % NXCD, off = wgid / NXCD; wgid = (xcd < r ? xcd * (q + 1) : r * (q + 1) + (xcd - r) * q) + off; }
        const int nig = WGM * nN, gid = wgid / nig, fm = gid * WGM, gsz = (nM - fm) < WGM ? (nM - fm) : WGM;
        u.pm = fm + ((wgid % nig) % gsz); u.pn = (wgid % nig) / gsz; return true;
    }
    __device__ __forceinline__ void a_ready(const Unit&) const {}
    __device__ __forceinline__ void done(const Unit&) const {}
};
__device__ __forceinline__ unsigned cvt_pk_bf16(float lo, float hi) { unsigned r; asm volatile("v_cvt_pk_bf16_f32 %0, %1, %2" : "=v"(r) : "v"(lo), "v"(hi)); return r; }
typedef float f32x2 __attribute__((ext_vector_type(2)));
template <class Epi, class Sched, bool ALIGN_EPI = false, bool SP2 = false>
__device__ __forceinline__ void gemm_phase(PG8_LAS unsigned char* lds, const Gemm g, const Sched& S, const Epi& E, const int wave_in) {
    int tid_; asm volatile("v_mbcnt_lo_u32_b32 %0, -1, 0\n\tv_mbcnt_hi_u32_b32 %0, -1, %0" : "=v"(tid_)); tid_ += wave_in * 64;
    const int tid = tid_, wid = __builtin_amdgcn_readfirstlane(tid >> 6), lane = tid & 63, wr = wid >> 2, wc = wid & 3, fr = lane & 15, fq = lane >> 4;
    const int K = g.K, nt = K / BK;
    unsigned voffA[2], voffB[2];
#pragma unroll
    for (int i = 0; i < 2; ++i) { int R, C; stage_rc(tid * 16 + i * 8192, R, C); const int Rb = Epi::PERM ? ((R & ~31) + perm32(R & 31)) : R;
        voffA[i] = (unsigned)(R * K + C) * 2u; voffB[i] = (unsigned)(Rb * K + C) * 2u; }
    const size_t kstep = (size_t)(BK * 2);
    const size_t hstep = (size_t)HALF * K * 2;
    const size_t tstep = 2 * hstep;
    const unsigned ldsw = (unsigned)wid * 1024u;
    const int aoff = lds_byte(wr * 64 + fr, fq * 8), boff = lds_byte(wc * 32 + fr, fq * 8);
#define PG8_SA(b, h) (((b) * 2 + (h)) * HTB)
#define PG8_SB(b, h) ((4 + (b) * 2 + (h)) * HTB)
#define PG8_STAGE(bufoff, gbase, voff) do { _Pragma("unroll") for (int _i = 0; _i < 2; ++_i) \
        __builtin_amdgcn_global_load_lds((const unsigned*)((const char*)(gbase) + (voff)[_i]), (PG8_LAS unsigned*)(lds + (bufoff) + ldsw + _i * 8192), 16, 0, 0); } while (0)
#define PG8_LDA(dst, b, h) do { _Pragma("unroll") for (int m = 0; m < 4; ++m) _Pragma("unroll") for (int k = 0; k < 2; ++k) dst[m][k] = *(const PG8_LAS bf16x8*)(lds + PG8_SA(b, h) + aoff + m * 2048 + k * 1024); } while (0)
#define PG8_LDB(dst, b, h) do { _Pragma("unroll") for (int n = 0; n < 2; ++n) _Pragma("unroll") for (int k = 0; k < 2; ++k) dst[n][k] = *(const PG8_LAS bf16x8*)(lds + PG8_SB(b, h) + boff + n * 2048 + k * 1024); } while (0)
#define PG8_MMA(ai, bj, At, Bt) do { __builtin_amdgcn_s_setprio(1); _Pragma("unroll") for (int m = 0; m < 4; ++m) _Pragma("unroll") for (int n = 0; n < 2; ++n) _Pragma("unroll") for (int k = 0; k < 2; ++k) \
        acc[ai][bj][m][n] = __builtin_amdgcn_mfma_f32_16x16x32_bf16(Bt[n][k], At[m][k], acc[ai][bj][m][n], 0, 0, 0); __builtin_amdgcn_s_setprio(0); } while (0)
#define PG8_WAIT_V(n) asm volatile("s_waitcnt vmcnt(" #n ")" ::: "memory")
#define PG8_WAIT_L(n) asm volatile("s_waitcnt lgkmcnt(" #n ")" ::: "memory")
#define PG8_BAR __builtin_amdgcn_s_barrier()
#define PG8_SCHED __builtin_amdgcn_sched_barrier(0)
    Unit cur, nxt; int ui = 0;
    if (!S.next(0, cur)) return;
    f32x4 acc[2][2][4][2];
#pragma unroll
    for (int a = 0; a < 2; ++a)
#pragma unroll
        for (int b = 0; b < 2; ++b)
#pragma unroll
            for (int m = 0; m < 4; ++m)
#pragma unroll
                for (int n = 0; n < 2; ++n) acc[a][b][m][n] = (f32x4){0.f, 0.f, 0.f, 0.f};
    bf16x8 At[4][2], B0[2][2], B1[2][2];
    const char* cA = (const char*)g.A + (size_t)cur.pm * tstep; const char* cB = (const char*)g.Bt + (size_t)cur.pn * tstep;
    S.a_ready(cur);
    if constexpr (SP2) {
        PG8_STAGE(PG8_SB(0, 0), cB, voffB); PG8_STAGE(PG8_SB(0, 1), cB + hstep, voffB); PG8_STAGE(PG8_SA(0, 0), cA, voffA); PG8_STAGE(PG8_SA(0, 1), cA + hstep, voffA);
        if (wr == 1) PG8_BAR;
        PG8_WAIT_V(2); PG8_BAR;
        PG8_STAGE(PG8_SB(1, 0), cB + kstep, voffB); PG8_STAGE(PG8_SA(1, 0), cA + kstep, voffA); PG8_STAGE(PG8_SB(1, 1), cB + hstep + kstep, voffB);
        PG8_WAIT_V(6); PG8_BAR;
    } else {
        PG8_STAGE(PG8_SB(0, 0), cB, voffB); PG8_STAGE(PG8_SA(0, 0), cA, voffA); PG8_STAGE(PG8_SB(0, 1), cB + hstep, voffB); PG8_STAGE(PG8_SA(0, 1), cA + hstep, voffA);
        if (wr == 1) PG8_BAR;
        PG8_WAIT_V(4); PG8_BAR;
        PG8_STAGE(PG8_SB(1, 0), cB + kstep, voffB); PG8_STAGE(PG8_SA(1, 0), cA + kstep, voffA); PG8_STAGE(PG8_SB(1, 1), cB + hstep + kstep, voffB);
        PG8_WAIT_V(6); PG8_BAR;
    }
    for (;;) {
        const bool has_next = S.next(ui + 1, nxt);
        const char* nA = has_next ? (const char*)g.A + (size_t)nxt.pm * tstep : cA; const char* nB = has_next ? (const char*)g.Bt + (size_t)nxt.pn * tstep : cB;
        for (int t = 0; t < nt; t += 2) {
            const bool last = (t == nt - 2);
            const char* a1 = cA + (size_t)(t + 1) * kstep;
            const char* a2 = last ? nA : cA + (size_t)(t + 2) * kstep; const char* b2 = last ? nB : cB + (size_t)(t + 2) * kstep;
            const char* a3 = a2 + kstep; const char* b3 = b2 + kstep;
            if (last && has_next) S.a_ready(nxt);
            if constexpr (SP2) {
            PG8_LDB(B0, 0, 0); PG8_LDB(B1, 0, 1); PG8_SCHED; PG8_LDA(At, 0, 0); PG8_STAGE(PG8_SA(1, 1), a1 + hstep, voffA);
            PG8_WAIT_V(8); PG8_WAIT_L(0); PG8_BAR; PG8_MMA(0, 0, At, B0); PG8_MMA(0, 1, At, B1); PG8_BAR; PG8_SCHED;
            PG8_LDA(At, 0, 1); PG8_STAGE(PG8_SB(0, 0), b2, voffB); PG8_STAGE(PG8_SB(0, 1), b2 + hstep, voffB); PG8_STAGE(PG8_SA(0, 0), a2, voffA);
            PG8_WAIT_V(8); PG8_WAIT_L(0); PG8_BAR; PG8_MMA(1, 0, At, B0); PG8_MMA(1, 1, At, B1); PG8_BAR; PG8_SCHED;
            PG8_LDB(B0, 1, 0); PG8_LDB(B1, 1, 1); PG8_SCHED; PG8_LDA(At, 1, 0); PG8_STAGE(PG8_SA(0, 1), a2 + hstep, voffA);
            PG8_WAIT_V(8); PG8_WAIT_L(0); PG8_BAR; PG8_MMA(0, 0, At, B0); PG8_MMA(0, 1, At, B1); PG8_BAR; PG8_SCHED;
            PG8_LDA(At, 1, 1); PG8_STAGE(PG8_SB(1, 0), b3, voffB); PG8_STAGE(PG8_SB(1, 1), b3 + hstep, voffB); PG8_STAGE(PG8_SA(1, 0), a3, voffA);
            PG8_WAIT_V(8); PG8_WAIT_L(0); PG8_BAR; PG8_MMA(1, 0, At, B0); PG8_MMA(1, 1, At, B1); PG8_BAR; PG8_SCHED;
            } else {
            PG8_LDB(B0, 0, 0); PG8_SCHED; PG8_LDA(At, 0, 0); PG8_STAGE(PG8_SA(1, 1), a1 + hstep, voffA);
            PG8_WAIT_L(8); PG8_BAR; PG8_WAIT_L(0); PG8_MMA(0, 0, At, B0); PG8_BAR; PG8_SCHED;
            PG8_LDB(B1, 0, 1); PG8_STAGE(PG8_SB(0, 0), b2, voffB);
            PG8_BAR; PG8_WAIT_L(0); PG8_MMA(0, 1, At, B1); PG8_BAR;
            PG8_LDA(At, 0, 1); PG8_STAGE(PG8_SA(0, 0), a2, voffA);
            PG8_BAR; PG8_WAIT_L(0); PG8_MMA(1, 0, At, B0); PG8_BAR; PG8_SCHED;
            PG8_STAGE(PG8_SB(0, 1), b2 + hstep, voffB);
            PG8_WAIT_V(6); PG8_BAR; PG8_MMA(1, 1, At, B1); PG8_BAR;
            PG8_LDB(B0, 1, 0); PG8_SCHED; PG8_LDA(At, 1, 0); PG8_STAGE(PG8_SA(0, 1), a2 + hstep, voffA);
            PG8_WAIT_L(8); PG8_BAR; PG8_WAIT_L(0); PG8_MMA(0, 0, At, B0); PG8_BAR; PG8_SCHED;
            PG8_LDB(B1, 1, 1); PG8_STAGE(PG8_SB(1, 0), b3, voffB);
            PG8_BAR; PG8_WAIT_L(0); PG8_MMA(0, 1, At, B1); PG8_BAR;
            PG8_LDA(At, 1, 1); PG8_STAGE(PG8_SA(1, 0), a3, voffA);
            PG8_BAR; PG8_WAIT_L(0); PG8_MMA(1, 0, At, B0); PG8_BAR; PG8_SCHED;
            PG8_STAGE(PG8_SB(1, 1), b3 + hstep, voffB);
            PG8_WAIT_V(6); PG8_BAR; PG8_MMA(1, 1, At, B1); PG8_BAR;
            }
        }
        if constexpr (ALIGN_EPI) { if (wr == 0) PG8_BAR; }
        if constexpr (!Epi::AFTER_DRAIN) { E(acc, cur, wr, wc, fr, fq); S.done(cur); }
        if (!has_next) break;
#pragma unroll
        for (int a = 0; a < 2; ++a)
#pragma unroll
            for (int b = 0; b < 2; ++b)
#pragma unroll
                for (int m = 0; m < 4; ++m)
#pragma unroll
                    for (int n = 0; n < 2; ++n) acc[a][b][m][n] = (f32x4){0.f, 0.f, 0.f, 0.f};
        cur = nxt; cA = nA; cB = nB; ++ui;
        if constexpr (ALIGN_EPI) { if (wr == 1) PG8_BAR; }
    }
    PG8_WAIT_V(0);
    if constexpr (!ALIGN_EPI) { if (wr == 0) PG8_BAR; }
    PG8_BAR;
    if constexpr (Epi::AFTER_DRAIN) { E.fused(acc, cur, wr, wc, fr, fq, lds, wid, lane); S.done(cur); }
#undef PG8_SA
#undef PG8_SB
#undef PG8_STAGE
#undef PG8_LDA
#undef PG8_LDB
#undef PG8_MMA
#undef PG8_WAIT_V
#undef PG8_WAIT_L
#undef PG8_BAR
#undef PG8_SCHED
}
}

#define LAS __attribute__((address_space(3)))
typedef unsigned short bf16_t;
typedef short bf16x8 __attribute__((ext_vector_type(8)));
typedef short s16x4 __attribute__((ext_vector_type(4)));
typedef float f32x4 __attribute__((ext_vector_type(4)));
typedef unsigned u32x4 __attribute__((ext_vector_type(4)));
typedef unsigned u32x2 __attribute__((ext_vector_type(2)));

constexpr int D = 2048, NB = 8, SEQ = 2048, NMETA = 16, NHEAD = 4, DV = 256, DQK = 128;
constexpr int MREAL = NB * SEQ;
constexpr int MMETA = NMETA;
constexpr int MTOT = MREAL + MMETA;
constexpr int MPAD = MTOT;
constexpr int DIN = 6152, NPROJ = 6144, DFF = 5632, NGU = 2 * DFF;
constexpr int C_Q = 0, C_K = 512, C_V = 1024, C_OG = 2048, C_U = 3072, C_GB = 4096, C_GC = 5120;
constexpr float EPS = 1e-6f, GATE_CAP = 15.0f;
constexpr int NCHUNK = 33;

constexpr size_t MiB = 1u << 20;
constexpr size_t SZ_WT_IN = (size_t)NPROJ * D * 2, SZ_WT_OUT = (size_t)D * D * 2, SZ_WT_GU = (size_t)NGU * D * 2, SZ_WT_DN = (size_t)D * DFF * 2;
constexpr size_t WS_WT_IN = 0, WS_WT_OUT = 48 * MiB, WS_WT_GU = 64 * MiB, WS_WT_DN = 152 * MiB;
constexpr size_t WS_XA = 196 * MiB;
constexpr size_t WS_PROJ = 261 * MiB;
constexpr size_t WS_NUM = 456 * MiB;
constexpr size_t WS_HMETA = 489 * MiB;
constexpr size_t WS_LI = 491 * MiB, WS_LF = WS_LI + MiB / 2, WS_DEN = 492 * MiB, WS_MT = WS_DEN + MiB / 2;
constexpr size_t WS_CTL = 493 * MiB, CTL_BYTES = 65536;
constexpr size_t WS_END = 494 * MiB;
static_assert(2 * SZ_WT_IN <= WS_WT_OUT - WS_WT_IN && 2 * SZ_WT_OUT <= WS_WT_GU - WS_WT_OUT && 2 * SZ_WT_GU <= WS_WT_DN - WS_WT_GU && 2 * SZ_WT_DN <= WS_XA - WS_WT_DN, "ws map");
static_assert((size_t)MPAD * D * 2 <= WS_PROJ - WS_XA && (size_t)MPAD * NPROJ * 2 <= WS_NUM - WS_PROJ && (size_t)MPAD * 1024 * 2 <= WS_HMETA - WS_NUM, "ws map");

constexpr int LDS_BYTES = 147456;
constexpr int NWAVES = 8, NTHREADS = 512;

__device__ __forceinline__ unsigned cvt_pk(float lo, float hi) { unsigned r; asm volatile("v_cvt_pk_bf16_f32 %0, %1, %2" : "=v"(r) : "v"(lo), "v"(hi)); return r; }
__device__ __forceinline__ float bf2f(unsigned short b) { return __uint_as_float(((unsigned)b) << 16); }
__device__ __forceinline__ float bflo(unsigned w) { return __uint_as_float(w << 16); }
__device__ __forceinline__ float bfhi(unsigned w) { return __uint_as_float(w & 0xffff0000u); }
__device__ __forceinline__ float wave_sum(float v) {
#pragma unroll
    for (int o = 1; o < 64; o <<= 1) v += __shfl_xor(v, o);
    return v;
}
__device__ __forceinline__ float wave_max(float v) {
#pragma unroll
    for (int o = 1; o < 64; o <<= 1) v = fmaxf(v, __shfl_xor(v, o));
    return v;
}

struct Args {
    const float *x, *meta, *nmw, *win, *bg, *cw, *mnw, *wout, *nfw, *wg, *wu, *wd, *nfin;
    float* out; unsigned char* ws; int ph_lo, ph_hi;
};
static_assert(sizeof(Args) == 15 * 8 + 8, "Args has no padding");

#define GAS __attribute__((address_space(1)))
struct PArgs {
    const GAS float *x, *meta, *nmw, *win, *bg, *cw, *mnw, *wout, *nfw, *wg, *wu, *wd, *nfin;
    GAS float* out; GAS unsigned char* ws;
};
__device__ __forceinline__ GAS float* hrow(const PArgs& a, int m) { return m < MREAL ? a.out + (size_t)m * D : (GAS float*)(a.ws + WS_HMETA) + (size_t)(m - MREAL) * D; }

struct EpiProj {
    static constexpr bool PERM = true, AFTER_DRAIN = false;
    GAS bf16_t* O;
    __device__ __forceinline__ void operator()(const f32x4 (&acc)[2][2][4][2], const pg8::Unit& u, int wr, int wc, int fr, int fq) const {
        const int row0 = u.pm * 256 + wr * 64 + fr, colt = u.pn * 256;
        const float sc = (colt < C_K) ? 0.08838834764831845f : 1.0f;
        const int col0 = colt + wc * 32 + 8 * fq;
#pragma unroll
        for (int ai = 0; ai < 2; ++ai)
#pragma unroll
            for (int m = 0; m < 4; ++m) { GAS bf16_t* rowp = O + (size_t)(row0 + ai * 128 + m * 16) * NPROJ + col0;
#pragma unroll
                for (int bj = 0; bj < 2; ++bj) { const f32x4 v0 = acc[ai][bj][m][0] * sc, v1 = acc[ai][bj][m][1] * sc;
                    u32x4 w; w.x = cvt_pk(v0[0], v0[1]); w.y = cvt_pk(v0[2], v0[3]); w.z = cvt_pk(v1[0], v1[1]); w.w = cvt_pk(v1[2], v1[3]);
                    *(GAS u32x4*)(rowp + bj * 128) = w; } }
    }
};
struct EpiResid {
    static constexpr bool PERM = false, AFTER_DRAIN = false;
    GAS float* out; GAS float* hmeta;
    __device__ __forceinline__ void operator()(const f32x4 (&acc)[2][2][4][2], const pg8::Unit& u, int wr, int wc, int fr, int fq) const {
        GAS float* hb = (u.pm < MREAL / 256) ? out + (size_t)u.pm * 256 * D : hmeta;
        const int r0 = wr * 64 + fr, col0 = u.pn * 256 + wc * 32 + 4 * fq;
#pragma unroll
        for (int ai = 0; ai < 2; ++ai)
#pragma unroll
            for (int m = 0; m < 4; ++m) { GAS float* rowp = hb + (size_t)(r0 + ai * 128 + m * 16) * D + col0;
                f32x4 old[2][2];
#pragma unroll
                for (int bj = 0; bj < 2; ++bj)
#pragma unroll
                    for (int n = 0; n < 2; ++n) old[bj][n] = *(const GAS f32x4*)(rowp + bj * 128 + n * 16);
#pragma unroll
                for (int bj = 0; bj < 2; ++bj)
#pragma unroll
                    for (int n = 0; n < 2; ++n) *(GAS f32x4*)(rowp + bj * 128 + n * 16) = old[bj][n] + acc[ai][bj][m][n];
            }
    }
};
struct EpiSwiglu {
    static constexpr bool PERM = true, AFTER_DRAIN = false;
    GAS bf16_t* O;
    __device__ __forceinline__ void operator()(const f32x4 (&acc)[2][2][4][2], const pg8::Unit& u, int wr, int wc, int fr, int fq) const {
        const int row0 = u.pm * 256 + wr * 64 + fr, col0 = u.pn * 128 + wc * 32 + 8 * fq;
#pragma unroll
        for (int ai = 0; ai < 2; ++ai)
#pragma unroll
            for (int m = 0; m < 4; ++m) { GAS bf16_t* rowp = O + (size_t)(row0 + ai * 128 + m * 16) * DFF + col0;
                float r[8];
#pragma unroll
                for (int n = 0; n < 2; ++n)
#pragma unroll
                    for (int j = 0; j < 4; ++j) { const float g = acc[ai][0][m][n][j], up = acc[ai][1][m][n][j]; r[n * 4 + j] = g * up * __builtin_amdgcn_rcpf(1.0f + __expf(-g)); }
                u32x4 w; w.x = cvt_pk(r[0], r[1]); w.y = cvt_pk(r[2], r[3]); w.z = cvt_pk(r[4], r[5]); w.w = cvt_pk(r[6], r[7]);
                *(GAS u32x4*)rowp = w; }
    }
};

#define RLX_AGENT __ATOMIC_RELAXED, __HIP_MEMORY_SCOPE_AGENT
#define XB_TMO      128
#define XB_XCNT(j)  (256  + 64 * (j))
#define XB_XSUB(j)  (1280 + 64 * (j))
#define XB_XGEN(j)  (2304 + 64 * (j))
#define XB_TOP      3328
#define XB_TOPGEN   3392
#define XCD_BAR_WORDS 3456
#define XB_SPIN_CAP (1u << 18)

__device__ __forceinline__ unsigned xb_ld(unsigned* p)              { return __hip_atomic_load(p, __ATOMIC_RELAXED, __HIP_MEMORY_SCOPE_AGENT); }
__device__ __forceinline__ unsigned xb_add(unsigned* p, unsigned v) { return __hip_atomic_fetch_add(p, v, __ATOMIC_RELAXED, __HIP_MEMORY_SCOPE_AGENT); }
__device__ __forceinline__ unsigned xb_xcc_id() { return (unsigned)__builtin_amdgcn_s_getreg((3 << 11) | 20) & 0xFu; }
#define XB_SPIN(cond, bar) do { unsigned _sp = 0; while (cond) { __builtin_amdgcn_s_sleep(1); \
    if ((++_sp & 255u) == 0u) { if (xb_ld(&(bar)[XB_TMO])) break; if (_sp > XB_SPIN_CAP) { atomicAdd(&(bar)[XB_TMO], 1u); break; } } } } while (0)

struct XcdBarrier {
    unsigned* bar; unsigned x;
    volatile LAS unsigned* st;
};

__device__ __forceinline__ XcdBarrier xcd_barrier_post(unsigned* bar, volatile LAS unsigned* st) {
    XcdBarrier b; b.bar = bar; b.x = xb_xcc_id(); b.st = st;
    if (threadIdx.x == 0) (void)xb_add(&bar[XB_XCNT(b.x)], 1u);
    return b;
}
__device__ __forceinline__ void xcd_barrier_complete(unsigned* bar, unsigned x, unsigned& nloc, unsigned& nx) {
    const unsigned G = gridDim.x * gridDim.y * gridDim.z;
    unsigned sum, cnt, mine, sp = 0u;
    for (;;) {
        sum = 0u; cnt = 0u; mine = 0u;
#pragma unroll
        for (unsigned j = 0; j < 16; ++j) { const unsigned c = xb_ld(&bar[XB_XCNT(j)]); sum += c; cnt += (c > 0u) ? 1u : 0u; mine = (j == x) ? c : mine; }
        if (sum == G) break;
        __builtin_amdgcn_s_sleep(1);
        if ((++sp & 255u) == 0u) { if (xb_ld(&bar[XB_TMO])) break; if (sp > XB_SPIN_CAP) { atomicAdd(&bar[XB_TMO], 1u); break; } }
    }
    nloc = mine > 0u ? mine : 1u; nx = cnt > 0u ? cnt : 1u;
}

__device__ __forceinline__ void xcd_barrier(const XcdBarrier& b) {
    asm volatile("s_waitcnt vmcnt(0)" ::: "memory");
    __syncthreads();
    if (threadIdx.x == 0) {
        unsigned* bar = b.bar;
        __builtin_amdgcn_s_waitcnt(0);
        unsigned nloc = b.st[0], nx = b.st[1];
        if (nloc == 0u) { xcd_barrier_complete(bar, b.x, nloc, nx); b.st[0] = nloc; b.st[1] = nx; }
        const unsigned old = xb_add(&bar[XB_XSUB(b.x)], 1u);
        const unsigned gen = old / nloc;
        if (old + 1u == (gen + 1u) * nloc) {
            __builtin_amdgcn_fence(__ATOMIC_RELEASE, "agent");
            asm volatile("s_waitcnt vmcnt(0)" ::: "memory");
            const unsigned og = xb_add(&bar[XB_TOP], 1u);
            const unsigned tg = og / nx;
            if (og + 1u == (tg + 1u) * nx) xb_add(&bar[XB_TOPGEN], 1u);
            else XB_SPIN(xb_ld(&bar[XB_TOPGEN]) == tg, bar);
            __builtin_amdgcn_fence(__ATOMIC_ACQUIRE, "agent");
            xb_add(&bar[XB_XGEN(b.x)], 1u);
            asm volatile("s_waitcnt vmcnt(0)" ::: "memory");
        } else {
            XB_SPIN(xb_ld(&bar[XB_XGEN(b.x)]) == gen, bar);
            __builtin_amdgcn_fence(__ATOMIC_ACQUIRE, "agent");
            asm volatile("s_waitcnt vmcnt(0)" ::: "memory");
        }
    }
    __syncthreads();
}


__device__ __forceinline__ void tr_item(const GAS float* W, int ldw, int k0, int src_n0, GAS bf16_t* WT, int K, int dst_row0, LAS float* scr, int lane) {
#pragma unroll 8
    for (int i = 0; i < 32; ++i) { const int kk = 2 * i + (lane >> 5); scr[kk * 33 + (lane & 31)] = W[(size_t)(k0 + kk) * ldw + src_n0 + (lane & 31)]; }
    asm volatile("s_waitcnt lgkmcnt(0)" ::: "memory");
    const int c = lane & 7;
#pragma unroll
    for (int j = 0; j < 4; ++j) { const int n = (lane >> 3) + 8 * j; const LAS float* s = scr + (8 * c) * 33 + n;
        u32x4 o; o.x = cvt_pk(s[0 * 33], s[1 * 33]); o.y = cvt_pk(s[2 * 33], s[3 * 33]); o.z = cvt_pk(s[4 * 33], s[5 * 33]); o.w = cvt_pk(s[6 * 33], s[7 * 33]);
        *(GAS u32x4*)(WT + (size_t)(dst_row0 + n) * K + k0 + 8 * c) = o; }
    asm volatile("s_waitcnt lgkmcnt(0)" ::: "memory");
}
__device__ __forceinline__ void weights_phase(const PArgs& a, LAS unsigned char* lds, int wave, int lane) {
    LAS float* scr = (LAS float*)(lds + wave * 16384);
    const int gw = blockIdx.x * NWAVES + wave, NGW = gridDim.x * NWAVES;
    constexpr int I_IN = 32 * 192, I_OUT = 32 * 64, I_G = 32 * 176, I_DN = 88 * 64, I_LAYER = I_IN + I_OUT + 2 * I_G + I_DN;
    for (int it = gw; it < 2 * I_LAYER; it += NGW) {
        const int l = it / I_LAYER; int r = it - l * I_LAYER;
        if (r < I_IN) { const int kb = r / 192, nb = r % 192, d0 = nb * 32; tr_item(a.win + (size_t)l * D * DIN, DIN, kb * 64, d0 + (d0 >= 3072 ? 8 : 0), (GAS bf16_t*)(a.ws + WS_WT_IN + l * SZ_WT_IN), D, d0, scr, lane); continue; } r -= I_IN;
        if (r < I_OUT) { const int kb = r / 64, nb = r % 64; tr_item(a.wout + (size_t)l * D * D, D, kb * 64, nb * 32, (GAS bf16_t*)(a.ws + WS_WT_OUT + l * SZ_WT_OUT), D, nb * 32, scr, lane); continue; } r -= I_OUT;
        if (r < I_G) { const int kb = r / 176, nb = r % 176, n0 = nb * 32; tr_item(a.wg + (size_t)l * D * DFF, DFF, kb * 64, n0, (GAS bf16_t*)(a.ws + WS_WT_GU + l * SZ_WT_GU), D, (n0 >> 7) * 256 + (n0 & 127), scr, lane); continue; } r -= I_G;
        if (r < I_G) { const int kb = r / 176, nb = r % 176, n0 = nb * 32; tr_item(a.wu + (size_t)l * D * DFF, DFF, kb * 64, n0, (GAS bf16_t*)(a.ws + WS_WT_GU + l * SZ_WT_GU), D, (n0 >> 7) * 256 + 128 + (n0 & 127), scr, lane); continue; } r -= I_G;
        { const int kb = r / 64, nb = r % 64; tr_item(a.wd + (size_t)l * DFF * D, D, kb * 64, nb * 32, (GAS bf16_t*)(a.ws + WS_WT_DN + l * SZ_WT_DN), DFF, nb * 32, scr, lane); }
    }
}

template <int MODE>
__device__ __forceinline__ void norm_phase(const PArgs& a, int layer, LAS unsigned char* lds, int wave, int lane) {
    const GAS float* nw = MODE <= 1 ? a.nmw + layer * D : (MODE == 2 ? a.nfw + layer * D : a.nfin);
    LAS float* WG = (LAS float*)lds;
    if (MODE <= 1) {
        const GAS float* wsrc = a.win + (size_t)layer * D * DIN + 3072;
        for (int k = wave * 64 + lane; k < D; k += NTHREADS) { const f32x4 g0 = *(const GAS f32x4*)(wsrc + (size_t)k * DIN), g1 = *(const GAS f32x4*)(wsrc + (size_t)k * DIN + 4);
            WG[0 * D + k] = g0[0]; WG[1 * D + k] = g0[1]; WG[2 * D + k] = g0[2]; WG[3 * D + k] = g0[3]; WG[4 * D + k] = g1[0]; WG[5 * D + k] = g1[1]; WG[6 * D + k] = g1[2]; WG[7 * D + k] = g1[3]; }
        __syncthreads();
    }
    GAS bf16_t* XA = (GAS bf16_t*)(a.ws + WS_XA); GAS float* LI = (GAS float*)(a.ws + WS_LI); GAS float* LF = (GAS float*)(a.ws + WS_LF);
    const int gw = blockIdx.x * NWAVES + wave, NGW = gridDim.x * NWAVES;
    f32x4 w[8];
#pragma unroll
    for (int j = 0; j < 8; ++j) w[j] = *((const GAS f32x4*)nw + lane + 64 * j);
    for (int m = gw; m < (MODE == 3 ? MREAL : MTOT); m += NGW) {
        const GAS float* src = MODE == 0 ? (m < MREAL ? a.x + (size_t)m * D : a.meta + (size_t)((m - MREAL) & 15) * D) : hrow(a, m);
        f32x4 v[8]; float ss = 0.f;
#pragma unroll
        for (int j = 0; j < 8; ++j) { v[j] = *((const GAS f32x4*)src + lane + 64 * j); ss += (v[j][0] * v[j][0] + v[j][1] * v[j][1]) + (v[j][2] * v[j][2] + v[j][3] * v[j][3]); }
        if (MODE == 0) { GAS float* hp = hrow(a, m);
#pragma unroll
            for (int j = 0; j < 8; ++j) *((GAS f32x4*)hp + lane + 64 * j) = v[j]; }
        const float rstd = rsqrtf(wave_sum(ss) * (1.0f / D) + EPS);
#pragma unroll
        for (int j = 0; j < 8; ++j) v[j] = v[j] * rstd * w[j];
        if (MODE == 3) { GAS float* op = a.out + (size_t)m * D;
#pragma unroll
            for (int j = 0; j < 8; ++j) *((GAS f32x4*)op + lane + 64 * j) = v[j];
        } else { GAS bf16_t* op = XA + (size_t)m * D;
#pragma unroll
            for (int j = 0; j < 8; ++j) { u32x2 o; o.x = cvt_pk(v[j][0], v[j][1]); o.y = cvt_pk(v[j][2], v[j][3]); *((GAS u32x2*)op + lane + 64 * j) = o; } }
        if (MODE <= 1) {
            float mine = 0.f;
#pragma unroll
            for (int g = 0; g < 8; ++g) { float s = 0.f;
#pragma unroll
                for (int j = 0; j < 8; ++j) { const f32x4 wg = *((const LAS f32x4*)(WG + g * D) + lane + 64 * j); s += (v[j][0] * wg[0] + v[j][1] * wg[1]) + (v[j][2] * wg[2] + v[j][3] * wg[3]); }
                s = wave_sum(s); mine = (lane == g) ? s : mine; }
            if (lane < 8) { const float raw = mine + a.bg[layer * 8 + lane]; const float e2 = __expf(raw * (2.0f / GATE_CAP)); const float cp = GATE_CAP * (e2 - 1.0f) / (e2 + 1.0f);
                if (lane < 4) LI[m * 4 + lane] = cp; else LF[m * 4 + lane - 4] = fminf(cp, 0.f) - __logf(1.0f + __expf(-fabsf(cp))); }
        }
    }
}

__device__ __forceinline__ bf16x8 pack8(const f32x4& x, const f32x4& y) {
    u32x4 w; w.x = cvt_pk(x[0], x[1]); w.y = cvt_pk(x[2], x[3]); w.z = cvt_pk(y[0], y[1]); w.w = cvt_pk(y[2], y[3]); return __builtin_bit_cast(bf16x8, w);
}
typedef short v4i16_t __attribute__((ext_vector_type(4)));
__device__ __forceinline__ s16x4 lds_tr(LAS unsigned char* p) { return __builtin_bit_cast(s16x4, __builtin_amdgcn_ds_read_tr16_b64_v4i16((LAS v4i16_t*)p)); }
#define MFMA16(x, y, c) __builtin_amdgcn_mfma_f32_16x16x32_bf16((x), (y), (c), 0, 0, 0)
constexpr int KIMG_STRIDE = 288, KIMG_BYTES = 64 * KIMG_STRIDE, MWAVE_BYTES = 2 * KIMG_BYTES + 1024;
constexpr int MLSTM_WAVES = 3;

__device__ __forceinline__ void mlstm_item(const PArgs& a, int bh, int sl, LAS unsigned char* kbase, int lane_in) {
    const GAS bf16_t* proj = (const GAS bf16_t*)(a.ws + WS_PROJ);
    const GAS float* LI = (const GAS float*)(a.ws + WS_LI); const GAS float* LF = (const GAS float*)(a.ws + WS_LF);
    GAS bf16_t* NUM = (GAS bf16_t*)(a.ws + WS_NUM); GAS float* DEN = (GAS float*)(a.ws + WS_DEN); GAS float* MT = (GAS float*)(a.ws + WS_MT);
    LAS float* sc = (LAS float*)(kbase + 2 * KIMG_BYTES);
    const int b = bh >> 2, hd = bh & 3;
    const bool den_item = (sl == 16);
    int lane = lane_in; asm volatile("" : "+v"(lane));
    int fr = lane & 15, fq = lane >> 4;
    int vcol = C_V + hd * 256 + (den_item ? 0 : sl * 16) + fr;
    f32x4 C[8];
#pragma unroll
    for (int i = 0; i < 8; ++i) C[i] = (f32x4){0.f, 0.f, 0.f, 0.f};
    float m_st = 0.f;
#define ROWOF(cc, p) ((cc) == 0 ? (MREAL + ((p) < 48 ? 0 : (p) - 48)) : (b * SEQ + ((cc) - 1) * 64 + (p)))
    unsigned vpre[8]; float lfpre, lipre; bf16x8 qpre[4];
#define K_DMA(cc, buf) do { LAS unsigned char* kd_ = kbase + (buf) * KIMG_BYTES; \
        _Pragma("unroll") for (int j = 0; j < 18; ++j) { const int g_ = j * 64 + lane, row_ = g_ / 18, col_ = g_ - row_ * 18; \
            const GAS bf16_t* src_ = proj + (size_t)ROWOF(cc, row_) * NPROJ + C_K + hd * 128 + (col_ < 16 ? col_ : 15) * 8; \
            __builtin_amdgcn_global_load_lds((const GAS unsigned*)src_, (LAS unsigned*)(kd_ + j * 1024), 16, 0, 0); } } while (0)
#define LOAD_CHUNK(cc) do { \
        _Pragma("unroll") for (int i = 0; i < 8; ++i) { const int s0_ = 32 * (i >> 2) + 16 * ((i >> 1) & 1) + 4 * fq + 2 * (i & 1); \
            const unsigned lo_ = den_item ? 0u : (unsigned)proj[(size_t)ROWOF(cc, s0_) * NPROJ + vcol], hi_ = den_item ? 0u : (unsigned)proj[(size_t)ROWOF(cc, s0_ + 1) * NPROJ + vcol]; vpre[i] = lo_ | (hi_ << 16); } \
        { const int rl_ = ROWOF(cc, lane); lfpre = LF[rl_ * 4 + hd]; lipre = LI[rl_ * 4 + hd]; } } while (0)
#define LOAD_Q(cc, tb_) do { const GAS bf16_t* rp_ = proj + (size_t)ROWOF(cc, (tb_) * 16 + fr) * NPROJ + C_Q + hd * 128 + fq * 4; \
        _Pragma("unroll") for (int kc = 0; kc < 4; ++kc) { const s16x4 lo_ = *(const GAS s16x4*)(rp_ + 32 * kc), hi_ = *(const GAS s16x4*)(rp_ + 32 * kc + 16); qpre[kc] = __builtin_shufflevector(lo_, hi_, 0, 1, 2, 3, 4, 5, 6, 7); } } while (0)
    K_DMA(0, 0); LOAD_CHUNK(0); LOAD_Q(0, 0);
    asm volatile("s_waitcnt vmcnt(0)" ::: "memory");
#pragma unroll 1
    for (int c = 0; c < NCHUNK; ++c) {
        const int cn = c + 1 < NCHUNK ? c + 1 : c;
        asm volatile("" : "+v"(lane)); fr = lane & 15; fq = lane >> 4; vcol = C_V + hd * 256 + (den_item ? 0 : sl * 16) + fr;
        float w_old, m_new;
        {
            float lf = lfpre, li = lipre;
            if (c == 0 && lane < 48) { lf = 0.f; li = -1e30f; }
            float bc = lf;
#pragma unroll
            for (int o = 1; o < 64; o <<= 1) { const float t = __shfl_up(bc, o); bc += (lane >= o) ? t : 0.f; }
            const float b_end = __shfl(bc, 63);
            const float decay = b_end - bc + li;
            m_new = fmaxf(b_end + m_st, wave_max(decay));
            w_old = __expf(b_end + m_st - m_new);
            sc[lane] = li - bc; sc[64 + lane] = __expf(decay - m_new); sc[128 + lane] = bc;
        }
        LAS unsigned char* kimg = kbase + (c & 1) * KIMG_BYTES;
        K_DMA(cn, (c + 1) & 1);
        unsigned vraw[8];
#pragma unroll
        for (int i = 0; i < 8; ++i) vraw[i] = vpre[i];
        asm volatile("s_waitcnt lgkmcnt(0)" ::: "memory");
        LOAD_CHUNK(cn);
        bf16x8 vf[2], wvf[2];
#pragma unroll
        for (int ks = 0; ks < 2; ++ks) { float vv[8]; u32x4 vw;
#pragma unroll
            for (int h = 0; h < 2; ++h) { const f32x4 wi = *(const LAS f32x4*)(sc + 64 + 32 * ks + 16 * h + 4 * fq);
                unsigned w0 = vraw[4 * ks + 2 * h], w1 = vraw[4 * ks + 2 * h + 1];
                if (den_item) { w0 = w1 = (fr == 0) ? 0x3F803F80u : 0u; }
                vw[2 * h] = w0; vw[2 * h + 1] = w1;
                vv[4 * h + 0] = bflo(w0) * wi[0]; vv[4 * h + 1] = bfhi(w0) * wi[1]; vv[4 * h + 2] = bflo(w1) * wi[2]; vv[4 * h + 3] = bfhi(w1) * wi[3]; }
            vf[ks] = __builtin_bit_cast(bf16x8, vw);
            wvf[ks] = pack8((f32x4){vv[0], vv[1], vv[2], vv[3]}, (f32x4){vv[4], vv[5], vv[6], vv[7]}); }
        bf16x8 cf[4];
#pragma unroll
        for (int kc = 0; kc < 4; ++kc) cf[kc] = pack8(C[2 * kc], C[2 * kc + 1]);
#pragma unroll
        for (int tb = 0; tb < 4; ++tb) {
            const int t = tb * 16 + fr;
            bf16x8 qf[4];
#pragma unroll
            for (int kc = 0; kc < 4; ++kc) qf[kc] = qpre[kc];
            if (tb < 3) LOAD_Q(c, tb + 1); else LOAD_Q(cn, 0);
            f32x4 S[4];
#pragma unroll
            for (int sb = 0; sb < 4; ++sb) { f32x4 acc = (f32x4){0.f, 0.f, 0.f, 0.f}; const LAS unsigned char* kp = kimg + (sb * 16 + fr) * KIMG_STRIDE + fq * 8;
#pragma unroll
                for (int kc = 0; kc < 4; ++kc) { const s16x4 lo = *(const LAS s16x4*)(kp + 64 * kc), hi = *(const LAS s16x4*)(kp + 64 * kc + 32);
                    acc = MFMA16(__builtin_shufflevector(lo, hi, 0, 1, 2, 3, 4, 5, 6, 7), qf[kc], acc); }
                S[sb] = acc; }
            const float bt = sc[128 + t];
            f32x4 gs[4];
#pragma unroll
            for (int sb = 0; sb < 4; ++sb) gs[sb] = *(const LAS f32x4*)(sc + sb * 16 + 4 * fq);
            float dmax = -1e30f;
#pragma unroll
            for (int sb = 0; sb < 4; ++sb)
#pragma unroll
                for (int jj = 0; jj < 4; ++jj) { const int s = sb * 16 + fq * 4 + jj; const float d = (s <= t) ? bt + gs[sb][jj] : -1e30f; dmax = fmaxf(dmax, d); }
            dmax = fmaxf(dmax, __shfl_xor(dmax, 16)); dmax = fmaxf(dmax, __shfl_xor(dmax, 32));
            const float inter = bt + m_st, mt = fmaxf(inter, dmax);
            sc[192 + t] = __expf(inter - mt);
#pragma unroll
            for (int sb = 0; sb < 4; ++sb)
#pragma unroll
                for (int jj = 0; jj < 4; ++jj) { const int s = sb * 16 + fq * 4 + jj; const float e = (s <= t) ? __expf(bt + gs[sb][jj] - mt) : 0.f; S[sb][jj] *= e; }
            f32x4 nm = (f32x4){0.f, 0.f, 0.f, 0.f};
#pragma unroll
            for (int kc = 0; kc < 4; ++kc) nm = MFMA16(qf[kc], cf[kc], nm);
            nm = nm * *(const LAS f32x4*)(sc + 192 + tb * 16 + 4 * fq);
#pragma unroll
            for (int ks = 0; ks < 2; ++ks) nm = MFMA16(pack8(S[2 * ks], S[2 * ks + 1]), vf[ks], nm);
            if (tb == 2) asm volatile("s_waitcnt vmcnt(0)" ::: "memory");
#pragma unroll
            for (int jj = 0; jj < 4; ++jj) { const int tt = tb * 16 + fq * 4 + jj;
                if (c > 0 || (tt >= 48 && b == 0)) { const int row = ROWOF(c, tt);
                    if (!den_item) NUM[(size_t)row * 1024 + hd * 256 + sl * 16 + fr] = (bf16_t)(cvt_pk(nm[jj], 0.f) & 0xffffu);
                    else if (fr == 0) DEN[row * 4 + hd] = nm[jj]; } }
            if (den_item && fq == 0 && (c > 0 || (t >= 48 && b == 0))) MT[ROWOF(c, t) * 4 + hd] = mt;
        }
#pragma unroll
        for (int dt = 0; dt < 8; ++dt) { f32x4 cc = C[dt] * w_old;
#pragma unroll
            for (int ks = 0; ks < 2; ++ks) { LAS unsigned char* tp = kimg + (32 * ks + 4 * fq + (fr >> 2)) * KIMG_STRIDE + (dt * 16 + 4 * (fr & 3)) * 2;
                const s16x4 lo = lds_tr(tp), hi = lds_tr(tp + 16 * KIMG_STRIDE);
                cc = MFMA16(__builtin_shufflevector(lo, hi, 0, 1, 2, 3, 4, 5, 6, 7), wvf[ks], cc); }
            C[dt] = cc; }
        m_st = m_new;
        asm volatile("s_waitcnt lgkmcnt(0)" ::: "memory");
    }
#undef ROWOF
#undef LOAD_CHUNK
#undef K_DMA
#undef LOAD_Q
}
__device__ __forceinline__ void mlstm_phase(const PArgs& a, LAS unsigned char* lds, int wave, int lane) {
    if (wave >= MLSTM_WAVES) return;
    LAS unsigned char* kbase = lds + wave * MWAVE_BYTES;
    for (int it = wave * (int)gridDim.x + (int)blockIdx.x; it < 32 * 17; it += MLSTM_WAVES * (int)gridDim.x) mlstm_item(a, it / 17, it % 17, kbase, lane);
}


template <int NSTEP>
__device__ __forceinline__ f32x4 mini_dot(const GAS bf16_t* Ar, const GAS bf16_t* Br) {
    f32x4 acc = (f32x4){0.f, 0.f, 0.f, 0.f};
#pragma unroll
    for (int s0 = 0; s0 < NSTEP; s0 += 8) { constexpr int dummy = 0; (void)dummy; bf16x8 av[8], bv[8];
#pragma unroll
        for (int i = 0; i < 8; ++i) if (s0 + i < NSTEP) { av[i] = *(const GAS bf16x8*)(Ar + 32 * (s0 + i)); bv[i] = *(const GAS bf16x8*)(Br + 32 * (s0 + i)); }
#pragma unroll
        for (int i = 0; i < 8; ++i) if (s0 + i < NSTEP) acc = MFMA16(bv[i], av[i], acc); }
    return acc;
}
template <int WHICH>
__device__ __forceinline__ void mini_gemm(const PArgs& a, int l, LAS unsigned char* lds, int wave, int lane) {
    const int fr = lane & 15, fq = lane >> 4, G = gridDim.x;
    const GAS bf16_t* XA = (const GAS bf16_t*)(a.ws + WS_XA); GAS bf16_t* PROJ = (GAS bf16_t*)(a.ws + WS_PROJ); GAS float* hm = (GAS float*)(a.ws + WS_HMETA);
    LAS f32x4* red = (LAS f32x4*)lds;
    constexpr int NT = WHICH == 1 ? NPROJ / 16 : (WHICH == 3 ? DFF / 16 : D / 16);
    constexpr int K = WHICH == 4 ? DFF : D, KS = K / 8, NSTEP = KS / 32;
    for (int t = (int)blockIdx.x; t < NT; t += G) {
        const int n0 = t * 16;
        const GAS bf16_t* Ar = (WHICH == 4 ? (const GAS bf16_t*)PROJ : XA) + (size_t)(MREAL + fr) * K + wave * KS + 8 * fq;
        const GAS bf16_t* Wt = (const GAS bf16_t*)(a.ws + (WHICH == 1 ? WS_WT_IN + l * SZ_WT_IN : WHICH == 2 ? WS_WT_OUT + l * SZ_WT_OUT : WHICH == 3 ? WS_WT_GU + l * SZ_WT_GU : WS_WT_DN + l * SZ_WT_DN));
        const int r0 = WHICH == 3 ? (n0 >> 7) * 256 + (n0 & 127) : n0;
        red[wave * 64 + lane] = mini_dot<NSTEP>(Ar, Wt + (size_t)(r0 + fr) * K + wave * KS + 8 * fq);
        if (WHICH == 3) red[512 + wave * 64 + lane] = mini_dot<NSTEP>(Ar, Wt + (size_t)(r0 + 128 + fr) * K + wave * KS + 8 * fq);
        __syncthreads();
        if (wave == 0) {
            f32x4 acc = red[lane], up = (f32x4){0.f, 0.f, 0.f, 0.f};
#pragma unroll
            for (int w = 1; w < 8; ++w) acc = acc + red[w * 64 + lane];
            if (WHICH == 3) { up = red[512 + lane];
#pragma unroll
                for (int w = 1; w < 8; ++w) up = up + red[512 + w * 64 + lane]; }
            if (WHICH == 1) { if (n0 < C_K) acc = acc * 0.08838834764831845f;
                u32x2 o; o.x = cvt_pk(acc[0], acc[1]); o.y = cvt_pk(acc[2], acc[3]); *(GAS u32x2*)(PROJ + (size_t)(MREAL + fr) * NPROJ + n0 + 4 * fq) = o; }
            if (WHICH == 2 || WHICH == 4) { GAS f32x4* hp = (GAS f32x4*)(hm + (size_t)fr * D + n0 + 4 * fq); *hp = *hp + acc; }
            if (WHICH == 3) { float r[4];
#pragma unroll
                for (int j = 0; j < 4; ++j) r[j] = acc[j] * up[j] * __builtin_amdgcn_rcpf(1.0f + __expf(-acc[j]));
                u32x2 o; o.x = cvt_pk(r[0], r[1]); o.y = cvt_pk(r[2], r[3]); *(GAS u32x2*)(PROJ + (size_t)(MREAL + fr) * DFF + n0 + 4 * fq) = o; }
        }
        __syncthreads();
    }
}

__device__ __forceinline__ void cat_phase(const PArgs& a, int layer, int wave, int lane) {
    const GAS bf16_t* proj = (const GAS bf16_t*)(a.ws + WS_PROJ); const GAS bf16_t* NUM = (const GAS bf16_t*)(a.ws + WS_NUM);
    const GAS float* DEN = (const GAS float*)(a.ws + WS_DEN); const GAS float* MT = (const GAS float*)(a.ws + WS_MT);
    GAS bf16_t* XA = (GAS bf16_t*)(a.ws + WS_XA);
    const GAS float* mnw = a.mnw + layer * 1024; const GAS float* cw = a.cw + layer * 3 * 1024;
    const int gw = blockIdx.x * NWAVES + wave, NGW = gridDim.x * NWAVES;
    for (int m = gw; m < MTOT; m += NGW) {
        int p1, p2;
        if (m < MREAL) { const int t = m & (SEQ - 1); p1 = t >= 1 ? m - 1 : MREAL + 15; p2 = t >= 2 ? m - 2 : MREAL + 14 + t; }
        else { const int j = (m - MREAL) & 15; p1 = j >= 1 ? m - 1 : -1; p2 = j >= 2 ? m - 2 : -1; }
        const GAS bf16_t* pr = proj + (size_t)m * NPROJ; const GAS bf16_t* pr1 = proj + (size_t)(p1 < 0 ? m : p1) * NPROJ; const GAS bf16_t* pr2 = proj + (size_t)(p2 < 0 ? m : p2) * NPROJ;
        const float z1 = p1 < 0 ? 0.f : 1.f, z2 = p2 < 0 ? 0.f : 1.f;
#pragma unroll
        for (int j = 0; j < 4; ++j) {
            const int c = lane * 4 + 256 * j;
            const u32x2 nv = *(const GAS u32x2*)(NUM + (size_t)m * 1024 + c);
            const float den = DEN[m * 4 + j], mt = MT[m * 4 + j];
            const float sc = 1.0f / fmaxf(fabsf(den), __expf(-mt));
            float h0 = bflo(nv.x) * sc, h1 = bfhi(nv.x) * sc, h2 = bflo(nv.y) * sc, h3 = bfhi(nv.y) * sc;
            const float r = rsqrtf(wave_sum((h0 * h0 + h1 * h1) + (h2 * h2 + h3 * h3)) * (1.0f / DV) + EPS);
            const f32x4 w4 = *(const GAS f32x4*)(mnw + c);
            const u32x2 ogv = *(const GAS u32x2*)(pr + C_OG + c);
            const float s0 = 1.0f / (1.0f + __expf(-bflo(ogv.x))), s1 = 1.0f / (1.0f + __expf(-bfhi(ogv.x))), s2 = 1.0f / (1.0f + __expf(-bflo(ogv.y))), s3 = 1.0f / (1.0f + __expf(-bfhi(ogv.y)));
            u32x2 o; o.x = cvt_pk(s0 * h0 * r * w4[0], s1 * h1 * r * w4[1]); o.y = cvt_pk(s2 * h2 * r * w4[2], s3 * h3 * r * w4[3]);
            *(GAS u32x2*)(XA + (size_t)m * D + c) = o;
            const u32x2 u0 = *(const GAS u32x2*)(pr + C_U + c), g0 = *(const GAS u32x2*)(pr + C_GC + c), gb = *(const GAS u32x2*)(pr + C_GB + c);
            const u32x2 u1 = *(const GAS u32x2*)(pr1 + C_U + c), g1 = *(const GAS u32x2*)(pr1 + C_GC + c), u2 = *(const GAS u32x2*)(pr2 + C_U + c), g2 = *(const GAS u32x2*)(pr2 + C_GC + c);
            const f32x4 k0 = *(const GAS f32x4*)(cw + c), k1 = *(const GAS f32x4*)(cw + 1024 + c), k2 = *(const GAS f32x4*)(cw + 2048 + c);
            float cv[4];
            cv[0] = z2 * bflo(u2.x) * bflo(g2.x) * k0[0] + z1 * bflo(u1.x) * bflo(g1.x) * k1[0] + bflo(u0.x) * bflo(g0.x) * k2[0];
            cv[1] = z2 * bfhi(u2.x) * bfhi(g2.x) * k0[1] + z1 * bfhi(u1.x) * bfhi(g1.x) * k1[1] + bfhi(u0.x) * bfhi(g0.x) * k2[1];
            cv[2] = z2 * bflo(u2.y) * bflo(g2.y) * k0[2] + z1 * bflo(u1.y) * bflo(g1.y) * k1[2] + bflo(u0.y) * bflo(g0.y) * k2[2];
            cv[3] = z2 * bfhi(u2.y) * bfhi(g2.y) * k0[3] + z1 * bfhi(u1.y) * bfhi(g1.y) * k1[3] + bfhi(u0.y) * bfhi(g0.y) * k2[3];
            u32x2 oc; oc.x = cvt_pk(bflo(gb.x) * cv[0], bfhi(gb.x) * cv[1]); oc.y = cvt_pk(bflo(gb.y) * cv[2], bfhi(gb.y) * cv[3]);
            *(GAS u32x2*)(XA + (size_t)m * D + 1024 + c) = oc;
        }
    }
}

#ifndef MK_PER_PHASE
#define MK_PER_PHASE 0
#endif

__device__ __forceinline__ PArgs launder(const Args& s) { Args r = s;
    asm volatile("" : "+s"(r.x), "+s"(r.meta), "+s"(r.nmw), "+s"(r.win), "+s"(r.bg), "+s"(r.cw), "+s"(r.mnw), "+s"(r.wout), "+s"(r.nfw), "+s"(r.wg), "+s"(r.wu), "+s"(r.wd), "+s"(r.nfin), "+s"(r.out), "+s"(r.ws));
    PArgs q; q.x = (const GAS float*)r.x; q.meta = (const GAS float*)r.meta; q.nmw = (const GAS float*)r.nmw; q.win = (const GAS float*)r.win; q.bg = (const GAS float*)r.bg; q.cw = (const GAS float*)r.cw;
    q.mnw = (const GAS float*)r.mnw; q.wout = (const GAS float*)r.wout; q.nfw = (const GAS float*)r.nfw; q.wg = (const GAS float*)r.wg; q.wu = (const GAS float*)r.wu; q.wd = (const GAS float*)r.wd; q.nfin = (const GAS float*)r.nfin;
    q.out = (GAS float*)r.out; q.ws = (GAS unsigned char*)r.ws;
    return q; }
constexpr int N_PHASES = 17;

__global__ void __launch_bounds__(NTHREADS, 2) hymba_fwd(Args a_in) {
    extern __shared__ __attribute__((aligned(16))) unsigned char lds_raw[];
    LAS unsigned char* lds = (LAS unsigned char*)lds_raw;
    const int wave = __builtin_amdgcn_readfirstlane(threadIdx.x >> 6);
#define LANE() ({ int l_; asm volatile("v_mbcnt_lo_u32_b32 %0, -1, 0\n\tv_mbcnt_hi_u32_b32 %0, -1, %0" : "=v"(l_)); l_; })
    const int G = gridDim.x, bid = blockIdx.x;
    const int lo = a_in.ph_lo, hi = a_in.ph_hi;
    volatile LAS unsigned* MISC = (volatile LAS unsigned*)(lds + 131072);
    XcdBarrier bar; bar.bar = (unsigned*)(a_in.ws + WS_CTL); bar.x = 0; bar.st = MISC + 8;
    if (hi - lo > 1) { if (threadIdx.x < 64) MISC[threadIdx.x] = 0u; __syncthreads(); bar = xcd_barrier_post((unsigned*)(a_in.ws + WS_CTL), MISC + 8); }
#define IN(k) (lo <= (k) && (k) < hi)
#ifndef PROBE
#define PROBE 0
#endif
#define DUP(n) for (int rep_ = 0; rep_ < ((PROBE == (n)) ? 2 : 1); ++rep_)
#define SEAM(k) do { if (IN(k) && IN((k) + 1)) { if ((k) == 0) cg::this_grid().sync(); else xcd_barrier(bar); if (PROBE == 9) xcd_barrier(bar); } } while (0)
    if (IN(0)) { const PArgs a = launder(a_in); DUP(1) { weights_phase(a, lds, wave, LANE()); __syncthreads(); } norm_phase<0>(a, 0, lds, wave, LANE()); __syncthreads(); }
    SEAM(0);
#pragma unroll
    for (int l = 0; l < 2; ++l) {
        const int p0 = 1 + 8 * l;
        if (IN(p0 + 0)) DUP(2) { const PArgs a = launder(a_in); pg8::Gemm g{(const bf16_t*)(const unsigned char*)(a.ws + WS_XA), (const bf16_t*)(const unsigned char*)(a.ws + WS_WT_IN + l * SZ_WT_IN), MREAL, NPROJ, D}; pg8::StaticOrder S; S.init(MREAL, NPROJ, G, bid);
            EpiProj E{(GAS bf16_t*)(a.ws + WS_PROJ)}; pg8::gemm_phase<EpiProj, pg8::StaticOrder, true, true>(lds, g, S, E, wave); mini_gemm<1>(a, l, lds, wave, LANE()); }
        SEAM(p0 + 0);
        if (IN(p0 + 1)) DUP(3) { const PArgs a = launder(a_in); mlstm_phase(a, lds, wave, LANE()); __syncthreads(); }
        SEAM(p0 + 1);
        if (IN(p0 + 2)) DUP(4) { const PArgs a = launder(a_in); cat_phase(a, l, wave, LANE()); }
        SEAM(p0 + 2);
        if (IN(p0 + 3)) { const PArgs a = launder(a_in); pg8::Gemm g{(const bf16_t*)(const unsigned char*)(a.ws + WS_XA), (const bf16_t*)(const unsigned char*)(a.ws + WS_WT_OUT + l * SZ_WT_OUT), MREAL, D, D}; pg8::StaticOrder S; S.init(MREAL, D, G, bid);
            EpiResid E{a.out, (GAS float*)(a.ws + WS_HMETA)}; pg8::gemm_phase<EpiResid, pg8::StaticOrder, true, true>(lds, g, S, E, wave); mini_gemm<2>(a, l, lds, wave, LANE()); }
        SEAM(p0 + 3);
        if (IN(p0 + 4)) DUP(5) { const PArgs a = launder(a_in); norm_phase<2>(a, l, lds, wave, LANE()); }
        SEAM(p0 + 4);
        if (IN(p0 + 5)) DUP(6) { const PArgs a = launder(a_in); pg8::Gemm g{(const bf16_t*)(const unsigned char*)(a.ws + WS_XA), (const bf16_t*)(const unsigned char*)(a.ws + WS_WT_GU + l * SZ_WT_GU), MREAL, NGU, D}; pg8::StaticOrder S; S.init(MREAL, NGU, G, bid);
            EpiSwiglu E{(GAS bf16_t*)(a.ws + WS_PROJ)}; pg8::gemm_phase<EpiSwiglu, pg8::StaticOrder, true, true>(lds, g, S, E, wave); mini_gemm<3>(a, l, lds, wave, LANE()); }
        SEAM(p0 + 5);
        if (IN(p0 + 6)) { const PArgs a = launder(a_in); pg8::Gemm g{(const bf16_t*)(const unsigned char*)(a.ws + WS_PROJ), (const bf16_t*)(const unsigned char*)(a.ws + WS_WT_DN + l * SZ_WT_DN), MREAL, D, DFF}; pg8::StaticOrder S; S.init(MREAL, D, G, bid);
            EpiResid E{a.out, (GAS float*)(a.ws + WS_HMETA)}; pg8::gemm_phase<EpiResid, pg8::StaticOrder, true, true>(lds, g, S, E, wave); mini_gemm<4>(a, l, lds, wave, LANE()); }
        SEAM(p0 + 6);
        if (IN(p0 + 7)) { const PArgs a = launder(a_in); if (l == 0) { norm_phase<1>(a, 1, lds, wave, LANE()); __syncthreads(); } else norm_phase<3>(a, 0, lds, wave, LANE()); }
        if (l == 0) SEAM(p0 + 7);
    }
#undef IN
#undef SEAM
}

extern "C" void kernel_launch(void* const* d_in, const int* in_sizes, int n_in, void* d_out, int out_size, void* d_ws, size_t ws_size, hipStream_t stream) {
    static int grid = 0;
    if (grid == 0) {
        if (n_in != 13 || in_sizes[0] != MREAL * D || out_size != MREAL * D || ws_size < WS_END) {
            fprintf(stderr, "kernel_launch: unexpected shapes (n_in %d, in0 %d, out %d, ws %zu; need ws >= %zu); nothing launched\n", n_in, n_in > 0 ? in_sizes[0] : -1, out_size, ws_size, (size_t)WS_END); grid = -1; return; }
        int dev = 0, cus = 0, per_cu = 0;
        hipGetDevice(&dev); hipDeviceGetAttribute(&cus, hipDeviceAttributeMultiprocessorCount, dev);
        if (hipFuncSetAttribute((const void*)hymba_fwd, hipFuncAttributeMaxDynamicSharedMemorySize, LDS_BYTES) != hipSuccess) { fprintf(stderr, "kernel_launch: hipFuncSetAttribute failed\n"); grid = -1; return; }
        if (hipOccupancyMaxActiveBlocksPerMultiprocessor(&per_cu, (const void*)hymba_fwd, NTHREADS, LDS_BYTES) != hipSuccess || per_cu < 1) { fprintf(stderr, "kernel_launch: occupancy query says %d\n", per_cu); per_cu = 1; }
        (void)hipGetLastError();
        grid = cus * per_cu;
    }
    if (grid < 0) return;
    Args a{};
    a.x = (const float*)d_in[0]; a.meta = (const float*)d_in[1]; a.nmw = (const float*)d_in[2]; a.win = (const float*)d_in[3]; a.bg = (const float*)d_in[4]; a.cw = (const float*)d_in[5];
    a.mnw = (const float*)d_in[6]; a.wout = (const float*)d_in[7]; a.nfw = (const float*)d_in[8]; a.wg = (const float*)d_in[9]; a.wu = (const float*)d_in[10]; a.wd = (const float*)d_in[11]; a.nfin = (const float*)d_in[12];
    a.out = (float*)d_out; a.ws = (unsigned char*)d_ws;
#if MK_PER_PHASE
    for (int p = 0; p < N_PHASES; ++p) { a.ph_lo = p; a.ph_hi = p + 1; hipLaunchKernelGGL(hymba_fwd, dim3(grid), dim3(NTHREADS), LDS_BYTES, stream, a); }
#else
    a.ph_lo = 0; a.ph_hi = N_PHASES;
    if (hipMemsetAsync((char*)d_ws + WS_CTL, 0, CTL_BYTES, stream) != hipSuccess) { fprintf(stderr, "kernel_launch: memset failed\n"); return; }
    void* args[] = {&a};
    hipError_t e = hipLaunchCooperativeKernel((const void*)hymba_fwd, dim3(grid), dim3(NTHREADS), args, LDS_BYTES, stream);
    if (e != hipSuccess) fprintf(stderr, "kernel_launch: cooperative launch failed: %s (grid %d)\n", hipGetErrorString(e), grid);
#endif
}
```

```cpp
#include <hip/hip_runtime.h>
#include <hip/hip_cooperative_groups.h>
#include <cstdio>
#include <cstdint>
namespace cg = cooperative_groups;
namespace pg8 {
#define PG8_LAS __attribute__((address_space(3)))
typedef unsigned short bf16_t;
typedef short bf16x8 __attribute__((ext_vector_type(8)));
typedef float f32x4 __attribute__((ext_vector_type(4)));
typedef unsigned u32x4 __attribute__((ext_vector_type(4)));
constexpr int BM = 256, BK = 64, HALF = 128, HTB = HALF * BK * 2  , STAGE_BYTES = 8 * HTB, NXCD = 8, WGM = 8;

__host__ __device__ __forceinline__ int lds_byte(int r, int c) { const int st = (r >> 4) * 2 + (c >> 5), rr = r & 15, cc = c & 31, ob = rr * 64 + cc * 2; return st * 1024 + (ob ^ (((ob >> 9) & 1) << 5)); }
__host__ __device__ __forceinline__ void stage_rc(int b, int& R, int& C) { const int st = b / 1024, sb = b % 1024, swz = sb ^ (((sb >> 9) & 1) << 5); R = (st >> 1) * 16 + swz / 64; C = (st & 1) * 32 + (swz % 64) / 2; }
__host__ __device__ __forceinline__ int perm32(int rho) { const int n = rho >> 4, i = rho & 15; return 8 * (i >> 2) + 4 * n + (i & 3); }

struct Unit { int pm, pn; };
struct Gemm { const bf16_t* A; const bf16_t* Bt; int M, N, K; };

struct StaticOrder {
    int nM, nN, nwg, G, c;
    __host__ __device__ void init(int M, int N, int G_, int c_) { nM = M / BM; nN = N / BM; nwg = nM * nN; G = G_; c = c_; }
    __host__ __device__ bool next(int i, Unit& u) const {
        const long L = (long)i * G + c; if (L >= nwg) return false;
        int wgid = (int)L; { const int q = nwg / NXCD, r = nwg % NXCD, xcd = wgid % NXCD, off = wgid / NXCD; wgid = (xcd < r ? xcd * (q + 1) : r * (q + 1) + (xcd - r) * q) + off; }
        const int nig = WGM * nN, gid = wgid / nig, fm = gid * WGM, gsz = (nM - fm) < WGM ? (nM - fm) : WGM;
        u.pm = fm + ((wgid % nig) % gsz); u.pn = (wgid % nig) / gsz; return true;
    }
    __device__ __forceinline__ void a_ready(const Unit&) const {}
    __device__ __forceinline__ void done(const Unit&) const {}
};
__device__ __forceinline__ unsigned cvt_pk_bf16(float lo, float hi) { unsigned r; asm volatile("v_cvt_pk_bf16_f32 %0, %1, %2" : "=v"(r) : "v"(lo), "v"(hi)); return r; }
typedef float f32x2 __attribute__((ext_vector_type(2)));
template <class Epi, class Sched, bool ALIGN_EPI = false, bool SP2 = false>
__device__ __forceinline__ void gemm_phase(PG8_LAS unsigned char* lds, const Gemm g, const Sched& S, const Epi& E, const int wave_in) {
    int tid_; asm volatile("v_mbcnt_lo_u32_b32 %0, -1, 0\n\tv_mbcnt_hi_u32_b32 %0, -1, %0" : "=v"(tid_)); tid_ += wave_in * 64;
    const int tid = tid_, wid = __builtin_amdgcn_readfirstlane(tid >> 6), lane = tid & 63, wr = wid >> 2, wc = wid & 3, fr = lane & 15, fq = lane >> 4;
    const int K = g.K, nt = K / BK;
    unsigned voffA[2], voffB[2];
#pragma unroll
    for (int i = 0; i < 2; ++i) { int R, C; stage_rc(tid * 16 + i * 8192, R, C); const int Rb = Epi::PERM ? ((R & ~31) + perm32(R & 31)) : R;
        voffA[i] = (unsigned)(R * K + C) * 2u; voffB[i] = (unsigned)(Rb * K + C) * 2u; }
    const size_t kstep = (size_t)(BK * 2);
    const size_t hstep = (size_t)HALF * K * 2;
    const size_t tstep = 2 * hstep;
    const unsigned ldsw = (unsigned)wid * 1024u;
    const int aoff = lds_byte(wr * 64 + fr, fq * 8), boff = lds_byte(wc * 32 + fr, fq * 8);
#define PG8_SA(b, h) (((b) * 2 + (h)) * HTB)
#define PG8_SB(b, h) ((4 + (b) * 2 + (h)) * HTB)
#define PG8_STAGE(bufoff, gbase, voff) do { _Pragma("unroll") for (int _i = 0; _i < 2; ++_i) \
        __builtin_amdgcn_global_load_lds((const unsigned*)((const char*)(gbase) + (voff)[_i]), (PG8_LAS unsigned*)(lds + (bufoff) + ldsw + _i * 8192), 16, 0, 0); } while (0)
#define PG8_LDA(dst, b, h) do { _Pragma("unroll") for (int m = 0; m < 4; ++m) _Pragma("unroll") for (int k = 0; k < 2; ++k) dst[m][k] = *(const PG8_LAS bf16x8*)(lds + PG8_SA(b, h) + aoff + m * 2048 + k * 1024); } while (0)
#define PG8_LDB(dst, b, h) do { _Pragma("unroll") for (int n = 0; n < 2; ++n) _Pragma("unroll") for (int k = 0; k < 2; ++k) dst[n][k] = *(const PG8_LAS bf16x8*)(lds + PG8_SB(b, h) + boff + n * 2048 + k * 1024); } while (0)
#define PG8_MMA(ai, bj, At, Bt) do { __builtin_amdgcn_s_setprio(1); _Pragma("unroll") for (int m = 0; m < 4; ++m) _Pragma("unroll") for (int n = 0; n < 2; ++n) _Pragma("unroll") for (int k = 0; k < 2; ++k) \
        acc[ai][bj][m][n] = __builtin_amdgcn_mfma_f32_16x16x32_bf16(Bt[n][k], At[m][k], acc[ai][bj][m][n], 0, 0, 0); __builtin_amdgcn_s_setprio(0); } while (0)
#define PG8_WAIT_V(n) asm volatile("s_waitcnt vmcnt(" #n ")" ::: "memory")
#define PG8_WAIT_L(n) asm volatile("s_waitcnt lgkmcnt(" #n ")" ::: "memory")
#define PG8_BAR __builtin_amdgcn_s_barrier()
#define PG8_SCHED __builtin_amdgcn_sched_barrier(0)
    Unit cur, nxt; int ui = 0;
    if (!S.next(0, cur)) return;
    f32x4 acc[2][2][4][2];
#pragma unroll
    for (int a = 0; a < 2; ++a)
#pragma unroll
        for (int b = 0; b < 2; ++b)
#pragma unroll
            for (int m = 0; m < 4; ++m)
#pragma unroll
                for (int n = 0; n < 2; ++n) acc[a][b][m][n] = (f32x4){0.f, 0.f, 0.f, 0.f};
    bf16x8 At[4][2], B0[2][2], B1[2][2];
    const char* cA = (const char*)g.A + (size_t)cur.pm * tstep; const char* cB = (const char*)g.Bt + (size_t)cur.pn * tstep;
    S.a_ready(cur);
    if constexpr (SP2) {
        PG8_STAGE(PG8_SB(0, 0), cB, voffB); PG8_STAGE(PG8_SB(0, 1), cB + hstep, voffB); PG8_STAGE(PG8_SA(0, 0), cA, voffA); PG8_STAGE(PG8_SA(0, 1), cA + hstep, voffA);
        if (wr == 1) PG8_BAR;
        PG8_WAIT_V(2); PG8_BAR;
        PG8_STAGE(PG8_SB(1, 0), cB + kstep, voffB); PG8_STAGE(PG8_SA(1, 0), cA + kstep, voffA); PG8_STAGE(PG8_SB(1, 1), cB + hstep + kstep, voffB);
        PG8_WAIT_V(6); PG8_BAR;
    } else {
        PG8_STAGE(PG8_SB(0, 0), cB, voffB); PG8_STAGE(PG8_SA(0, 0), cA, voffA); PG8_STAGE(PG8_SB(0, 1), cB + hstep, voffB); PG8_STAGE(PG8_SA(0, 1), cA + hstep, voffA);
        if (wr == 1) PG8_BAR;
        PG8_WAIT_V(4); PG8_BAR;
        PG8_STAGE(PG8_SB(1, 0), cB + kstep, voffB); PG8_STAGE(PG8_SA(1, 0), cA + kstep, voffA); PG8_STAGE(PG8_SB(1, 1), cB + hstep + kstep, voffB);
        PG8_WAIT_V(6); PG8_BAR;
    }
    for (;;) {
        const bool has_next = S.next(ui + 1, nxt);
        const char* nA = has_next ? (const char*)g.A + (size_t)nxt.pm * tstep : cA; const char* nB = has_next ? (const char*)g.Bt + (size_t)nxt.pn * tstep : cB;
        for (int t = 0; t < nt; t += 2) {
            const bool last = (t == nt - 2);
            const char* a1 = cA + (size_t)(t + 1) * kstep;
            const char* a2 = last ? nA : cA + (size_t)(t + 2) * kstep; const char* b2 = last ? nB : cB + (size_t)(t + 2) * kstep;
            const char* a3 = a2 + kstep; const char* b3 = b2 + kstep;
            if (last && has_next) S.a_ready(nxt);
            if constexpr (SP2) {
            PG8_LDB(B0, 0, 0); PG8_LDB(B1, 0, 1); PG8_SCHED; PG8_LDA(At, 0, 0); PG8_STAGE(PG8_SA(1, 1), a1 + hstep, voffA);
            PG8_WAIT_V(8); PG8_WAIT_L(0); PG8_BAR; PG8_MMA(0, 0, At, B0); PG8_MMA(0, 1, At, B1); PG8_BAR; PG8_SCHED;
            PG8_LDA(At, 0, 1); PG8_STAGE(PG8_SB(0, 0), b2, voffB); PG8_STAGE(PG8_SB(0, 1), b2 + hstep, voffB); PG8_STAGE(PG8_SA(0, 0), a2, voffA);
            PG8_WAIT_V(8); PG8_WAIT_L(0); PG8_BAR; PG8_MMA(1, 0, At, B0); PG8_MMA(1, 1, At, B1); PG8_BAR; PG8_SCHED;
            PG8_LDB(B0, 1, 0); PG8_LDB(B1, 1, 1); PG8_SCHED; PG8_LDA(At, 1, 0); PG8_STAGE(PG8_SA(0, 1), a2 + hstep, voffA);
            PG8_WAIT_V(8); PG8_WAIT_L(0); PG8_BAR; PG8_MMA(0, 0, At, B0); PG8_MMA(0, 1, At, B1); PG8_BAR; PG8_SCHED;
            PG8_LDA(At, 1, 1); PG8_STAGE(PG8_SB(1, 0), b3, voffB); PG8_STAGE(PG8_SB(1, 1), b3 + hstep, voffB); PG8_STAGE(PG8_SA(1, 0), a3, voffA);
            PG8_WAIT_V(8); PG8_WAIT_L(0); PG8_BAR; PG8_MMA(1, 0, At, B0); PG8_MMA(1, 1, At, B1); PG8_BAR; PG8_SCHED;
            } else {
            PG8_LDB(B0, 0, 0); PG8_SCHED; PG8_LDA(At, 0, 0); PG8_STAGE(PG8_SA(1, 1), a1 + hstep, voffA);
            PG8_WAIT_L(8); PG8_BAR; PG8_WAIT_L(0); PG8_MMA(0, 0, At, B0); PG8_BAR; PG8_SCHED;
            PG8_LDB(B1, 0, 1); PG8_STAGE(PG8_SB(0, 0), b2, voffB);
            PG8_BAR; PG8_WAIT_L(0); PG8_MMA(0, 1, At, B1); PG8_BAR;
            PG8_LDA(At, 0, 1); PG8_STAGE(PG8_SA(0, 0), a2, voffA);
            PG8_BAR; PG8_WAIT_L(0); PG8_MMA(1, 0, At, B0); PG8_BAR; PG8_SCHED;
            PG8_STAGE(PG8_SB(0, 1), b2 + hstep, voffB);
            PG8_WAIT_V(6); PG8_BAR; PG8_MMA(1, 1, At, B1); PG8_BAR;
            PG8_LDB(B0, 1, 0); PG8_SCHED; PG8_LDA(At, 1, 0); PG8_STAGE(PG8_SA(0, 1), a2 + hstep, voffA);
            PG8_WAIT_L(8); PG8_BAR; PG8_WAIT_L(0); PG8_MMA(0, 0, At, B0); PG8_BAR; PG8_SCHED;
            PG8_LDB(B1, 1, 1); PG8_STAGE(PG8_SB(1, 0), b3, voffB);
            PG8_BAR; PG8_WAIT_L(0); PG8_MMA(0, 1, At, B1); PG8_BAR;
            PG8_LDA(At, 1, 1); PG8_STAGE(PG8_SA(1, 0), a3, voffA);
            PG8_BAR; PG8_WAIT_L(0); PG8_MMA(1, 0, At, B0); PG8_BAR; PG8_SCHED;
            PG8_STAGE(PG8_SB(1, 1), b3 + hstep, voffB);
            PG8_WAIT_V(6); PG8_BAR; PG8_MMA(1, 1, At, B1); PG8_BAR;
            }
        }
        if constexpr (ALIGN_EPI) { if (wr == 0) PG8_BAR; }
        if constexpr (!Epi::AFTER_DRAIN) { E(acc, cur, wr, wc, fr, fq); S.done(cur); }
        if (!has_next) break;
#pragma unroll
        for (int a = 0; a < 2; ++a)
#pragma unroll
            for (int b = 0; b < 2; ++b)
#pragma unroll
                for (int m = 0; m < 4; ++m)
#pragma unroll
                    for (int n = 0; n < 2; ++n) acc[a][b][m][n] = (f32x4){0.f, 0.f, 0.f, 0.f};
        cur = nxt; cA = nA; cB = nB; ++ui;
        if constexpr (ALIGN_EPI) { if (wr == 1) PG8_BAR; }
    }
    PG8_WAIT_V(0);
    if constexpr (!ALIGN_EPI) { if (wr == 0) PG8_BAR; }
    PG8_BAR;
    if constexpr (Epi::AFTER_DRAIN) { E.fused(acc, cur, wr, wc, fr, fq, lds, wid, lane); S.done(cur); }
#undef PG8_SA
#undef PG8_SB
#undef PG8_STAGE
#undef PG8_LDA
#undef PG8_LDB
#undef PG8_MMA
#undef PG8_WAIT_V
#undef PG8_WAIT_L
#undef PG8_BAR
#undef PG8_SCHED
}
}

#define LAS __attribute__((address_space(3)))
typedef unsigned short bf16_t;
typedef short bf16x8 __attribute__((ext_vector_type(8)));
typedef short s16x4 __attribute__((ext_vector_type(4)));
typedef float f32x4 __attribute__((ext_vector_type(4)));
typedef unsigned u32x4 __attribute__((ext_vector_type(4)));
typedef unsigned u32x2 __attribute__((ext_vector_type(2)));

constexpr int D = 2048, NB = 8, SEQ = 2048, NMETA = 16, NHEAD = 4, DV = 256, DQK = 128;
constexpr int MREAL = NB * SEQ;
constexpr int MMETA = NMETA;
constexpr int MTOT = MREAL + MMETA;
constexpr int MPAD = MTOT;
constexpr int DIN = 6152, NPROJ = 6144, DFF = 5632, NGU = 2 * DFF;
constexpr int LDP = 5120;
constexpr int C_Q = 0, C_K = 512, C_V = 1024, C_OG = 2048, C_A = 3072, C_GB = 4096;
constexpr float EPS = 1e-6f, GATE_CAP = 15.0f;
constexpr int NCHUNK = 33;

constexpr size_t MiB = 1u << 20;
constexpr size_t SZ_WT_IN = (size_t)NPROJ * D * 2, SZ_WT_OUT = (size_t)D * D * 2, SZ_WT_GU = (size_t)NGU * D * 2, SZ_WT_DN = (size_t)D * DFF * 2;
constexpr size_t WS_WT_IN = 0, WS_WT_OUT = 48 * MiB, WS_WT_GU = 64 * MiB, WS_WT_DN = 152 * MiB;
constexpr size_t WS_XA = 196 * MiB;
constexpr size_t WS_PROJ = 261 * MiB;
constexpr size_t WS_NUM = 456 * MiB;
constexpr size_t WS_HMETA = 489 * MiB;
constexpr size_t WS_LI = 491 * MiB, WS_LF = WS_LI + MiB / 2, WS_DEN = 492 * MiB, WS_MT = WS_DEN + MiB / 2;
constexpr size_t WS_CTL = 493 * MiB, CTL_BYTES = 65536;
constexpr size_t WS_END = 494 * MiB;
static_assert(2 * SZ_WT_IN <= WS_WT_OUT - WS_WT_IN && 2 * SZ_WT_OUT <= WS_WT_GU - WS_WT_OUT && 2 * SZ_WT_GU <= WS_WT_DN - WS_WT_GU && 2 * SZ_WT_DN <= WS_XA - WS_WT_DN, "ws map");
static_assert((size_t)MPAD * D * 2 <= WS_PROJ - WS_XA && (size_t)MPAD * NPROJ * 2 <= WS_NUM - WS_PROJ && (size_t)MPAD * 1024 * 2 <= WS_HMETA - WS_NUM, "ws map");

constexpr int LDS_BYTES = 147456;
constexpr int NWAVES = 8, NTHREADS = 512;

__device__ __forceinline__ unsigned cvt_pk(float lo, float hi) { unsigned r; asm volatile("v_cvt_pk_bf16_f32 %0, %1, %2" : "=v"(r) : "v"(lo), "v"(hi)); return r; }
__device__ __forceinline__ float bf2f(unsigned short b) { return __uint_as_float(((unsigned)b) << 16); }
__device__ __forceinline__ float bflo(unsigned w) { return __uint_as_float(w << 16); }
__device__ __forceinline__ float bfhi(unsigned w) { return __uint_as_float(w & 0xffff0000u); }
#define DPPF(old_, src_, ctrl_, rmask_) __builtin_bit_cast(float, __builtin_amdgcn_update_dpp(__builtin_bit_cast(int, (float)(old_)), __builtin_bit_cast(int, (float)(src_)), ctrl_, rmask_, 0xF, false))
__device__ __forceinline__ float wave_scan_sum(float v) {
    v += DPPF(0.f, v, 0x111, 0xF); v += DPPF(0.f, v, 0x112, 0xF); v += DPPF(0.f, v, 0x114, 0xF); v += DPPF(0.f, v, 0x118, 0xF);
    v += DPPF(0.f, v, 0x142, 0xA); v += DPPF(0.f, v, 0x143, 0xC);
    return v;
}
__device__ __forceinline__ float wave_max_last(float v) {
    const float ninf = -3.0e38f;
    v = fmaxf(v, DPPF(ninf, v, 0x111, 0xF)); v = fmaxf(v, DPPF(ninf, v, 0x112, 0xF)); v = fmaxf(v, DPPF(ninf, v, 0x114, 0xF)); v = fmaxf(v, DPPF(ninf, v, 0x118, 0xF));
    v = fmaxf(v, DPPF(ninf, v, 0x142, 0xA)); v = fmaxf(v, DPPF(ninf, v, 0x143, 0xC));
    return __builtin_bit_cast(float, __builtin_amdgcn_readlane(__builtin_bit_cast(int, v), 63));
}
__device__ __forceinline__ float wave_sum(float v) { return __builtin_bit_cast(float, __builtin_amdgcn_readlane(__builtin_bit_cast(int, wave_scan_sum(v)), 63)); }
__device__ __forceinline__ float wave_max(float v) { return wave_max_last(v); }

struct Args {
    const float *x, *meta, *nmw, *win, *bg, *cw, *mnw, *wout, *nfw, *wg, *wu, *wd, *nfin;
    float* out; unsigned char* ws; int ph_lo, ph_hi;
};
static_assert(sizeof(Args) == 15 * 8 + 8, "Args has no padding");

#define GAS __attribute__((address_space(1)))
struct PArgs {
    const GAS float *x, *meta, *nmw, *win, *bg, *cw, *mnw, *wout, *nfw, *wg, *wu, *wd, *nfin;
    GAS float* out; GAS unsigned char* ws;
};
__device__ __forceinline__ GAS bf16_t* hrow(const PArgs& a, int m) { return m < MREAL ? (GAS bf16_t*)a.out + (size_t)m * (2 * D) + D : (GAS bf16_t*)(a.ws + WS_HMETA) + (size_t)(m - MREAL) * D; }

struct EpiProj {
    static constexpr bool PERM = true, AFTER_DRAIN = false;
    GAS bf16_t* O;
    __device__ __forceinline__ void operator()(const f32x4 (&acc)[2][2][4][2], const pg8::Unit& u, int wr, int wc, int fr, int fq) const {
        const int row0 = u.pm * 256 + wr * 64 + fr;
        if (u.pn >= 12 && u.pn < 20) {
            const int col0 = C_A + (u.pn - 12) * 128 + wc * 32 + 8 * fq;
#pragma unroll
            for (int ai = 0; ai < 2; ++ai)
#pragma unroll
                for (int m = 0; m < 4; ++m) { const f32x4 v0 = acc[ai][0][m][0] * acc[ai][1][m][0], v1 = acc[ai][0][m][1] * acc[ai][1][m][1];
                    u32x4 w; w.x = cvt_pk(v0[0], v0[1]); w.y = cvt_pk(v0[2], v0[3]); w.z = cvt_pk(v1[0], v1[1]); w.w = cvt_pk(v1[2], v1[3]);
                    *(GAS u32x4*)(O + (size_t)(row0 + ai * 128 + m * 16) * LDP + col0) = w; }
        } else {
            const int colt = u.pn < 12 ? u.pn * 256 : C_GB + (u.pn - 20) * 256;
            const float sc = (colt < C_K) ? 0.08838834764831845f : 1.0f;
            const int col0 = colt + wc * 32 + 8 * fq;
#pragma unroll
            for (int ai = 0; ai < 2; ++ai)
#pragma unroll
                for (int m = 0; m < 4; ++m) { GAS bf16_t* rowp = O + (size_t)(row0 + ai * 128 + m * 16) * LDP + col0;
#pragma unroll
                    for (int bj = 0; bj < 2; ++bj) { const f32x4 v0 = acc[ai][bj][m][0] * sc, v1 = acc[ai][bj][m][1] * sc;
                        u32x4 w; w.x = cvt_pk(v0[0], v0[1]); w.y = cvt_pk(v0[2], v0[3]); w.z = cvt_pk(v1[0], v1[1]); w.w = cvt_pk(v1[2], v1[3]);
                        *(GAS u32x4*)(rowp + bj * 128) = w; } }
        }
    }
};
struct EpiResid {
    static constexpr bool PERM = true, AFTER_DRAIN = false;
    GAS float* out;
    __device__ __forceinline__ void operator()(const f32x4 (&acc)[2][2][4][2], const pg8::Unit& u, int wr, int wc, int fr, int fq) const {
        GAS bf16_t* hb = (GAS bf16_t*)out + (size_t)(u.pm * 256) * (2 * D) + D;
        const int r0 = wr * 64 + fr, col0 = u.pn * 256 + wc * 32 + 8 * fq;
#pragma unroll
        for (int ai = 0; ai < 2; ++ai) { u32x4 old[4][2];
#pragma unroll
            for (int m = 0; m < 4; ++m) { const GAS bf16_t* rowp = hb + (size_t)(r0 + ai * 128 + m * 16) * (2 * D) + col0;
#pragma unroll
                for (int bj = 0; bj < 2; ++bj) old[m][bj] = *(const GAS u32x4*)(rowp + bj * 128); }
#pragma unroll
            for (int m = 0; m < 4; ++m) { GAS bf16_t* rowp = hb + (size_t)(r0 + ai * 128 + m * 16) * (2 * D) + col0;
#pragma unroll
                for (int bj = 0; bj < 2; ++bj) { const u32x4 o = old[m][bj]; const f32x4 a0 = acc[ai][bj][m][0], a1 = acc[ai][bj][m][1];
                    u32x4 w; w.x = cvt_pk(bflo(o.x) + a0[0], bfhi(o.x) + a0[1]); w.y = cvt_pk(bflo(o.y) + a0[2], bfhi(o.y) + a0[3]); w.z = cvt_pk(bflo(o.z) + a1[0], bfhi(o.z) + a1[1]); w.w = cvt_pk(bflo(o.w) + a1[2], bfhi(o.w) + a1[3]);
                    *(GAS u32x4*)(rowp + bj * 128) = w; } }
        }
    }
};
struct EpiSwiglu {
    static constexpr bool PERM = true, AFTER_DRAIN = false;
    GAS bf16_t* O;
    __device__ __forceinline__ void operator()(const f32x4 (&acc)[2][2][4][2], const pg8::Unit& u, int wr, int wc, int fr, int fq) const {
        const int row0 = u.pm * 256 + wr * 64 + fr, col0 = u.pn * 128 + wc * 32 + 8 * fq;
#pragma unroll
        for (int ai = 0; ai < 2; ++ai)
#pragma unroll
            for (int m = 0; m < 4; ++m) { GAS bf16_t* rowp = O + (size_t)(row0 + ai * 128 + m * 16) * DFF + col0;
                float r[8];
#pragma unroll
                for (int n = 0; n < 2; ++n)
#pragma unroll
                    for (int j = 0; j < 4; ++j) { const float g = acc[ai][0][m][n][j], up = acc[ai][1][m][n][j]; r[n * 4 + j] = g * up * __builtin_amdgcn_rcpf(1.0f + __expf(-g)); }
                u32x4 w; w.x = cvt_pk(r[0], r[1]); w.y = cvt_pk(r[2], r[3]); w.z = cvt_pk(r[4], r[5]); w.w = cvt_pk(r[6], r[7]);
                *(GAS u32x4*)rowp = w; }
    }
};

#define RLX_AGENT __ATOMIC_RELAXED, __HIP_MEMORY_SCOPE_AGENT
#define XB_TMO      128
#define XB_XCNT(j)  (256  + 64 * (j))
#define XB_XSUB(j)  (1280 + 64 * (j))
#define XB_XGEN(j)  (2304 + 64 * (j))
#define XB_TOP      3328
#define XB_TOPGEN   3392
#define XCD_BAR_WORDS 3456
#define XB_SPIN_CAP (1u << 18)

__device__ __forceinline__ unsigned xb_ld(unsigned* p)              { return __hip_atomic_load(p, __ATOMIC_RELAXED, __HIP_MEMORY_SCOPE_AGENT); }
__device__ __forceinline__ unsigned xb_add(unsigned* p, unsigned v) { return __hip_atomic_fetch_add(p, v, __ATOMIC_RELAXED, __HIP_MEMORY_SCOPE_AGENT); }
__device__ __forceinline__ unsigned xb_xcc_id() { return (unsigned)__builtin_amdgcn_s_getreg((3 << 11) | 20) & 0xFu; }
#define XB_SPIN(cond, bar) do { unsigned _sp = 0; while (cond) { __builtin_amdgcn_s_sleep(1); \
    if ((++_sp & 255u) == 0u) { if (xb_ld(&(bar)[XB_TMO])) break; if (_sp > XB_SPIN_CAP) { atomicAdd(&(bar)[XB_TMO], 1u); break; } } } } while (0)

struct XcdBarrier {
    unsigned* bar; unsigned x;
    volatile LAS unsigned* st;
};

__device__ __forceinline__ XcdBarrier xcd_barrier_post(unsigned* bar, volatile LAS unsigned* st) {
    XcdBarrier b; b.bar = bar; b.x = xb_xcc_id(); b.st = st;
    if (threadIdx.x == 0) (void)xb_add(&bar[XB_XCNT(b.x)], 1u);
    return b;
}
__device__ __forceinline__ void xcd_barrier_complete(unsigned* bar, unsigned x, unsigned& nloc, unsigned& nx) {
    const unsigned G = gridDim.x * gridDim.y * gridDim.z;
    unsigned sum, cnt, mine, sp = 0u;
    for (;;) {
        sum = 0u; cnt = 0u; mine = 0u;
#pragma unroll
        for (unsigned j = 0; j < 16; ++j) { const unsigned c = xb_ld(&bar[XB_XCNT(j)]); sum += c; cnt += (c > 0u) ? 1u : 0u; mine = (j == x) ? c : mine; }
        if (sum == G) break;
        __builtin_amdgcn_s_sleep(1);
        if ((++sp & 255u) == 0u) { if (xb_ld(&bar[XB_TMO])) break; if (sp > XB_SPIN_CAP) { atomicAdd(&bar[XB_TMO], 1u); break; } }
    }
    nloc = mine > 0u ? mine : 1u; nx = cnt > 0u ? cnt : 1u;
}

__device__ __forceinline__ void xcd_barrier(const XcdBarrier& b) {
    asm volatile("s_waitcnt vmcnt(0)" ::: "memory");
    __syncthreads();
    if (threadIdx.x == 0) {
        unsigned* bar = b.bar;
        __builtin_amdgcn_s_waitcnt(0);
        unsigned nloc = b.st[0], nx = b.st[1];
        if (nloc == 0u) { xcd_barrier_complete(bar, b.x, nloc, nx); b.st[0] = nloc; b.st[1] = nx; }
        const unsigned old = xb_add(&bar[XB_XSUB(b.x)], 1u);
        const unsigned gen = old / nloc;
        if (old + 1u == (gen + 1u) * nloc) {
            __builtin_amdgcn_fence(__ATOMIC_RELEASE, "agent");
            asm volatile("s_waitcnt vmcnt(0)" ::: "memory");
            const unsigned og = xb_add(&bar[XB_TOP], 1u);
            const unsigned tg = og / nx;
            if (og + 1u == (tg + 1u) * nx) xb_add(&bar[XB_TOPGEN], 1u);
            else XB_SPIN(xb_ld(&bar[XB_TOPGEN]) == tg, bar);
            __builtin_amdgcn_fence(__ATOMIC_ACQUIRE, "agent");
            xb_add(&bar[XB_XGEN(b.x)], 1u);
            asm volatile("s_waitcnt vmcnt(0)" ::: "memory");
        } else {
            XB_SPIN(xb_ld(&bar[XB_XGEN(b.x)]) == gen, bar);
            __builtin_amdgcn_fence(__ATOMIC_ACQUIRE, "agent");
            asm volatile("s_waitcnt vmcnt(0)" ::: "memory");
        }
    }
    __syncthreads();
}


struct WItem { const GAS float* src; GAS bf16_t* dst; int ldw, K; };
__device__ __forceinline__ WItem witem(const PArgs& a, int it) {
    constexpr int I_IN = 32 * 192, I_OUT = 32 * 64, I_G = 32 * 176, I_DN = 88 * 64, I_LAYER = I_IN + I_OUT + 2 * I_G + I_DN;
    const int l = it / I_LAYER; int r = it - l * I_LAYER; WItem w;
    if (r < I_IN) { const int kb = r / 192, nb = r % 192, d0 = nb * 32; w.ldw = DIN; w.K = D; w.src = a.win + (size_t)l * D * DIN + (size_t)(kb * 64) * DIN + (d0 < 3072 ? d0 : (d0 < 5120 ? ((((d0 - 3072) & 255) < 128) ? 3080 + ((d0 - 3072) >> 8) * 128 + ((d0 - 3072) & 127) : 5128 + ((d0 - 3072) >> 8) * 128 + ((d0 - 3072) & 127)) : 4104 + (d0 - 5120))); w.dst = (GAS bf16_t*)(a.ws + WS_WT_IN + l * SZ_WT_IN) + (size_t)d0 * D + kb * 64; return w; } r -= I_IN;
    if (r < I_OUT) { const int kb = r / 64, nb = r % 64; w.ldw = D; w.K = D; w.src = a.wout + (size_t)l * D * D + (size_t)(kb * 64) * D + nb * 32; w.dst = (GAS bf16_t*)(a.ws + WS_WT_OUT + l * SZ_WT_OUT) + (size_t)(nb * 32) * D + kb * 64; return w; } r -= I_OUT;
    if (r < 2 * I_G) { const int up = r >= I_G; r -= up * I_G; const int kb = r / 176, nb = r % 176, n0 = nb * 32; w.ldw = DFF; w.K = D; w.src = (up ? a.wu : a.wg) + (size_t)l * D * DFF + (size_t)(kb * 64) * DFF + n0;
        w.dst = (GAS bf16_t*)(a.ws + WS_WT_GU + l * SZ_WT_GU) + (size_t)((n0 >> 7) * 256 + up * 128 + (n0 & 127)) * D + kb * 64; return w; } r -= 2 * I_G;
    { const int kb = r / 64, nb = r % 64; w.ldw = D; w.K = DFF; w.src = a.wd + (size_t)l * DFF * D + (size_t)(kb * 64) * D + nb * 32; w.dst = (GAS bf16_t*)(a.ws + WS_WT_DN + l * SZ_WT_DN) + (size_t)(nb * 32) * DFF + kb * 64; return w; }
}
constexpr int W_ITEMS_LAYER = 32 * 192 + 32 * 64 + 2 * 32 * 176 + 88 * 64;
__device__ __forceinline__ void weights_one(const PArgs& a, int it, LAS float* scr, int lane) {
    const WItem w = witem(a, it); const int kr = lane >> 3, n4 = (lane & 7) * 4;
    f32x4 v[8];
#pragma unroll
    for (int i = 0; i < 8; ++i) v[i] = __builtin_nontemporal_load((const GAS f32x4*)(w.src + (size_t)(8 * i + kr) * w.ldw + n4));
#pragma unroll
    for (int i = 0; i < 8; ++i) *(LAS f32x4*)(scr + (8 * i + kr) * 36 + n4) = v[i];
    asm volatile("s_waitcnt lgkmcnt(0)" ::: "memory");
    const int c = lane & 7;
#pragma unroll
    for (int j = 0; j < 4; ++j) { const int n = (lane >> 3) + 8 * j; const LAS float* s = scr + (8 * c) * 36 + n;
        u32x4 o; o.x = cvt_pk(s[0 * 36], s[1 * 36]); o.y = cvt_pk(s[2 * 36], s[3 * 36]); o.z = cvt_pk(s[4 * 36], s[5 * 36]); o.w = cvt_pk(s[6 * 36], s[7 * 36]);
        *(GAS u32x4*)(w.dst + (size_t)n * w.K + 8 * c) = o; }
    asm volatile("s_waitcnt lgkmcnt(0)" ::: "memory");
}
__device__ __forceinline__ void weights_stream(const PArgs& a, LAS float* scr, int lane, int first, int stride, int it0, int nbar) {
    const int kr = lane >> 3, n4 = (lane & 7) * 4;
    f32x4 v[8];
    int it = first;
    if (it < W_ITEMS_LAYER) { const WItem w = witem(a, it0 + it);
#pragma unroll
        for (int i = 0; i < 8; ++i) v[i] = __builtin_nontemporal_load((const GAS f32x4*)(w.src + (size_t)(8 * i + kr) * w.ldw + n4)); }
#pragma unroll 1
    for (; it < W_ITEMS_LAYER; it += stride) {
        const WItem w = witem(a, it0 + it);
#pragma unroll
        for (int i = 0; i < 8; ++i) *(LAS f32x4*)(scr + (8 * i + kr) * 36 + n4) = v[i];
        if (it + stride < W_ITEMS_LAYER) { const WItem wn = witem(a, it0 + it + stride);
#pragma unroll
            for (int i = 0; i < 8; ++i) v[i] = __builtin_nontemporal_load((const GAS f32x4*)(wn.src + (size_t)(8 * i + kr) * wn.ldw + n4)); }
        asm volatile("s_waitcnt lgkmcnt(0)" ::: "memory");
        const int c = lane & 7;
#pragma unroll
        for (int j = 0; j < 4; ++j) { const int n = (lane >> 3) + 8 * j; const LAS float* s = scr + (8 * c) * 36 + n;
            u32x4 o; o.x = cvt_pk(s[0 * 36], s[1 * 36]); o.y = cvt_pk(s[2 * 36], s[3 * 36]); o.z = cvt_pk(s[4 * 36], s[5 * 36]); o.w = cvt_pk(s[6 * 36], s[7 * 36]);
            *(GAS u32x4*)(w.dst + (size_t)n * w.K + 8 * c) = o; }
        asm volatile("s_waitcnt lgkmcnt(0)" ::: "memory");
        if (nbar > 0) { --nbar; __builtin_amdgcn_s_barrier(); asm volatile("" ::: "memory"); }
    }
    for (; nbar > 0; --nbar) { __builtin_amdgcn_s_barrier(); asm volatile("" ::: "memory"); }
}
__device__ __forceinline__ void weights_phase(const PArgs& a, LAS unsigned char* lds, int wave, int lane) {
    weights_stream(a, (LAS float*)(lds + wave * 16384), lane, blockIdx.x * NWAVES + wave, gridDim.x * NWAVES, 0, 0);
}

template <int MODE>
__device__ __forceinline__ void norm_phase(const PArgs& a, int layer, LAS unsigned char* lds, int wave, int lane) {
    const GAS float* nw = MODE <= 1 ? a.nmw + layer * D : (MODE == 2 ? a.nfw + layer * D : a.nfin);
    LAS float* WG = (LAS float*)lds;
    if (MODE <= 1) {
        const GAS float* wsrc = a.win + (size_t)layer * D * DIN + 3072;
        for (int k = wave * 64 + lane; k < D; k += NTHREADS) { const f32x4 g0 = *(const GAS f32x4*)(wsrc + (size_t)k * DIN), g1 = *(const GAS f32x4*)(wsrc + (size_t)k * DIN + 4);
            WG[0 * D + k] = g0[0]; WG[1 * D + k] = g0[1]; WG[2 * D + k] = g0[2]; WG[3 * D + k] = g0[3]; WG[4 * D + k] = g1[0]; WG[5 * D + k] = g1[1]; WG[6 * D + k] = g1[2]; WG[7 * D + k] = g1[3]; }
        __syncthreads();
    }
    GAS bf16_t* XA = (GAS bf16_t*)(a.ws + WS_XA); GAS float* LI = (GAS float*)(a.ws + WS_LI); GAS float* LF = (GAS float*)(a.ws + WS_LF);
    const int gw = blockIdx.x * NWAVES + wave, NGW = gridDim.x * NWAVES;
    f32x4 w[8];
#pragma unroll
    for (int j = 0; j < 8; ++j) w[j] = *((const GAS f32x4*)nw + lane + 64 * j);
    constexpr int MEND = (MODE == 3 ? MREAL : MTOT);
#define NORM_SRC(mm) ((mm) < MREAL ? a.x + (size_t)(mm) * D : a.meta + (size_t)(((mm) - MREAL) & 15) * D)
    f32x4 vn[8]; u32x2 hn[8];
    if (gw < MEND) { if (MODE == 0) { const GAS float* src = NORM_SRC(gw);
#pragma unroll
            for (int j = 0; j < 8; ++j) vn[j] = __builtin_nontemporal_load((const GAS f32x4*)src + lane + 64 * j); }
        else { const GAS bf16_t* src = hrow(a, gw);
#pragma unroll
            for (int j = 0; j < 8; ++j) hn[j] = *((const GAS u32x2*)src + lane + 64 * j); } }
    for (int m = gw; m < MEND; m += NGW) {
        f32x4 v[8]; float ss = 0.f;
#pragma unroll
        for (int j = 0; j < 8; ++j) { if (MODE == 0) v[j] = vn[j]; else v[j] = (f32x4){bflo(hn[j].x), bfhi(hn[j].x), bflo(hn[j].y), bfhi(hn[j].y)};
            ss += (v[j][0] * v[j][0] + v[j][1] * v[j][1]) + (v[j][2] * v[j][2] + v[j][3] * v[j][3]); }
        if (m + NGW < MEND) { if (MODE == 0) { const GAS float* src = NORM_SRC(m + NGW);
#pragma unroll
                for (int j = 0; j < 8; ++j) vn[j] = __builtin_nontemporal_load((const GAS f32x4*)src + lane + 64 * j); }
            else { const GAS bf16_t* src = hrow(a, m + NGW);
#pragma unroll
                for (int j = 0; j < 8; ++j) hn[j] = *((const GAS u32x2*)src + lane + 64 * j); } }
        if (MODE == 0) { GAS bf16_t* hp = hrow(a, m);
#pragma unroll
            for (int j = 0; j < 8; ++j) { u32x2 o; o.x = cvt_pk(v[j][0], v[j][1]); o.y = cvt_pk(v[j][2], v[j][3]); *((GAS u32x2*)hp + lane + 64 * j) = o; } }
        const float rstd = rsqrtf(wave_sum(ss) * (1.0f / D) + EPS);
#pragma unroll
        for (int j = 0; j < 8; ++j) v[j] = v[j] * rstd * w[j];
        if (MODE == 3) { GAS float* op = a.out + (size_t)m * D;
#pragma unroll
            for (int j = 0; j < 8; ++j) __builtin_nontemporal_store(v[j], (GAS f32x4*)op + lane + 64 * j);
        } else { GAS bf16_t* op = XA + (size_t)m * D;
#pragma unroll
            for (int j = 0; j < 8; ++j) { u32x2 o; o.x = cvt_pk(v[j][0], v[j][1]); o.y = cvt_pk(v[j][2], v[j][3]); *((GAS u32x2*)op + lane + 64 * j) = o; } }
        if (MODE <= 1) {
            float mine = 0.f;
#pragma unroll
            for (int g = 0; g < 8; ++g) { float s = 0.f;
#pragma unroll
                for (int j = 0; j < 8; ++j) { const f32x4 wg = *((const LAS f32x4*)(WG + g * D) + lane + 64 * j); s += (v[j][0] * wg[0] + v[j][1] * wg[1]) + (v[j][2] * wg[2] + v[j][3] * wg[3]); }
                s = wave_sum(s); mine = (lane == g) ? s : mine; }
            if (lane < 8) { const float raw = mine + a.bg[layer * 8 + lane]; const float e2 = __expf(raw * (2.0f / GATE_CAP)); const float cp = GATE_CAP * (e2 - 1.0f) / (e2 + 1.0f);
                if (lane < 4) LI[m * 4 + lane] = cp; else LF[m * 4 + lane - 4] = fminf(cp, 0.f) - __logf(1.0f + __expf(-fabsf(cp))); }
        }
    }
}

__device__ __forceinline__ bf16x8 pack8(const f32x4& x, const f32x4& y) {
    u32x4 w; w.x = cvt_pk(x[0], x[1]); w.y = cvt_pk(x[2], x[3]); w.z = cvt_pk(y[0], y[1]); w.w = cvt_pk(y[2], y[3]); return __builtin_bit_cast(bf16x8, w);
}

typedef short v4i16_t __attribute__((ext_vector_type(4)));
__device__ __forceinline__ s16x4 lds_tr(LAS unsigned char* p) { return __builtin_bit_cast(s16x4, __builtin_amdgcn_ds_read_tr16_b64_v4i16((LAS v4i16_t*)p)); }
#define MFMA16(x, y, c) __builtin_amdgcn_mfma_f32_16x16x32_bf16((x), (y), (c), 0, 0, 0)
constexpr int KIMG_STRIDE = 288, KIMG_BYTES = 64 * KIMG_STRIDE;
constexpr int VIMG_STRIDE = 72, VIMG_BYTES = 64 * VIMG_STRIDE;
constexpr int MTEAM_BYTES = 2 * (KIMG_BYTES + VIMG_BYTES);
constexpr int MSC_OFF = 2 * MTEAM_BYTES;

__device__ __forceinline__ void mlstm_team(const PArgs& a, bool valid, bool den_item, int bh, int sl, int tb, LAS unsigned char* kteam, LAS float* sc, int lane_in) {
    const GAS bf16_t* proj = (const GAS bf16_t*)(a.ws + WS_PROJ);
    const GAS float* LI = (const GAS float*)(a.ws + WS_LI); const GAS float* LF = (const GAS float*)(a.ws + WS_LF);
    GAS bf16_t* NUM = (GAS bf16_t*)(a.ws + WS_NUM); GAS float* DEN = (GAS float*)(a.ws + WS_DEN); GAS float* MT = (GAS float*)(a.ws + WS_MT);
    const int b = bh >> 2, hd = bh & 3;
    int lane = lane_in; asm volatile("" : "+v"(lane));
    int fr = lane & 15, fq = lane >> 4;
    f32x4 C[2][8], C2[8];
#pragma unroll
    for (int i = 0; i < 8; ++i) { C[0][i] = (f32x4){0.f, 0.f, 0.f, 0.f}; C[1][i] = (f32x4){0.f, 0.f, 0.f, 0.f}; C2[i] = (f32x4){0.f, 0.f, 0.f, 0.f}; }
    f32x4 dn_p = (f32x4){0.f, 0.f, 0.f, 0.f};
    float m_st = 0.f;
#define ROWOF(cc, p) ((cc) == 0 ? (MREAL + ((p) < 48 ? 0 : (p) - 48)) : (b * SEQ + ((cc) - 1) * 64 + (p)))
    u32x4 kpre[4], vpre; float lfpre = 0.f, lipre = 0.f; bf16x8 qpre[4];
    f32x4 nm_p[2]; float mt_p = 0.f; nm_p[0] = (f32x4){0.f, 0.f, 0.f, 0.f}; nm_p[1] = nm_p[0];
#define LOAD_CHUNK(cc) do { \
        { const GAS bf16_t* rp_ = proj + (size_t)ROWOF(cc, 16 * tb + (lane >> 2)) * LDP; \
          _Pragma("unroll") for (int i = 0; i < 4; ++i) kpre[i] = *(const GAS u32x4*)(rp_ + C_K + hd * 128 + (lane & 3) * 32 + 8 * i); \
          vpre = *(const GAS u32x4*)(rp_ + C_V + hd * 256 + sl * 32 + (lane & 3) * 8); } \
        { const int rl_ = ROWOF(cc, lane); lfpre = LF[rl_ * 4 + hd]; lipre = LI[rl_ * 4 + hd]; } \
        { const GAS bf16_t* rp_ = proj + (size_t)ROWOF(cc, tb * 16 + fr) * LDP + C_Q + hd * 128 + fq * 4; \
          _Pragma("unroll") for (int kc = 0; kc < 4; ++kc) { const s16x4 lo_ = *(const GAS s16x4*)(rp_ + 32 * kc), hi_ = *(const GAS s16x4*)(rp_ + 32 * kc + 16); qpre[kc] = __builtin_shufflevector(lo_, hi_, 0, 1, 2, 3, 4, 5, 6, 7); } } } while (0)
#define STORE_OUT(cc) do { if ((cc) > 0 || (tb == 3 && b == 0)) { \
        _Pragma("unroll") for (int sx = 0; sx < 2; ++sx) _Pragma("unroll") for (int jj = 0; jj < 4; ++jj) \
            NUM[(size_t)ROWOF(cc, tb * 16 + fq * 4 + jj) * 1024 + hd * 256 + sl * 32 + sx * 16 + fr] = (bf16_t)(cvt_pk(nm_p[sx][jj], 0.f) & 0xffffu); \
        if (den_item) { if (fr == 0) { _Pragma("unroll") for (int jj = 0; jj < 4; ++jj) DEN[ROWOF(cc, tb * 16 + fq * 4 + jj) * 4 + hd] = dn_p[jj]; } \
            if (fq == 0) MT[ROWOF(cc, tb * 16 + fr) * 4 + hd] = mt_p; } } } while (0)
    if (valid) LOAD_CHUNK(0);
#pragma unroll 1
    for (int c = 0; c < NCHUNK; ++c) {
        const int cn = c + 1 < NCHUNK ? c + 1 : c;
        LAS unsigned char* kimg = kteam + (c & 1) * (KIMG_BYTES + VIMG_BYTES); LAS unsigned char* vimg = kimg + KIMG_BYTES;
        float w_old = 0.f, m_new = 0.f; bf16x8 qf[4];
        if (valid) {
            asm volatile("" : "+v"(lane)); fr = lane & 15; fq = lane >> 4;
            __builtin_amdgcn_s_waitcnt(0x0F70);
            const float lf0 = lfpre, li0 = lipre;
            { LAS unsigned char* wp = kimg + (16 * tb + (lane >> 2)) * KIMG_STRIDE + (lane & 3) * 64;
#pragma unroll
              for (int i = 0; i < 4; ++i) *(LAS u32x4*)(wp + 16 * i) = kpre[i];
              const u32x4 vv = vpre;
              LAS unsigned char* vp = vimg + (16 * tb + (lane >> 2)) * VIMG_STRIDE + (lane & 3) * 16;
              *(LAS u32x2*)vp = (u32x2){vv[0], vv[1]}; *(LAS u32x2*)(vp + 8) = (u32x2){vv[2], vv[3]}; }
#pragma unroll
            for (int kc = 0; kc < 4; ++kc) qf[kc] = qpre[kc];
            LOAD_CHUNK(cn);
            {
                float lf = lf0, li = li0;
                if (c == 0 && lane < 48) { lf = 0.f; li = -1e30f; }
                const float bc = wave_scan_sum(lf);
                const float b_end = __builtin_bit_cast(float, __builtin_amdgcn_readlane(__builtin_bit_cast(int, bc), 63));
                const float decay = b_end - bc + li;
                m_new = fmaxf(b_end + m_st, wave_max_last(decay));
                w_old = __expf(b_end + m_st - m_new);
                sc[lane] = li - bc; sc[64 + lane] = __expf(decay - m_new); sc[128 + lane] = bc;
            }
        }
        asm volatile("s_waitcnt lgkmcnt(0)" ::: "memory");
        __builtin_amdgcn_s_barrier();
        asm volatile("" ::: "memory");
        if (valid) {
            bf16x8 vf[2][2], wvf[2][2];
#pragma unroll
            for (int ks = 0; ks < 2; ++ks) { const f32x4 wi0 = *(const LAS f32x4*)(sc + 64 + 32 * ks + 4 * fq), wi1 = *(const LAS f32x4*)(sc + 64 + 32 * ks + 16 + 4 * fq);
#pragma unroll
                for (int sx = 0; sx < 2; ++sx) { LAS unsigned char* tp = vimg + (32 * ks + 4 * fq + (fr >> 2)) * VIMG_STRIDE + (sx * 16 + 4 * (fr & 3)) * 2;
                    const s16x4 lo = lds_tr(tp), hi = lds_tr(tp + 16 * VIMG_STRIDE);
                    vf[sx][ks] = __builtin_shufflevector(lo, hi, 0, 1, 2, 3, 4, 5, 6, 7);
                    const u32x2 l2 = __builtin_bit_cast(u32x2, lo), h2 = __builtin_bit_cast(u32x2, hi);
                    wvf[sx][ks] = pack8((f32x4){bflo(l2[0]) * wi0[0], bfhi(l2[0]) * wi0[1], bflo(l2[1]) * wi0[2], bfhi(l2[1]) * wi0[3]},
                                        (f32x4){bflo(h2[0]) * wi1[0], bfhi(h2[0]) * wi1[1], bflo(h2[1]) * wi1[2], bfhi(h2[1]) * wi1[3]}); } }
            const int t = tb * 16 + fr;
            f32x4 S[4];
#pragma unroll
            for (int hb = 0; hb < 2; ++hb) { bf16x8 kf[2][4];
#pragma unroll
              for (int sb = 0; sb < 2; ++sb) { const LAS unsigned char* kp = kimg + ((2 * hb + sb) * 16 + fr) * KIMG_STRIDE + fq * 8;
#pragma unroll
                for (int kc = 0; kc < 4; ++kc) { const s16x4 lo = *(const LAS s16x4*)(kp + 64 * kc), hi = *(const LAS s16x4*)(kp + 64 * kc + 32); kf[sb][kc] = __builtin_shufflevector(lo, hi, 0, 1, 2, 3, 4, 5, 6, 7); } }
              __builtin_amdgcn_sched_barrier(0);
#pragma unroll
              for (int sb = 0; sb < 2; ++sb) { f32x4 acc = (f32x4){0.f, 0.f, 0.f, 0.f};
#pragma unroll
                for (int kc = 0; kc < 4; ++kc) acc = MFMA16(kf[sb][kc], qf[kc], acc);
                S[2 * hb + sb] = acc; }
              __builtin_amdgcn_sched_barrier(0); }
            const float bt = sc[128 + t];
            f32x4 gs[4];
#pragma unroll
            for (int sb = 0; sb < 4; ++sb) gs[sb] = *(const LAS f32x4*)(sc + sb * 16 + 4 * fq);
            float dmax = -1e30f;
#pragma unroll
            for (int sb = 0; sb < 4; ++sb)
#pragma unroll
                for (int jj = 0; jj < 4; ++jj) { const float d = (sb < tb || (sb == tb && fq * 4 + jj <= fr)) ? bt + gs[sb][jj] : -1e30f; dmax = fmaxf(dmax, d); }
            { auto r16 = __builtin_amdgcn_permlane16_swap(__float_as_uint(dmax), __float_as_uint(dmax), false, false); dmax = fmaxf(__uint_as_float(r16[0]), __uint_as_float(r16[1]));
              auto r32 = __builtin_amdgcn_permlane32_swap(__float_as_uint(dmax), __float_as_uint(dmax), false, false); dmax = fmaxf(__uint_as_float(r32[0]), __uint_as_float(r32[1])); }
            const float inter = bt + m_st, mt = fmaxf(inter, dmax);
            sc[192 + fr] = __expf(inter - mt);
#pragma unroll
            for (int sb = 0; sb < 4; ++sb)
#pragma unroll
                for (int jj = 0; jj < 4; ++jj) { const float e = (sb < tb || (sb == tb && fq * 4 + jj <= fr)) ? __expf(bt + gs[sb][jj] - mt) : 0.f; S[sb][jj] *= e; }
            const f32x4 wint = *(const LAS f32x4*)(sc + 192 + 4 * fq);
            const bf16x8 sw0 = pack8(S[0], S[1]), sw1 = pack8(S[2], S[3]);
#pragma unroll
            for (int sx = 0; sx < 2; ++sx) { f32x4 nm = (f32x4){0.f, 0.f, 0.f, 0.f};
#pragma unroll
                for (int kc = 0; kc < 4; ++kc) nm = MFMA16(qf[kc], pack8(C[sx][2 * kc], C[sx][2 * kc + 1]), nm);
                nm = nm * wint;
                nm = MFMA16(sw0, vf[sx][0], nm);
                nm = MFMA16(sw1, vf[sx][1], nm);
                nm_p[sx] = nm; }
            mt_p = mt;
            bf16x8 w2f[2];
            if (den_item) {
#pragma unroll
                for (int ks = 0; ks < 2; ++ks) { const f32x4 wi0 = *(const LAS f32x4*)(sc + 64 + 32 * ks + 4 * fq), wi1 = *(const LAS f32x4*)(sc + 64 + 32 * ks + 16 + 4 * fq);
                    const f32x4 z = (f32x4){0.f, 0.f, 0.f, 0.f}; w2f[ks] = pack8(fr == 0 ? wi0 : z, fr == 0 ? wi1 : z); }
                const unsigned one2 = (fr == 0) ? 0x3F803F80u : 0u; const bf16x8 onesf = __builtin_bit_cast(bf16x8, (u32x4){one2, one2, one2, one2});
                f32x4 dn = (f32x4){0.f, 0.f, 0.f, 0.f};
#pragma unroll
                for (int kc = 0; kc < 4; ++kc) dn = MFMA16(qf[kc], pack8(C2[2 * kc], C2[2 * kc + 1]), dn);
                dn = dn * wint; dn = MFMA16(sw0, onesf, dn); dn = MFMA16(sw1, onesf, dn); dn_p = dn;
            } else { w2f[0] = sw0; w2f[1] = sw0; }
#pragma unroll
            for (int dh = 0; dh < 2; ++dh) { bf16x8 kt[4][2];
#pragma unroll
                for (int d4 = 0; d4 < 4; ++d4)
#pragma unroll
                    for (int ks = 0; ks < 2; ++ks) { LAS unsigned char* tp = kimg + (32 * ks + 4 * fq + (fr >> 2)) * KIMG_STRIDE + ((dh * 4 + d4) * 16 + 4 * (fr & 3)) * 2;
                        const s16x4 lo = lds_tr(tp), hi = lds_tr(tp + 16 * KIMG_STRIDE); kt[d4][ks] = __builtin_shufflevector(lo, hi, 0, 1, 2, 3, 4, 5, 6, 7); }
                __builtin_amdgcn_sched_barrier(0);
#pragma unroll
                for (int sx = 0; sx < 2; ++sx)
#pragma unroll
                    for (int d4 = 0; d4 < 4; ++d4) { const int dt = dh * 4 + d4; f32x4 cc = C[sx][dt] * w_old;
                        cc = MFMA16(kt[d4][0], wvf[sx][0], cc); cc = MFMA16(kt[d4][1], wvf[sx][1], cc); C[sx][dt] = cc; }
                if (den_item) {
#pragma unroll
                    for (int d4 = 0; d4 < 4; ++d4) { const int dt = dh * 4 + d4; f32x4 c2 = C2[dt] * w_old;
                        c2 = MFMA16(kt[d4][0], w2f[0], c2); c2 = MFMA16(kt[d4][1], w2f[1], c2); C2[dt] = c2; } }
                __builtin_amdgcn_sched_barrier(0); }
            m_st = m_new;
            STORE_OUT(c);
        }
        asm volatile("s_waitcnt lgkmcnt(0)" ::: "memory");
    }
#undef STORE_OUT
#undef ROWOF
#undef LOAD_CHUNK
}
__device__ __forceinline__ void mlstm_den_wave(const PArgs& a, int bh, int tb, LAS unsigned char* kteam, LAS float* sc, int lane_in) {
    const GAS bf16_t* proj = (const GAS bf16_t*)(a.ws + WS_PROJ);
    const GAS float* LI = (const GAS float*)(a.ws + WS_LI); const GAS float* LF = (const GAS float*)(a.ws + WS_LF);
    GAS float* DEN = (GAS float*)(a.ws + WS_DEN); GAS float* MT = (GAS float*)(a.ws + WS_MT);
    const int b = bh >> 2, hd = bh & 3;
    int lane = lane_in; asm volatile("" : "+v"(lane));
    int fr = lane & 15, fq = lane >> 4;
    f32x4 C2[8];
#pragma unroll
    for (int i = 0; i < 8; ++i) C2[i] = (f32x4){0.f, 0.f, 0.f, 0.f};
    float m_st = 0.f;
#define ROWOF(cc, p) ((cc) == 0 ? (MREAL + ((p) < 48 ? 0 : (p) - 48)) : (b * SEQ + ((cc) - 1) * 64 + (p)))
    float lfpre = 0.f, lipre = 0.f; bf16x8 qpre[4]; f32x4 dn_p = (f32x4){0.f, 0.f, 0.f, 0.f}; float mt_p = 0.f;
#define LOAD_D(cc) do { \
        { const int rl_ = ROWOF(cc, lane); lfpre = LF[rl_ * 4 + hd]; lipre = LI[rl_ * 4 + hd]; } \
        { const GAS bf16_t* rp_ = proj + (size_t)ROWOF(cc, tb * 16 + fr) * LDP + C_Q + hd * 128 + fq * 4; \
          _Pragma("unroll") for (int kc = 0; kc < 4; ++kc) { const s16x4 lo_ = *(const GAS s16x4*)(rp_ + 32 * kc), hi_ = *(const GAS s16x4*)(rp_ + 32 * kc + 16); qpre[kc] = __builtin_shufflevector(lo_, hi_, 0, 1, 2, 3, 4, 5, 6, 7); } } } while (0)
#define STORE_D(cc) do { if ((cc) > 0 || (tb == 3 && b == 0)) { \
        if (fr == 0) { _Pragma("unroll") for (int jj = 0; jj < 4; ++jj) DEN[ROWOF(cc, tb * 16 + fq * 4 + jj) * 4 + hd] = dn_p[jj]; } \
        if (fq == 0) MT[ROWOF(cc, tb * 16 + fr) * 4 + hd] = mt_p; } } while (0)
    LOAD_D(0);
#pragma unroll 1
    for (int c = 0; c < NCHUNK; ++c) {
        const int cn = c + 1 < NCHUNK ? c + 1 : c;
        LAS unsigned char* kimg = kteam + (c & 1) * (KIMG_BYTES + VIMG_BYTES);
        float w_old, m_new; bf16x8 qf[4];
        asm volatile("" : "+v"(lane)); fr = lane & 15; fq = lane >> 4;
        __builtin_amdgcn_s_waitcnt(0x0F70);
        { const float lf0 = lfpre, li0 = lipre;
#pragma unroll
          for (int kc = 0; kc < 4; ++kc) qf[kc] = qpre[kc];
          LOAD_D(cn);
          float lf = lf0, li = li0;
          if (c == 0 && lane < 48) { lf = 0.f; li = -1e30f; }
          const float bc = wave_scan_sum(lf);
          const float b_end = __builtin_bit_cast(float, __builtin_amdgcn_readlane(__builtin_bit_cast(int, bc), 63));
          const float decay = b_end - bc + li;
          m_new = fmaxf(b_end + m_st, wave_max_last(decay));
          w_old = __expf(b_end + m_st - m_new);
          sc[lane] = li - bc; sc[64 + lane] = __expf(decay - m_new); sc[128 + lane] = bc; }
        asm volatile("s_waitcnt lgkmcnt(0)" ::: "memory");
        __builtin_amdgcn_s_barrier();
        asm volatile("" ::: "memory");
        bf16x8 w2f[2];
#pragma unroll
        for (int ks = 0; ks < 2; ++ks) { const f32x4 wi0 = *(const LAS f32x4*)(sc + 64 + 32 * ks + 4 * fq), wi1 = *(const LAS f32x4*)(sc + 64 + 32 * ks + 16 + 4 * fq);
            const f32x4 z = (f32x4){0.f, 0.f, 0.f, 0.f}; w2f[ks] = pack8(fr == 0 ? wi0 : z, fr == 0 ? wi1 : z); }
        const unsigned one2 = (fr == 0) ? 0x3F803F80u : 0u;
        const bf16x8 onesf = __builtin_bit_cast(bf16x8, (u32x4){one2, one2, one2, one2});
        const int t = tb * 16 + fr;
        f32x4 S[4];
#pragma unroll
        for (int hb = 0; hb < 2; ++hb) { bf16x8 kf[2][4];
#pragma unroll
          for (int sb = 0; sb < 2; ++sb) { const LAS unsigned char* kp = kimg + ((2 * hb + sb) * 16 + fr) * KIMG_STRIDE + fq * 8;
#pragma unroll
            for (int kc = 0; kc < 4; ++kc) { const s16x4 lo = *(const LAS s16x4*)(kp + 64 * kc), hi = *(const LAS s16x4*)(kp + 64 * kc + 32); kf[sb][kc] = __builtin_shufflevector(lo, hi, 0, 1, 2, 3, 4, 5, 6, 7); } }
          __builtin_amdgcn_sched_barrier(0);
#pragma unroll
          for (int sb = 0; sb < 2; ++sb) { f32x4 acc = (f32x4){0.f, 0.f, 0.f, 0.f};
#pragma unroll
            for (int kc = 0; kc < 4; ++kc) acc = MFMA16(kf[sb][kc], qf[kc], acc);
            S[2 * hb + sb] = acc; }
          __builtin_amdgcn_sched_barrier(0); }
        const float bt = sc[128 + t];
        f32x4 gs[4];
#pragma unroll
        for (int sb = 0; sb < 4; ++sb) gs[sb] = *(const LAS f32x4*)(sc + sb * 16 + 4 * fq);
        float dmax = -1e30f;
#pragma unroll
        for (int sb = 0; sb < 4; ++sb)
#pragma unroll
            for (int jj = 0; jj < 4; ++jj) { const float d = (sb < tb || (sb == tb && fq * 4 + jj <= fr)) ? bt + gs[sb][jj] : -1e30f; dmax = fmaxf(dmax, d); }
        { auto r16 = __builtin_amdgcn_permlane16_swap(__float_as_uint(dmax), __float_as_uint(dmax), false, false); dmax = fmaxf(__uint_as_float(r16[0]), __uint_as_float(r16[1]));
          auto r32 = __builtin_amdgcn_permlane32_swap(__float_as_uint(dmax), __float_as_uint(dmax), false, false); dmax = fmaxf(__uint_as_float(r32[0]), __uint_as_float(r32[1])); }
        const float inter = bt + m_st, mt = fmaxf(inter, dmax);
        sc[192 + fr] = __expf(inter - mt);
#pragma unroll
        for (int sb = 0; sb < 4; ++sb)
#pragma unroll
            for (int jj = 0; jj < 4; ++jj) { const float e = (sb < tb || (sb == tb && fq * 4 + jj <= fr)) ? __expf(bt + gs[sb][jj] - mt) : 0.f; S[sb][jj] *= e; }
        const f32x4 wint = *(const LAS f32x4*)(sc + 192 + 4 * fq);
        const bf16x8 sw0 = pack8(S[0], S[1]), sw1 = pack8(S[2], S[3]);
        { f32x4 dn = (f32x4){0.f, 0.f, 0.f, 0.f};
#pragma unroll
          for (int kc = 0; kc < 4; ++kc) dn = MFMA16(qf[kc], pack8(C2[2 * kc], C2[2 * kc + 1]), dn);
          dn = dn * wint; dn = MFMA16(sw0, onesf, dn); dn = MFMA16(sw1, onesf, dn);
          dn_p = dn; mt_p = mt; }
#pragma unroll
        for (int dh = 0; dh < 2; ++dh) { bf16x8 kt[4][2];
#pragma unroll
            for (int d4 = 0; d4 < 4; ++d4)
#pragma unroll
                for (int ks = 0; ks < 2; ++ks) { LAS unsigned char* tp = kimg + (32 * ks + 4 * fq + (fr >> 2)) * KIMG_STRIDE + ((dh * 4 + d4) * 16 + 4 * (fr & 3)) * 2;
                    const s16x4 lo = lds_tr(tp), hi = lds_tr(tp + 16 * KIMG_STRIDE); kt[d4][ks] = __builtin_shufflevector(lo, hi, 0, 1, 2, 3, 4, 5, 6, 7); }
            __builtin_amdgcn_sched_barrier(0);
#pragma unroll
            for (int d4 = 0; d4 < 4; ++d4) { const int dt = dh * 4 + d4; f32x4 c2 = C2[dt] * w_old;
                c2 = MFMA16(kt[d4][0], w2f[0], c2); c2 = MFMA16(kt[d4][1], w2f[1], c2); C2[dt] = c2; }
            __builtin_amdgcn_sched_barrier(0); }
        m_st = m_new;
        STORE_D(c);
        asm volatile("s_waitcnt lgkmcnt(0)" ::: "memory");
    }
#undef STORE_D
#undef LOAD_D
#undef ROWOF
}
constexpr int MCONV_OFF = MSC_OFF + 8 * 1024;
static_assert(MCONV_OFF + 4 * 9216 <= LDS_BYTES - 256, "mLSTM LDS map");
__device__ __forceinline__ void mlstm_phase(const PArgs& a, LAS unsigned char* lds, int wave, int lane, int conv_layer) {
    const int G = gridDim.x;
    LAS float* sc = (LAS float*)(lds + MSC_OFF + wave * 1024);
    const int base = (int)blockIdx.x; (void)G;
    if (base < 256) {
        if (wave < 4) mlstm_team(a, true, (base & 7) < 4 && wave == (base & 7), base >> 3, base & 7, wave, lds, sc, lane);
        else if (wave >= 4 && conv_layer >= 0) weights_stream(a, (LAS float*)(lds + MCONV_OFF + (wave - 4) * 9216), lane, base * 4 + (wave - 4), 1024, conv_layer * W_ITEMS_LAYER, NCHUNK);
        else { for (int c = 0; c < NCHUNK; ++c) { asm volatile("s_waitcnt lgkmcnt(0)" ::: "memory"); __builtin_amdgcn_s_barrier(); asm volatile("" ::: "memory"); } }
        __syncthreads();
    }
}

template <int NSTEP>
__device__ __forceinline__ f32x4 mini_dot(const GAS bf16_t* Ar, const GAS bf16_t* Br) {
    f32x4 acc = (f32x4){0.f, 0.f, 0.f, 0.f};
#pragma unroll
    for (int s0 = 0; s0 < NSTEP; s0 += 8) { constexpr int dummy = 0; (void)dummy; bf16x8 av[8], bv[8];
#pragma unroll
        for (int i = 0; i < 8; ++i) if (s0 + i < NSTEP) { av[i] = *(const GAS bf16x8*)(Ar + 32 * (s0 + i)); bv[i] = *(const GAS bf16x8*)(Br + 32 * (s0 + i)); }
#pragma unroll
        for (int i = 0; i < 8; ++i) if (s0 + i < NSTEP) acc = MFMA16(bv[i], av[i], acc); }
    return acc;
}
template <int WHICH>
__device__ __forceinline__ void mini_gemm(const PArgs& a, int l, LAS unsigned char* lds, int wave, int lane) {
    const int fr = lane & 15, fq = lane >> 4, G = gridDim.x;
    const GAS bf16_t* XA = (const GAS bf16_t*)(a.ws + WS_XA); GAS bf16_t* PROJ = (GAS bf16_t*)(a.ws + WS_PROJ); GAS bf16_t* hm = (GAS bf16_t*)(a.ws + WS_HMETA);
    LAS f32x4* red = (LAS f32x4*)lds;
    constexpr int NT = WHICH == 1 ? LDP / 16 : (WHICH == 3 ? DFF / 16 : D / 16);
    constexpr int K = WHICH == 4 ? DFF : D, KS = K / 8, NSTEP = KS / 32;
    for (int t = (int)blockIdx.x; t < NT; t += G) {
        const int n0 = t * 16;
        const GAS bf16_t* Ar = (WHICH == 4 ? (const GAS bf16_t*)PROJ : XA) + (size_t)(MREAL + fr) * K + wave * KS + 8 * fq;
        const GAS bf16_t* Wt = (const GAS bf16_t*)(a.ws + (WHICH == 1 ? WS_WT_IN + l * SZ_WT_IN : WHICH == 2 ? WS_WT_OUT + l * SZ_WT_OUT : WHICH == 3 ? WS_WT_GU + l * SZ_WT_GU : WS_WT_DN + l * SZ_WT_DN));
        const bool prod1 = (WHICH == 1 && n0 >= C_A && n0 < C_GB);
        const int r0 = WHICH == 3 ? (n0 >> 7) * 256 + (n0 & 127) : (WHICH == 1 ? (n0 < C_A ? n0 : (n0 < C_GB ? 3072 + ((n0 - C_A) >> 7) * 256 + ((n0 - C_A) & 127) : 5120 + (n0 - C_GB))) : n0);
        red[wave * 64 + lane] = mini_dot<NSTEP>(Ar, Wt + (size_t)(r0 + fr) * K + wave * KS + 8 * fq);
        if (WHICH == 3 || prod1) red[512 + wave * 64 + lane] = mini_dot<NSTEP>(Ar, Wt + (size_t)(r0 + 128 + fr) * K + wave * KS + 8 * fq);
        __syncthreads();
        if (wave == 0) {
            f32x4 acc = red[lane], up = (f32x4){0.f, 0.f, 0.f, 0.f};
#pragma unroll
            for (int w = 1; w < 8; ++w) acc = acc + red[w * 64 + lane];
            if (WHICH == 3 || prod1) { up = red[512 + lane];
#pragma unroll
                for (int w = 1; w < 8; ++w) up = up + red[512 + w * 64 + lane]; }
            if (WHICH == 1) { if (n0 < C_K) acc = acc * 0.08838834764831845f; if (prod1) acc = acc * up;
                u32x2 o; o.x = cvt_pk(acc[0], acc[1]); o.y = cvt_pk(acc[2], acc[3]); *(GAS u32x2*)(PROJ + (size_t)(MREAL + fr) * LDP + n0 + 4 * fq) = o; }
            if (WHICH == 2 || WHICH == 4) { GAS u32x2* hp = (GAS u32x2*)(hm + (size_t)fr * D + n0 + 4 * fq); const u32x2 o = *hp; u32x2 w; w.x = cvt_pk(bflo(o.x) + acc[0], bfhi(o.x) + acc[1]); w.y = cvt_pk(bflo(o.y) + acc[2], bfhi(o.y) + acc[3]); *hp = w; }
            if (WHICH == 3) { float r[4];
#pragma unroll
                for (int j = 0; j < 4; ++j) r[j] = acc[j] * up[j] * __builtin_amdgcn_rcpf(1.0f + __expf(-acc[j]));
                u32x2 o; o.x = cvt_pk(r[0], r[1]); o.y = cvt_pk(r[2], r[3]); *(GAS u32x2*)(PROJ + (size_t)(MREAL + fr) * DFF + n0 + 4 * fq) = o; }
        }
        __syncthreads();
    }
}

__device__ __forceinline__ void cat_phase(const PArgs& a, int layer, int wave, int lane) {
    const GAS bf16_t* proj = (const GAS bf16_t*)(a.ws + WS_PROJ); const GAS bf16_t* NUM = (const GAS bf16_t*)(a.ws + WS_NUM);
    const GAS float* DEN = (const GAS float*)(a.ws + WS_DEN); const GAS float* MT = (const GAS float*)(a.ws + WS_MT);
    GAS bf16_t* XA = (GAS bf16_t*)(a.ws + WS_XA);
    const GAS float* mnw = a.mnw + layer * 1024; const GAS float* cw = a.cw + layer * 3 * 1024;
    const int gw = blockIdx.x * NWAVES + wave, NGW = gridDim.x * NWAVES;
    f32x4 w4[4], k0[4], k1[4], k2[4];
#pragma unroll
    for (int j = 0; j < 4; ++j) { const int c = lane * 4 + 256 * j; w4[j] = *(const GAS f32x4*)(mnw + c); k0[j] = *(const GAS f32x4*)(cw + c); k1[j] = *(const GAS f32x4*)(cw + 1024 + c); k2[j] = *(const GAS f32x4*)(cw + 2048 + c); }
    for (int m = gw; m < MTOT; m += NGW) {
        int p1, p2;
        if (m < MREAL) { const int t = m & (SEQ - 1); p1 = t >= 1 ? m - 1 : MREAL + 15; p2 = t >= 2 ? m - 2 : MREAL + 14 + t; }
        else { const int j = (m - MREAL) & 15; p1 = j >= 1 ? m - 1 : -1; p2 = j >= 2 ? m - 2 : -1; }
        const GAS bf16_t* pr = proj + (size_t)m * LDP; const GAS bf16_t* pr1 = proj + (size_t)(p1 < 0 ? m : p1) * LDP; const GAS bf16_t* pr2 = proj + (size_t)(p2 < 0 ? m : p2) * LDP;
        const float z1 = p1 < 0 ? 0.f : 1.f, z2 = p2 < 0 ? 0.f : 1.f;
        u32x2 nv[4], ogv[4], a0[4], gb[4], a1[4], a2[4]; float den[4], mt[4];
#pragma unroll
        for (int j = 0; j < 4; ++j) { const int c = lane * 4 + 256 * j;
            nv[j] = *(const GAS u32x2*)(NUM + (size_t)m * 1024 + c); den[j] = DEN[m * 4 + j]; mt[j] = MT[m * 4 + j]; ogv[j] = *(const GAS u32x2*)(pr + C_OG + c);
            a0[j] = *(const GAS u32x2*)(pr + C_A + c); gb[j] = *(const GAS u32x2*)(pr + C_GB + c); a1[j] = *(const GAS u32x2*)(pr1 + C_A + c); a2[j] = *(const GAS u32x2*)(pr2 + C_A + c); }
#pragma unroll
        for (int j = 0; j < 4; ++j) {
            const int c = lane * 4 + 256 * j;
            const float sc = 1.0f / fmaxf(fabsf(den[j]), __expf(-mt[j]));
            const float h0 = bflo(nv[j].x) * sc, h1 = bfhi(nv[j].x) * sc, h2 = bflo(nv[j].y) * sc, h3 = bfhi(nv[j].y) * sc;
            const float r = rsqrtf(wave_sum((h0 * h0 + h1 * h1) + (h2 * h2 + h3 * h3)) * (1.0f / DV) + EPS);
            const float s0 = 1.0f / (1.0f + __expf(-bflo(ogv[j].x))), s1 = 1.0f / (1.0f + __expf(-bfhi(ogv[j].x))), s2 = 1.0f / (1.0f + __expf(-bflo(ogv[j].y))), s3 = 1.0f / (1.0f + __expf(-bfhi(ogv[j].y)));
            u32x2 o; o.x = cvt_pk(s0 * h0 * r * w4[j][0], s1 * h1 * r * w4[j][1]); o.y = cvt_pk(s2 * h2 * r * w4[j][2], s3 * h3 * r * w4[j][3]);
            *(GAS u32x2*)(XA + (size_t)m * D + c) = o;
            float cv[4];
            cv[0] = z2 * bflo(a2[j].x) * k0[j][0] + z1 * bflo(a1[j].x) * k1[j][0] + bflo(a0[j].x) * k2[j][0];
            cv[1] = z2 * bfhi(a2[j].x) * k0[j][1] + z1 * bfhi(a1[j].x) * k1[j][1] + bfhi(a0[j].x) * k2[j][1];
            cv[2] = z2 * bflo(a2[j].y) * k0[j][2] + z1 * bflo(a1[j].y) * k1[j][2] + bflo(a0[j].y) * k2[j][2];
            cv[3] = z2 * bfhi(a2[j].y) * k0[j][3] + z1 * bfhi(a1[j].y) * k1[j][3] + bfhi(a0[j].y) * k2[j][3];
            u32x2 oc; oc.x = cvt_pk(bflo(gb[j].x) * cv[0], bfhi(gb[j].x) * cv[1]); oc.y = cvt_pk(bflo(gb[j].y) * cv[2], bfhi(gb[j].y) * cv[3]);
            *(GAS u32x2*)(XA + (size_t)m * D + 1024 + c) = oc;
        }
    }
}

#ifndef MK_PER_PHASE
#define MK_PER_PHASE 0
#endif

__device__ __forceinline__ PArgs launder(const Args& s) { Args r = s;
    asm volatile("" : "+s"(r.x), "+s"(r.meta), "+s"(r.nmw), "+s"(r.win), "+s"(r.bg), "+s"(r.cw), "+s"(r.mnw), "+s"(r.wout), "+s"(r.nfw), "+s"(r.wg), "+s"(r.wu), "+s"(r.wd), "+s"(r.nfin), "+s"(r.out), "+s"(r.ws));
    PArgs q; q.x = (const GAS float*)r.x; q.meta = (const GAS float*)r.meta; q.nmw = (const GAS float*)r.nmw; q.win = (const GAS float*)r.win; q.bg = (const GAS float*)r.bg; q.cw = (const GAS float*)r.cw;
    q.mnw = (const GAS float*)r.mnw; q.wout = (const GAS float*)r.wout; q.nfw = (const GAS float*)r.nfw; q.wg = (const GAS float*)r.wg; q.wu = (const GAS float*)r.wu; q.wd = (const GAS float*)r.wd; q.nfin = (const GAS float*)r.nfin;
    q.out = (GAS float*)r.out; q.ws = (GAS unsigned char*)r.ws;
    return q; }
constexpr int N_PHASES = 17;

__global__ void __launch_bounds__(NTHREADS, 2) hymba_fwd(Args a_in) {
    extern __shared__ __attribute__((aligned(16))) unsigned char lds_raw[];
    LAS unsigned char* lds = (LAS unsigned char*)lds_raw;
    const int wave = __builtin_amdgcn_readfirstlane(threadIdx.x >> 6);
#define LANE() ({ int l_; asm volatile("v_mbcnt_lo_u32_b32 %0, -1, 0\n\tv_mbcnt_hi_u32_b32 %0, -1, %0" : "=v"(l_)); l_; })
    const int G = gridDim.x, bid = blockIdx.x;
    const int lo = a_in.ph_lo, hi = a_in.ph_hi;
    volatile LAS unsigned* MISC = (volatile LAS unsigned*)(lds + LDS_BYTES - 256);
    XcdBarrier bar; bar.bar = (unsigned*)(a_in.ws + WS_CTL); bar.x = 0; bar.st = MISC + 8;
    if (hi - lo > 1) { if (threadIdx.x < 64) MISC[threadIdx.x] = 0u; __syncthreads(); bar = xcd_barrier_post((unsigned*)(a_in.ws + WS_CTL), MISC + 8); }
#define IN(k) (lo <= (k) && (k) < hi)
#ifndef PROBE
#define PROBE 0
#endif
#define DUP(n) for (int rep_ = 0; rep_ < ((PROBE == (n)) ? 2 : 1); ++rep_)
#ifndef TPROBE
#define TPROBE 0
#endif
    unsigned long long tstart = 0ull;
#define TBEG(cls) do { if ((TPROBE >> (cls)) & 1) { if (threadIdx.x == 0 && blockIdx.x == 0) tstart = __builtin_amdgcn_s_memrealtime(); } } while (0)
#define TEND(cls) do { if ((TPROBE >> (cls)) & 1) { if (threadIdx.x == 0 && blockIdx.x == 0) MISC[16] += (unsigned)(__builtin_amdgcn_s_memrealtime() - tstart); } } while (0)
#define SEAM(k) do { TBEG(10); if (IN(k) && IN((k) + 1)) { if ((k) == 0) cg::this_grid().sync(); else xcd_barrier(bar); if (PROBE == 9) xcd_barrier(bar); } TEND(10); } while (0)
    TBEG(1); if (IN(0)) { const PArgs a = launder(a_in); DUP(1) { weights_phase(a, lds, wave, LANE()); __syncthreads(); } norm_phase<0>(a, 0, lds, wave, LANE()); __syncthreads(); } TEND(1);
    SEAM(0);
#pragma unroll
    for (int l = 0; l < 2; ++l) {
        const int p0 = 1 + 8 * l;
        TBEG(2); if (IN(p0 + 0)) DUP(2) { const PArgs a = launder(a_in); pg8::Gemm g{(const bf16_t*)(const unsigned char*)(a.ws + WS_XA), (const bf16_t*)(const unsigned char*)(a.ws + WS_WT_IN + l * SZ_WT_IN), MREAL, NPROJ, D}; pg8::StaticOrder S; S.init(MREAL, NPROJ, G, bid);
            EpiProj E{(GAS bf16_t*)(a.ws + WS_PROJ)}; pg8::gemm_phase<EpiProj, pg8::StaticOrder, true, true>(lds, g, S, E, wave); mini_gemm<1>(a, l, lds, wave, LANE()); } TEND(2);
        SEAM(p0 + 0);
        TBEG(3); if (IN(p0 + 1)) DUP(3) { const PArgs a = launder(a_in); mlstm_phase(a, lds, wave, LANE(), l == 0 ? 1 : -1); __syncthreads(); } TEND(3);
        SEAM(p0 + 1);
        TBEG(4); if (IN(p0 + 2)) DUP(4) { const PArgs a = launder(a_in); cat_phase(a, l, wave, LANE()); } TEND(4);
        SEAM(p0 + 2);
        TBEG(5); if (IN(p0 + 3)) { const PArgs a = launder(a_in); pg8::Gemm g{(const bf16_t*)(const unsigned char*)(a.ws + WS_XA), (const bf16_t*)(const unsigned char*)(a.ws + WS_WT_OUT + l * SZ_WT_OUT), MREAL, D, D}; pg8::StaticOrder S; S.init(MREAL, D, G, bid);
            EpiResid E{a.out}; pg8::gemm_phase<EpiResid, pg8::StaticOrder, true, true>(lds, g, S, E, wave); mini_gemm<2>(a, l, lds, wave, LANE()); } TEND(5);
        SEAM(p0 + 3);
        TBEG(6); if (IN(p0 + 4)) DUP(5) { const PArgs a = launder(a_in); norm_phase<2>(a, l, lds, wave, LANE()); } TEND(6);
        SEAM(p0 + 4);
        TBEG(7); if (IN(p0 + 5)) DUP(6) { const PArgs a = launder(a_in); pg8::Gemm g{(const bf16_t*)(const unsigned char*)(a.ws + WS_XA), (const bf16_t*)(const unsigned char*)(a.ws + WS_WT_GU + l * SZ_WT_GU), MREAL, NGU, D}; pg8::StaticOrder S; S.init(MREAL, NGU, G, bid);
            EpiSwiglu E{(GAS bf16_t*)(a.ws + WS_PROJ)}; pg8::gemm_phase<EpiSwiglu, pg8::StaticOrder, true, true>(lds, g, S, E, wave); mini_gemm<3>(a, l, lds, wave, LANE()); } TEND(7);
        SEAM(p0 + 5);
        TBEG(8); if (IN(p0 + 6)) { const PArgs a = launder(a_in); pg8::Gemm g{(const bf16_t*)(const unsigned char*)(a.ws + WS_PROJ), (const bf16_t*)(const unsigned char*)(a.ws + WS_WT_DN + l * SZ_WT_DN), MREAL, D, DFF}; pg8::StaticOrder S; S.init(MREAL, D, G, bid);
            EpiResid E{a.out}; pg8::gemm_phase<EpiResid, pg8::StaticOrder, true, true>(lds, g, S, E, wave); mini_gemm<4>(a, l, lds, wave, LANE()); } TEND(8);
        SEAM(p0 + 6);
        TBEG(9); if (IN(p0 + 7)) { const PArgs a = launder(a_in); if (l == 0) { norm_phase<1>(a, 1, lds, wave, LANE()); __syncthreads(); } else norm_phase<3>(a, 0, lds, wave, LANE()); } TEND(9);
        if (l == 0) SEAM(p0 + 7);
    }
    if (TPROBE) { if (threadIdx.x == 0 && blockIdx.x == 0) { const unsigned long long t0 = __builtin_amdgcn_s_memrealtime(); const unsigned dly = MISC[16]; while ((unsigned)(__builtin_amdgcn_s_memrealtime() - t0) < dly) __builtin_amdgcn_s_sleep(8); } }
#undef IN
#undef SEAM
}

extern "C" void kernel_launch(void* const* d_in, const int* in_sizes, int n_in, void* d_out, int out_size, void* d_ws, size_t ws_size, hipStream_t stream) {
    static int grid = 0;
    if (grid == 0) {
        if (n_in != 13 || in_sizes[0] != MREAL * D || out_size != MREAL * D || ws_size < WS_END) {
            fprintf(stderr, "kernel_launch: unexpected shapes (n_in %d, in0 %d, out %d, ws %zu; need ws >= %zu); nothing launched\n", n_in, n_in > 0 ? in_sizes[0] : -1, out_size, ws_size, (size_t)WS_END); grid = -1; return; }
        int dev = 0, cus = 0, per_cu = 0;
        hipGetDevice(&dev); hipDeviceGetAttribute(&cus, hipDeviceAttributeMultiprocessorCount, dev);
        if (hipFuncSetAttribute((const void*)hymba_fwd, hipFuncAttributeMaxDynamicSharedMemorySize, LDS_BYTES) != hipSuccess) { fprintf(stderr, "kernel_launch: hipFuncSetAttribute failed\n"); grid = -1; return; }
        if (hipOccupancyMaxActiveBlocksPerMultiprocessor(&per_cu, (const void*)hymba_fwd, NTHREADS, LDS_BYTES) != hipSuccess || per_cu < 1) { fprintf(stderr, "kernel_launch: occupancy query says %d\n", per_cu); per_cu = 1; }
        (void)hipGetLastError();
        grid = cus * per_cu;
        if (grid != 256) { fprintf(stderr, "kernel_launch: built for a 256-workgroup grid (MI355X, one per CU); got %d; nothing launched\n", grid); grid = -1; return; }
    }
    if (grid < 0) return;
    Args a{};
    a.x = (const float*)d_in[0]; a.meta = (const float*)d_in[1]; a.nmw = (const float*)d_in[2]; a.win = (const float*)d_in[3]; a.bg = (const float*)d_in[4]; a.cw = (const float*)d_in[5];
    a.mnw = (const float*)d_in[6]; a.wout = (const float*)d_in[7]; a.nfw = (const float*)d_in[8]; a.wg = (const float*)d_in[9]; a.wu = (const float*)d_in[10]; a.wd = (const float*)d_in[11]; a.nfin = (const float*)d_in[12];
    a.out = (float*)d_out; a.ws = (unsigned char*)d_ws;
#if MK_PER_PHASE
    for (int p = 0; p < N_PHASES; ++p) { a.ph_lo = p; a.ph_hi = p + 1; hipLaunchKernelGGL(hymba_fwd, dim3(grid), dim3(NTHREADS), LDS_BYTES, stream, a); }
#else
    a.ph_lo = 0; a.ph_hi = N_PHASES;
    if (hipMemsetAsync((char*)d_ws + WS_CTL, 0, CTL_BYTES, stream) != hipSuccess) { fprintf(stderr, "kernel_launch: memset failed\n"); return; }
    void* args[] = {&a};
    hipError_t e = hipLaunchCooperativeKernel((const void*)hymba_fwd, dim3(grid), dim3(NTHREADS), args, LDS_BYTES, stream);
    if (e != hipSuccess) fprintf(stderr, "kernel_launch: cooperative launch failed: %s (grid %d)\n", hipGetErrorString(e), grid);
#endif
}
```

```cpp
#include <hip/hip_runtime.h>
#include <hip/hip_cooperative_groups.h>
#include <cstdio>
#include <cstdint>
namespace cg = cooperative_groups;
namespace pg8 {
#define PG8_LAS __attribute__((address_space(3)))
typedef unsigned short bf16_t;
typedef short bf16x8 __attribute__((ext_vector_type(8)));
typedef float f32x4 __attribute__((ext_vector_type(4)));
typedef unsigned u32x4 __attribute__((ext_vector_type(4)));
constexpr int BM = 256, BK = 64, HALF = 128, HTB = HALF * BK * 2  , STAGE_BYTES = 8 * HTB, NXCD = 8, WGM = 8;

__host__ __device__ __forceinline__ int lds_byte(int r, int c) { const int st = (r >> 4) * 2 + (c >> 5), rr = r & 15, cc = c & 31, ob = rr * 64 + cc * 2; return st * 1024 + (ob ^ (((ob >> 9) & 1) << 5)); }
__host__ __device__ __forceinline__ void stage_rc(int b, int& R, int& C) { const int st = b / 1024, sb = b % 1024, swz = sb ^ (((sb >> 9) & 1) << 5); R = (st >> 1) * 16 + swz / 64; C = (st & 1) * 32 + (swz % 64) / 2; }
__host__ __device__ __forceinline__ int perm32(int rho) { const int n = rho >> 4, i = rho & 15; return 8 * (i >> 2) + 4 * n + (i & 3); }

struct Unit { int pm, pn; };
struct Gemm { const bf16_t* A; const bf16_t* Bt; int M, N, K; };

struct StaticOrder {
    int nM, nN, nwg, G, c;
    __host__ __device__ void init(int M, int N, int G_, int c_) { nM = M / BM; nN = N / BM; nwg = nM * nN; G = G_; c = c_; }
    __host__ __device__ bool next(int i, Unit& u) const {
        const long L = (long)i * G + c; if (L >= nwg) return false;
        int wgid = (int)L; { const int q = nwg / NXCD, r = nwg % NXCD, xcd = wgid % NXCD, off = wgid / NXCD; wgid = (xcd < r ? xcd * (q + 1) : r * (q + 1) + (xcd - r) * q) + off; }
        const int nig = WGM * nN, gid = wgid / nig, fm = gid * WGM, gsz = (nM - fm) < WGM ? (nM - fm) : WGM;
        u.pm = fm + ((wgid % nig) % gsz); u.pn = (wgid % nig) / gsz; return true;
    }
    __device__ __forceinline__ void a_ready(const Unit&) const {}
    __device__ __forceinline__ void done(const Unit&) const {}
};
__device__ __forceinline__ unsigned cvt_pk_bf16(float lo, float hi) { unsigned r; asm volatile("v_cvt_pk_bf16_f32 %0, %1, %2" : "=v"(r) : "v"(lo), "v"(hi)); return r; }
typedef float f32x2 __attribute__((ext_vector_type(2)));
template <class Epi, class Sched, bool ALIGN_EPI = false, bool SP2 = false>
__device__ __forceinline__ void gemm_phase(PG8_LAS unsigned char* lds, const Gemm g, const Sched& S, const Epi& E, const int wave_in) {
    int tid_; asm volatile("v_mbcnt_lo_u32_b32 %0, -1, 0\n\tv_mbcnt_hi_u32_b32 %0, -1, %0" : "=v"(tid_)); tid_ += wave_in * 64;
    const int tid = tid_, wid = __builtin_amdgcn_readfirstlane(tid >> 6), lane = tid & 63, wr = wid >> 2, wc = wid & 3, fr = lane & 15, fq = lane >> 4;
    const int K = g.K, nt = K / BK;
    unsigned voffA[2], voffB[2];
#pragma unroll
    for (int i = 0; i < 2; ++i) { int R, C; stage_rc(tid * 16 + i * 8192, R, C); const int Rb = Epi::PERM ? ((R & ~31) + perm32(R & 31)) : R;
        voffA[i] = (unsigned)(R * K + C) * 2u; voffB[i] = (unsigned)(Rb * K + C) * 2u; }
    const size_t kstep = (size_t)(BK * 2);
    const size_t hstep = (size_t)HALF * K * 2;
    const size_t tstep = 2 * hstep;
    const unsigned ldsw = (unsigned)wid * 1024u;
    const int aoff = lds_byte(wr * 64 + fr, fq * 8), boff = lds_byte(wc * 32 + fr, fq * 8);
#define PG8_SA(b, h) (((b) * 2 + (h)) * HTB)
#define PG8_SB(b, h) ((4 + (b) * 2 + (h)) * HTB)
#define PG8_STAGE(bufoff, gbase, voff) do { _Pragma("unroll") for (int _i = 0; _i < 2; ++_i) \
        __builtin_amdgcn_global_load_lds((const unsigned*)((const char*)(gbase) + (voff)[_i]), (PG8_LAS unsigned*)(lds + (bufoff) + ldsw + _i * 8192), 16, 0, 0); } while (0)
#define PG8_LDA(dst, b, h) do { _Pragma("unroll") for (int m = 0; m < 4; ++m) _Pragma("unroll") for (int k = 0; k < 2; ++k) dst[m][k] = *(const PG8_LAS bf16x8*)(lds + PG8_SA(b, h) + aoff + m * 2048 + k * 1024); } while (0)
#define PG8_LDB(dst, b, h) do { _Pragma("unroll") for (int n = 0; n < 2; ++n) _Pragma("unroll") for (int k = 0; k < 2; ++k) dst[n][k] = *(const PG8_LAS bf16x8*)(lds + PG8_SB(b, h) + boff + n * 2048 + k * 1024); } while (0)
#define PG8_MMA(ai, bj, At, Bt) do { __builtin_amdgcn_s_setprio(1); _Pragma("unroll") for (int m = 0; m < 4; ++m) _Pragma("unroll") for (int n = 0; n < 2; ++n) _Pragma("unroll") for (int k = 0; k < 2; ++k) \
        acc[ai][bj][m][n] = __builtin_amdgcn_mfma_f32_16x16x32_bf16(Bt[n][k], At[m][k], acc[ai][bj][m][n], 0, 0, 0); __builtin_amdgcn_s_setprio(0); } while (0)
#define PG8_WAIT_V(n) asm volatile("s_waitcnt vmcnt(" #n ")" ::: "memory")
#define PG8_WAIT_L(n) asm volatile("s_waitcnt lgkmcnt(" #n ")" ::: "memory")
#define PG8_BAR __builtin_amdgcn_s_barrier()
#define PG8_SCHED __builtin_amdgcn_sched_barrier(0)
    Unit cur, nxt; int ui = 0;
    if (!S.next(0, cur)) return;
    f32x4 acc[2][2][4][2];
#pragma unroll
    for (int a = 0; a < 2; ++a)
#pragma unroll
        for (int b = 0; b < 2; ++b)
#pragma unroll
            for (int m = 0; m < 4; ++m)
#pragma unroll
                for (int n = 0; n < 2; ++n) acc[a][b][m][n] = (f32x4){0.f, 0.f, 0.f, 0.f};
    bf16x8 At[4][2], B0[2][2], B1[2][2];
    const char* cA = (const char*)g.A + (size_t)cur.pm * tstep; const char* cB = (const char*)g.Bt + (size_t)cur.pn * tstep;
    S.a_ready(cur);
    if constexpr (SP2) {
        PG8_STAGE(PG8_SB(0, 0), cB, voffB); PG8_STAGE(PG8_SB(0, 1), cB + hstep, voffB); PG8_STAGE(PG8_SA(0, 0), cA, voffA); PG8_STAGE(PG8_SA(0, 1), cA + hstep, voffA);
        if (wr == 1) PG8_BAR;
        PG8_WAIT_V(2); PG8_BAR;
        PG8_STAGE(PG8_SB(1, 0), cB + kstep, voffB); PG8_STAGE(PG8_SA(1, 0), cA + kstep, voffA); PG8_STAGE(PG8_SB(1, 1), cB + hstep + kstep, voffB);
        PG8_WAIT_V(6); PG8_BAR;
    } else {
        PG8_STAGE(PG8_SB(0, 0), cB, voffB); PG8_STAGE(PG8_SA(0, 0), cA, voffA); PG8_STAGE(PG8_SB(0, 1), cB + hstep, voffB); PG8_STAGE(PG8_SA(0, 1), cA + hstep, voffA);
        if (wr == 1) PG8_BAR;
        PG8_WAIT_V(4); PG8_BAR;
        PG8_STAGE(PG8_SB(1, 0), cB + kstep, voffB); PG8_STAGE(PG8_SA(1, 0), cA + kstep, voffA); PG8_STAGE(PG8_SB(1, 1), cB + hstep + kstep, voffB);
        PG8_WAIT_V(6); PG8_BAR;
    }
    for (;;) {
        const bool has_next = S.next(ui + 1, nxt);
        const char* nA = has_next ? (const char*)g.A + (size_t)nxt.pm * tstep : cA; const char* nB = has_next ? (const char*)g.Bt + (size_t)nxt.pn * tstep : cB;
        for (int t = 0; t < nt; t += 2) {
            const bool last = (t == nt - 2);
            const char* a1 = cA + (size_t)(t + 1) * kstep;
            const char* a2 = last ? nA : cA + (size_t)(t + 2) * kstep; const char* b2 = last ? nB : cB + (size_t)(t + 2) * kstep;
            const char* a3 = a2 + kstep; const char* b3 = b2 + kstep;
            if (last && has_next) S.a_ready(nxt);
            if constexpr (SP2) {
            PG8_LDB(B0, 0, 0); PG8_LDB(B1, 0, 1); PG8_SCHED; PG8_LDA(At, 0, 0); PG8_STAGE(PG8_SA(1, 1), a1 + hstep, voffA);
            PG8_WAIT_V(8); PG8_WAIT_L(0); PG8_BAR; PG8_MMA(0, 0, At, B0); PG8_MMA(0, 1, At, B1); PG8_BAR; PG8_SCHED;
            PG8_LDA(At, 0, 1); PG8_STAGE(PG8_SB(0, 0), b2, voffB); PG8_STAGE(PG8_SB(0, 1), b2 + hstep, voffB); PG8_STAGE(PG8_SA(0, 0), a2, voffA);
            PG8_WAIT_V(8); PG8_WAIT_L(0); PG8_BAR; PG8_MMA(1, 0, At, B0); PG8_MMA(1, 1, At, B1); PG8_BAR; PG8_SCHED;
            PG8_LDB(B0, 1, 0); PG8_LDB(B1, 1, 1); PG8_SCHED; PG8_LDA(At, 1, 0); PG8_STAGE(PG8_SA(0, 1), a2 + hstep, voffA);
            PG8_WAIT_V(8); PG8_WAIT_L(0); PG8_BAR; PG8_MMA(0, 0, At, B0); PG8_MMA(0, 1, At, B1); PG8_BAR; PG8_SCHED;
            PG8_LDA(At, 1, 1); PG8_STAGE(PG8_SB(1, 0), b3, voffB); PG8_STAGE(PG8_SB(1, 1), b3 + hstep, voffB); PG8_STAGE(PG8_SA(1, 0), a3, voffA);
            PG8_WAIT_V(8); PG8_WAIT_L(0); PG8_BAR; PG8_MMA(1, 0, At, B0); PG8_MMA(1, 1, At, B1); PG8_BAR; PG8_SCHED;
            } else {
            PG8_LDB(B0, 0, 0); PG8_SCHED; PG8_LDA(At, 0, 0); PG8_STAGE(PG8_SA(1, 1), a1 + hstep, voffA);
            PG8_WAIT_L(8); PG8_BAR; PG8_WAIT_L(0); PG8_MMA(0, 0, At, B0); PG8_BAR; PG8_SCHED;
            PG8_LDB(B1, 0, 1); PG8_STAGE(PG8_SB(0, 0), b2, voffB);
            PG8_BAR; PG8_WAIT_L(0); PG8_MMA(0, 1, At, B1); PG8_BAR;
            PG8_LDA(At, 0, 1); PG8_STAGE(PG8_SA(0, 0), a2, voffA);
            PG8_BAR; PG8_WAIT_L(0); PG8_MMA(1, 0, At, B0); PG8_BAR; PG8_SCHED;
            PG8_STAGE(PG8_SB(0, 1), b2 + hstep, voffB);
            PG8_WAIT_V(6); PG8_BAR; PG8_MMA(1, 1, At, B1); PG8_BAR;
            PG8_LDB(B0, 1, 0); PG8_SCHED; PG8_LDA(At, 1, 0); PG8_STAGE(PG8_SA(0, 1), a2 + hstep, voffA);
            PG8_WAIT_L(8); PG8_BAR; PG8_WAIT_L(0); PG8_MMA(0, 0, At, B0); PG8_BAR; PG8_SCHED;
            PG8_LDB(B1, 1, 1); PG8_STAGE(PG8_SB(1, 0), b3, voffB);
            PG8_BAR; PG8_WAIT_L(0); PG8_MMA(0, 1, At, B1); PG8_BAR;
            PG8_LDA(At, 1, 1); PG8_STAGE(PG8_SA(1, 0), a3, voffA);
            PG8_BAR; PG8_WAIT_L(0); PG8_MMA(1, 0, At, B0); PG8_BAR; PG8_SCHED;
            PG8_STAGE(PG8_SB(1, 1), b3 + hstep, voffB);
            PG8_WAIT_V(6); PG8_BAR; PG8_MMA(1, 1, At, B1); PG8_BAR;
            }
        }
        if constexpr (ALIGN_EPI) { if (wr == 0) PG8_BAR; }
        if constexpr (!Epi::AFTER_DRAIN) { E(acc, cur, wr, wc, fr, fq); S.done(cur); }
        if (!has_next) break;
#pragma unroll
        for (int a = 0; a < 2; ++a)
#pragma unroll
            for (int b = 0; b < 2; ++b)
#pragma unroll
                for (int m = 0; m < 4; ++m)
#pragma unroll
                    for (int n = 0; n < 2; ++n) acc[a][b][m][n] = (f32x4){0.f, 0.f, 0.f, 0.f};
        cur = nxt; cA = nA; cB = nB; ++ui;
        if constexpr (ALIGN_EPI) { if (wr == 1) PG8_BAR; }
    }
    PG8_WAIT_V(0);
    if constexpr (!ALIGN_EPI) { if (wr == 0) PG8_BAR; }
    PG8_BAR;
    if constexpr (Epi::AFTER_DRAIN) { E.fused(acc, cur, wr, wc, fr, fq, lds, wid, lane); S.done(cur); }
#undef PG8_SA
#undef PG8_SB
#undef PG8_STAGE
#undef PG8_LDA
#undef PG8_LDB
#undef PG8_MMA
#undef PG8_WAIT_V
#undef PG8_WAIT_L
#undef PG8_BAR
#undef PG8_SCHED
}
}

#define LAS __attribute__((address_space(3)))
typedef unsigned short bf16_t;
typedef short bf16x8 __attribute__((ext_vector_type(8)));
typedef short s16x4 __attribute__((ext_vector_type(4)));
typedef float f32x4 __attribute__((ext_vector_type(4)));
typedef unsigned u32x4 __attribute__((ext_vector_type(4)));
typedef unsigned u32x2 __attribute__((ext_vector_type(2)));

constexpr int D = 2048, NB = 8, SEQ = 2048, NMETA = 16, NHEAD = 4, DV = 256, DQK = 128;
constexpr int MREAL = NB * SEQ;
constexpr int MMETA = NMETA;
constexpr int MTOT = MREAL + MMETA;
constexpr int MPAD = MTOT;
constexpr int DIN = 6152, NPROJ = 6144, DFF = 5632, NGU = 2 * DFF;
constexpr int LDP = 5120;
constexpr int C_Q = 0, C_K = 512, C_V = 1024, C_OG = 2048, C_A = 3072, C_GB = 4096;
constexpr float EPS = 1e-6f, GATE_CAP = 15.0f;
constexpr int NCHUNK = 33;

constexpr size_t MiB = 1u << 20;
constexpr size_t SZ_WT_IN = (size_t)NPROJ * D * 2, SZ_WT_OUT = (size_t)D * D * 2, SZ_WT_GU = (size_t)NGU * D * 2, SZ_WT_DN = (size_t)D * DFF * 2;
constexpr size_t WS_WT_IN = 0, WS_WT_OUT = 48 * MiB, WS_WT_GU = 64 * MiB, WS_WT_DN = 152 * MiB;
constexpr size_t WS_XA = 196 * MiB;
constexpr size_t WS_PROJ = 261 * MiB;
constexpr size_t WS_NUM = 456 * MiB;
constexpr size_t WS_HMETA = 489 * MiB;
constexpr size_t WS_LI = 491 * MiB, WS_LF = WS_LI + MiB / 2, WS_DEN = 492 * MiB, WS_MT = WS_DEN + MiB / 2;
constexpr size_t WS_CTL = 493 * MiB, CTL_BYTES = 65536;
constexpr size_t WS_END = 494 * MiB;
static_assert(2 * SZ_WT_IN <= WS_WT_OUT - WS_WT_IN && 2 * SZ_WT_OUT <= WS_WT_GU - WS_WT_OUT && 2 * SZ_WT_GU <= WS_WT_DN - WS_WT_GU && 2 * SZ_WT_DN <= WS_XA - WS_WT_DN, "ws map");
static_assert((size_t)MPAD * D * 2 <= WS_PROJ - WS_XA && (size_t)MPAD * NPROJ * 2 <= WS_NUM - WS_PROJ && (size_t)MPAD * 1024 * 2 <= WS_HMETA - WS_NUM, "ws map");

constexpr int LDS_BYTES = 147456;
constexpr int NWAVES = 8, NTHREADS = 512;

__device__ __forceinline__ unsigned cvt_pk(float lo, float hi) { unsigned r; asm volatile("v_cvt_pk_bf16_f32 %0, %1, %2" : "=v"(r) : "v"(lo), "v"(hi)); return r; }
__device__ __forceinline__ float bf2f(unsigned short b) { return __uint_as_float(((unsigned)b) << 16); }
__device__ __forceinline__ float bflo(unsigned w) { return __uint_as_float(w << 16); }
__device__ __forceinline__ float bfhi(unsigned w) { return __uint_as_float(w & 0xffff0000u); }
#define DPPF(old_, src_, ctrl_, rmask_) __builtin_bit_cast(float, __builtin_amdgcn_update_dpp(__builtin_bit_cast(int, (float)(old_)), __builtin_bit_cast(int, (float)(src_)), ctrl_, rmask_, 0xF, false))
__device__ __forceinline__ float wave_scan_sum(float v) {
    v += DPPF(0.f, v, 0x111, 0xF); v += DPPF(0.f, v, 0x112, 0xF); v += DPPF(0.f, v, 0x114, 0xF); v += DPPF(0.f, v, 0x118, 0xF);
    v += DPPF(0.f, v, 0x142, 0xA); v += DPPF(0.f, v, 0x143, 0xC);
    return v;
}
__device__ __forceinline__ float wave_max_last(float v) {
    const float ninf = -3.0e38f;
    v = fmaxf(v, DPPF(ninf, v, 0x111, 0xF)); v = fmaxf(v, DPPF(ninf, v, 0x112, 0xF)); v = fmaxf(v, DPPF(ninf, v, 0x114, 0xF)); v = fmaxf(v, DPPF(ninf, v, 0x118, 0xF));
    v = fmaxf(v, DPPF(ninf, v, 0x142, 0xA)); v = fmaxf(v, DPPF(ninf, v, 0x143, 0xC));
    return __builtin_bit_cast(float, __builtin_amdgcn_readlane(__builtin_bit_cast(int, v), 63));
}
__device__ __forceinline__ float wave_sum(float v) { return __builtin_bit_cast(float, __builtin_amdgcn_readlane(__builtin_bit_cast(int, wave_scan_sum(v)), 63)); }
__device__ __forceinline__ float wave_max(float v) { return wave_max_last(v); }

struct Args {
    const float *x, *meta, *nmw, *win, *bg, *cw, *mnw, *wout, *nfw, *wg, *wu, *wd, *nfin;
    float* out; unsigned char* ws; int ph_lo, ph_hi;
};
static_assert(sizeof(Args) == 15 * 8 + 8, "Args has no padding");

#define GAS __attribute__((address_space(1)))
struct PArgs {
    const GAS float *x, *meta, *nmw, *win, *bg, *cw, *mnw, *wout, *nfw, *wg, *wu, *wd, *nfin;
    GAS float* out; GAS unsigned char* ws;
};
__device__ __forceinline__ GAS bf16_t* hrow(const PArgs& a, int m) { return m < MREAL ? (GAS bf16_t*)a.out + (size_t)m * (2 * D) + D : (GAS bf16_t*)(a.ws + WS_HMETA) + (size_t)(m - MREAL) * D; }

struct EpiProj {
    static constexpr bool PERM = true, AFTER_DRAIN = false;
    GAS bf16_t* O;
    __device__ __forceinline__ void operator()(const f32x4 (&acc)[2][2][4][2], const pg8::Unit& u, int wr, int wc, int fr, int fq) const {
        const int row0 = u.pm * 256 + wr * 64 + fr;
        if (u.pn >= 12 && u.pn < 20) {
            const int col0 = C_A + (u.pn - 12) * 128 + wc * 32 + 8 * fq;
#pragma unroll
            for (int ai = 0; ai < 2; ++ai)
#pragma unroll
                for (int m = 0; m < 4; ++m) { const f32x4 v0 = acc[ai][0][m][0] * acc[ai][1][m][0], v1 = acc[ai][0][m][1] * acc[ai][1][m][1];
                    u32x4 w; w.x = cvt_pk(v0[0], v0[1]); w.y = cvt_pk(v0[2], v0[3]); w.z = cvt_pk(v1[0], v1[1]); w.w = cvt_pk(v1[2], v1[3]);
                    *(GAS u32x4*)(O + (size_t)(row0 + ai * 128 + m * 16) * LDP + col0) = w; }
        } else {
            const int colt = u.pn < 12 ? u.pn * 256 : C_GB + (u.pn - 20) * 256;
            const float sc = (colt < C_K) ? 0.08838834764831845f : 1.0f;
            const int col0 = colt + wc * 32 + 8 * fq;
#pragma unroll
            for (int ai = 0; ai < 2; ++ai)
#pragma unroll
                for (int m = 0; m < 4; ++m) { GAS bf16_t* rowp = O + (size_t)(row0 + ai * 128 + m * 16) * LDP + col0;
#pragma unroll
                    for (int bj = 0; bj < 2; ++bj) { const f32x4 v0 = acc[ai][bj][m][0] * sc, v1 = acc[ai][bj][m][1] * sc;
                        u32x4 w; w.x = cvt_pk(v0[0], v0[1]); w.y = cvt_pk(v0[2], v0[3]); w.z = cvt_pk(v1[0], v1[1]); w.w = cvt_pk(v1[2], v1[3]);
                        *(GAS u32x4*)(rowp + bj * 128) = w; } }
        }
    }
};
struct EpiResid {
    static constexpr bool PERM = true, AFTER_DRAIN = false;
    GAS float* out;
    __device__ __forceinline__ void operator()(const f32x4 (&acc)[2][2][4][2], const pg8::Unit& u, int wr, int wc, int fr, int fq) const {
        GAS bf16_t* hb = (GAS bf16_t*)out + (size_t)(u.pm * 256) * (2 * D) + D;
        const int r0 = wr * 64 + fr, col0 = u.pn * 256 + wc * 32 + 8 * fq;
#pragma unroll
        for (int ai = 0; ai < 2; ++ai) { u32x4 old[4][2];
#pragma unroll
            for (int m = 0; m < 4; ++m) { const GAS bf16_t* rowp = hb + (size_t)(r0 + ai * 128 + m * 16) * (2 * D) + col0;
#pragma unroll
                for (int bj = 0; bj < 2; ++bj) old[m][bj] = *(const GAS u32x4*)(rowp + bj * 128); }
#pragma unroll
            for (int m = 0; m < 4; ++m) { GAS bf16_t* rowp = hb + (size_t)(r0 + ai * 128 + m * 16) * (2 * D) + col0;
#pragma unroll
                for (int bj = 0; bj < 2; ++bj) { const u32x4 o = old[m][bj]; const f32x4 a0 = acc[ai][bj][m][0], a1 = acc[ai][bj][m][1];
                    u32x4 w; w.x = cvt_pk(bflo(o.x) + a0[0], bfhi(o.x) + a0[1]); w.y = cvt_pk(bflo(o.y) + a0[2], bfhi(o.y) + a0[3]); w.z = cvt_pk(bflo(o.z) + a1[0], bfhi(o.z) + a1[1]); w.w = cvt_pk(bflo(o.w) + a1[2], bfhi(o.w) + a1[3]);
                    *(GAS u32x4*)(rowp + bj * 128) = w; } }
        }
    }
};
struct EpiSwiglu {
    static constexpr bool PERM = true, AFTER_DRAIN = false;
    GAS bf16_t* O;
    __device__ __forceinline__ void operator()(const f32x4 (&acc)[2][2][4][2], const pg8::Unit& u, int wr, int wc, int fr, int fq) const {
        const int row0 = u.pm * 256 + wr * 64 + fr, col0 = u.pn * 128 + wc * 32 + 8 * fq;
#pragma unroll
        for (int ai = 0; ai < 2; ++ai)
#pragma unroll
            for (int m = 0; m < 4; ++m) { GAS bf16_t* rowp = O + (size_t)(row0 + ai * 128 + m * 16) * DFF + col0;
                float r[8];
#pragma unroll
                for (int n = 0; n < 2; ++n)
#pragma unroll
                    for (int j = 0; j < 4; ++j) { const float g = acc[ai][0][m][n][j], up = acc[ai][1][m][n][j]; r[n * 4 + j] = g * up * __builtin_amdgcn_rcpf(1.0f + __expf(-g)); }
                u32x4 w; w.x = cvt_pk(r[0], r[1]); w.y = cvt_pk(r[2], r[3]); w.z = cvt_pk(r[4], r[5]); w.w = cvt_pk(r[6], r[7]);
                *(GAS u32x4*)rowp = w; }
    }
};

#define RLX_AGENT __ATOMIC_RELAXED, __HIP_MEMORY_SCOPE_AGENT
#define XB_TMO      128
#define XB_XCNT(j)  (256  + 64 * (j))
#define XB_XSUB(j)  (1280 + 64 * (j))
#define XB_XGEN(j)  (2304 + 64 * (j))
#define XB_TOP      3328
#define XB_TOPGEN   3392
#define XCD_BAR_WORDS 3456
#define XB_SPIN_CAP (1u << 18)

__device__ __forceinline__ unsigned xb_ld(unsigned* p)              { return __hip_atomic_load(p, __ATOMIC_RELAXED, __HIP_MEMORY_SCOPE_AGENT); }
__device__ __forceinline__ unsigned xb_add(unsigned* p, unsigned v) { return __hip_atomic_fetch_add(p, v, __ATOMIC_RELAXED, __HIP_MEMORY_SCOPE_AGENT); }
__device__ __forceinline__ unsigned xb_xcc_id() { return (unsigned)__builtin_amdgcn_s_getreg((3 << 11) | 20) & 0xFu; }
#define XB_SPIN(cond, bar) do { unsigned _sp = 0; while (cond) { __builtin_amdgcn_s_sleep(1); \
    if ((++_sp & 255u) == 0u) { if (xb_ld(&(bar)[XB_TMO])) break; if (_sp > XB_SPIN_CAP) { atomicAdd(&(bar)[XB_TMO], 1u); break; } } } } while (0)

struct XcdBarrier {
    unsigned* bar; unsigned x;
    volatile LAS unsigned* st;
};

__device__ __forceinline__ XcdBarrier xcd_barrier_post(unsigned* bar, volatile LAS unsigned* st) {
    XcdBarrier b; b.bar = bar; b.x = xb_xcc_id(); b.st = st;
    if (threadIdx.x == 0) (void)xb_add(&bar[XB_XCNT(b.x)], 1u);
    return b;
}
__device__ __forceinline__ void xcd_barrier_complete(unsigned* bar, unsigned x, unsigned& nloc, unsigned& nx) {
    const unsigned G = gridDim.x * gridDim.y * gridDim.z;
    unsigned sum, cnt, mine, sp = 0u;
    for (;;) {
        sum = 0u; cnt = 0u; mine = 0u;
#pragma unroll
        for (unsigned j = 0; j < 16; ++j) { const unsigned c = xb_ld(&bar[XB_XCNT(j)]); sum += c; cnt += (c > 0u) ? 1u : 0u; mine = (j == x) ? c : mine; }
        if (sum == G) break;
        __builtin_amdgcn_s_sleep(1);
        if ((++sp & 255u) == 0u) { if (xb_ld(&bar[XB_TMO])) break; if (sp > XB_SPIN_CAP) { atomicAdd(&bar[XB_TMO], 1u); break; } }
    }
    nloc = mine > 0u ? mine : 1u; nx = cnt > 0u ? cnt : 1u;
}

__device__ __forceinline__ void xcd_barrier(const XcdBarrier& b) {
    asm volatile("s_waitcnt vmcnt(0)" ::: "memory");
    __syncthreads();
    if (threadIdx.x == 0) {
        unsigned* bar = b.bar;
        __builtin_amdgcn_s_waitcnt(0);
        unsigned nloc = b.st[0], nx = b.st[1];
        if (nloc == 0u) { xcd_barrier_complete(bar, b.x, nloc, nx); b.st[0] = nloc; b.st[1] = nx; }
        const unsigned old = xb_add(&bar[XB_XSUB(b.x)], 1u);
        const unsigned gen = old / nloc;
        if (old + 1u == (gen + 1u) * nloc) {
            __builtin_amdgcn_fence(__ATOMIC_RELEASE, "agent");
            asm volatile("s_waitcnt vmcnt(0)" ::: "memory");
            const unsigned og = xb_add(&bar[XB_TOP], 1u);
            const unsigned tg = og / nx;
            if (og + 1u == (tg + 1u) * nx) xb_add(&bar[XB_TOPGEN], 1u);
            else XB_SPIN(xb_ld(&bar[XB_TOPGEN]) == tg, bar);
            __builtin_amdgcn_fence(__ATOMIC_ACQUIRE, "agent");
            xb_add(&bar[XB_XGEN(b.x)], 1u);
            asm volatile("s_waitcnt vmcnt(0)" ::: "memory");
        } else {
            XB_SPIN(xb_ld(&bar[XB_XGEN(b.x)]) == gen, bar);
            __builtin_amdgcn_fence(__ATOMIC_ACQUIRE, "agent");
            asm volatile("s_waitcnt vmcnt(0)" ::: "memory");
        }
    }
    __syncthreads();
}


struct WItem { const GAS float* src; GAS bf16_t* dst; int ldw, K; };
__device__ __forceinline__ WItem witem(const PArgs& a, int it) {
    constexpr int I_IN = 32 * 192, I_OUT = 32 * 64, I_G = 32 * 176, I_DN = 88 * 64, I_LAYER = I_IN + I_OUT + 2 * I_G + I_DN;
    const int l = it / I_LAYER; int r = it - l * I_LAYER; WItem w;
    if (r < I_IN) { const int kb = r / 192, nb = r % 192, d0 = nb * 32; w.ldw = DIN; w.K = D; w.src = a.win + (size_t)l * D * DIN + (size_t)(kb * 64) * DIN + (d0 < 3072 ? d0 : (d0 < 5120 ? ((((d0 - 3072) & 255) < 128) ? 3080 + ((d0 - 3072) >> 8) * 128 + ((d0 - 3072) & 127) : 5128 + ((d0 - 3072) >> 8) * 128 + ((d0 - 3072) & 127)) : 4104 + (d0 - 5120))); w.dst = (GAS bf16_t*)(a.ws + WS_WT_IN + l * SZ_WT_IN) + (size_t)d0 * D + kb * 64; return w; } r -= I_IN;
    if (r < I_OUT) { const int kb = r / 64, nb = r % 64; w.ldw = D; w.K = D; w.src = a.wout + (size_t)l * D * D + (size_t)(kb * 64) * D + nb * 32; w.dst = (GAS bf16_t*)(a.ws + WS_WT_OUT + l * SZ_WT_OUT) + (size_t)(nb * 32) * D + kb * 64; return w; } r -= I_OUT;
    if (r < 2 * I_G) { const int up = r >= I_G; r -= up * I_G; const int kb = r / 176, nb = r % 176, n0 = nb * 32; w.ldw = DFF; w.K = D; w.src = (up ? a.wu : a.wg) + (size_t)l * D * DFF + (size_t)(kb * 64) * DFF + n0;
        w.dst = (GAS bf16_t*)(a.ws + WS_WT_GU + l * SZ_WT_GU) + (size_t)((n0 >> 7) * 256 + up * 128 + (n0 & 127)) * D + kb * 64; return w; } r -= 2 * I_G;
    { const int kb = r / 64, nb = r % 64; w.ldw = D; w.K = DFF; w.src = a.wd + (size_t)l * DFF * D + (size_t)(kb * 64) * D + nb * 32; w.dst = (GAS bf16_t*)(a.ws + WS_WT_DN + l * SZ_WT_DN) + (size_t)(nb * 32) * DFF + kb * 64; return w; }
}
constexpr int W_ITEMS_LAYER = 32 * 192 + 32 * 64 + 2 * 32 * 176 + 88 * 64;
__device__ __forceinline__ void weights_one(const PArgs& a, int it, LAS float* scr, int lane) {
    const WItem w = witem(a, it); const int kr = lane >> 3, n4 = (lane & 7) * 4;
    f32x4 v[8];
#pragma unroll
    for (int i = 0; i < 8; ++i) v[i] = __builtin_nontemporal_load((const GAS f32x4*)(w.src + (size_t)(8 * i + kr) * w.ldw + n4));
#pragma unroll
    for (int i = 0; i < 8; ++i) *(LAS f32x4*)(scr + (8 * i + kr) * 36 + n4) = v[i];
    asm volatile("s_waitcnt lgkmcnt(0)" ::: "memory");
    const int c = lane & 7;
#pragma unroll
    for (int j = 0; j < 4; ++j) { const int n = (lane >> 3) + 8 * j; const LAS float* s = scr + (8 * c) * 36 + n;
        u32x4 o; o.x = cvt_pk(s[0 * 36], s[1 * 36]); o.y = cvt_pk(s[2 * 36], s[3 * 36]); o.z = cvt_pk(s[4 * 36], s[5 * 36]); o.w = cvt_pk(s[6 * 36], s[7 * 36]);
        *(GAS u32x4*)(w.dst + (size_t)n * w.K + 8 * c) = o; }
    asm volatile("s_waitcnt lgkmcnt(0)" ::: "memory");
}
__device__ __forceinline__ void weights_stream(const PArgs& a, LAS float* scr, int lane, int first, int stride, int it0, int nbar) {
    const int kr = lane >> 3, n4 = (lane & 7) * 4;
    f32x4 v[8];
    int it = first;
    if (it < W_ITEMS_LAYER) { const WItem w = witem(a, it0 + it);
#pragma unroll
        for (int i = 0; i < 8; ++i) v[i] = __builtin_nontemporal_load((const GAS f32x4*)(w.src + (size_t)(8 * i + kr) * w.ldw + n4)); }
#pragma unroll 1
    for (; it < W_ITEMS_LAYER; it += stride) {
        const WItem w = witem(a, it0 + it);
#pragma unroll
        for (int i = 0; i < 8; ++i) *(LAS f32x4*)(scr + (8 * i + kr) * 36 + n4) = v[i];
        if (it + stride < W_ITEMS_LAYER) { const WItem wn = witem(a, it0 + it + stride);
#pragma unroll
            for (int i = 0; i < 8; ++i) v[i] = __builtin_nontemporal_load((const GAS f32x4*)(wn.src + (size_t)(8 * i + kr) * wn.ldw + n4)); }
        asm volatile("s_waitcnt lgkmcnt(0)" ::: "memory");
        const int c = lane & 7;
#pragma unroll
        for (int j = 0; j < 4; ++j) { const int n = (lane >> 3) + 8 * j; const LAS float* s = scr + (8 * c) * 36 + n;
            u32x4 o; o.x = cvt_pk(s[0 * 36], s[1 * 36]); o.y = cvt_pk(s[2 * 36], s[3 * 36]); o.z = cvt_pk(s[4 * 36], s[5 * 36]); o.w = cvt_pk(s[6 * 36], s[7 * 36]);
            *(GAS u32x4*)(w.dst + (size_t)n * w.K + 8 * c) = o; }
        asm volatile("s_waitcnt lgkmcnt(0)" ::: "memory");
        if (nbar > 0) { --nbar; __builtin_amdgcn_s_barrier(); asm volatile("" ::: "memory"); }
    }
    for (; nbar > 0; --nbar) { __builtin_amdgcn_s_barrier(); asm volatile("" ::: "memory"); }
}
__device__ __forceinline__ void weights_phase(const PArgs& a, LAS unsigned char* lds, int wave, int lane) {
    weights_stream(a, (LAS float*)(lds + wave * 16384), lane, blockIdx.x * NWAVES + wave, gridDim.x * NWAVES, 0, 0);
}

template <int MODE>
__device__ __forceinline__ void norm_phase(const PArgs& a, int layer, LAS unsigned char* lds, int wave, int lane) {
    const GAS float* nw = MODE <= 1 ? a.nmw + layer * D : (MODE == 2 ? a.nfw + layer * D : a.nfin);
    LAS float* WG = (LAS float*)lds;
    if (MODE <= 1) {
        const GAS float* wsrc = a.win + (size_t)layer * D * DIN + 3072;
        for (int k = wave * 64 + lane; k < D; k += NTHREADS) { const f32x4 g0 = *(const GAS f32x4*)(wsrc + (size_t)k * DIN), g1 = *(const GAS f32x4*)(wsrc + (size_t)k * DIN + 4);
            WG[0 * D + k] = g0[0]; WG[1 * D + k] = g0[1]; WG[2 * D + k] = g0[2]; WG[3 * D + k] = g0[3]; WG[4 * D + k] = g1[0]; WG[5 * D + k] = g1[1]; WG[6 * D + k] = g1[2]; WG[7 * D + k] = g1[3]; }
        __syncthreads();
    }
    GAS bf16_t* XA = (GAS bf16_t*)(a.ws + WS_XA); GAS float* LI = (GAS float*)(a.ws + WS_LI); GAS float* LF = (GAS float*)(a.ws + WS_LF);
    const int gw = blockIdx.x * NWAVES + wave, NGW = gridDim.x * NWAVES;
    f32x4 w[8];
#pragma unroll
    for (int j = 0; j < 8; ++j) w[j] = *((const GAS f32x4*)nw + lane + 64 * j);
    constexpr int MEND = (MODE == 3 ? MREAL : MTOT);
#define NORM_SRC(mm) ((mm) < MREAL ? a.x + (size_t)(mm) * D : a.meta + (size_t)(((mm) - MREAL) & 15) * D)
    f32x4 vn[8]; u32x2 hn[8];
    if (gw < MEND) { if (MODE == 0) { const GAS float* src = NORM_SRC(gw);
#pragma unroll
            for (int j = 0; j < 8; ++j) vn[j] = __builtin_nontemporal_load((const GAS f32x4*)src + lane + 64 * j); }
        else { const GAS bf16_t* src = hrow(a, gw);
#pragma unroll
            for (int j = 0; j < 8; ++j) hn[j] = *((const GAS u32x2*)src + lane + 64 * j); } }
    for (int m = gw; m < MEND; m += NGW) {
        f32x4 v[8]; float ss = 0.f;
#pragma unroll
        for (int j = 0; j < 8; ++j) { if (MODE == 0) v[j] = vn[j]; else v[j] = (f32x4){bflo(hn[j].x), bfhi(hn[j].x), bflo(hn[j].y), bfhi(hn[j].y)};
            ss += (v[j][0] * v[j][0] + v[j][1] * v[j][1]) + (v[j][2] * v[j][2] + v[j][3] * v[j][3]); }
        if (m + NGW < MEND) { if (MODE == 0) { const GAS float* src = NORM_SRC(m + NGW);
#pragma unroll
                for (int j = 0; j < 8; ++j) vn[j] = __builtin_nontemporal_load((const GAS f32x4*)src + lane + 64 * j); }
            else { const GAS bf16_t* src = hrow(a, m + NGW);
#pragma unroll
                for (int j = 0; j < 8; ++j) hn[j] = *((const GAS u32x2*)src + lane + 64 * j); } }
        if (MODE == 0) { GAS bf16_t* hp = hrow(a, m);
#pragma unroll
            for (int j = 0; j < 8; ++j) { u32x2 o; o.x = cvt_pk(v[j][0], v[j][1]); o.y = cvt_pk(v[j][2], v[j][3]); *((GAS u32x2*)hp + lane + 64 * j) = o; } }
        const float rstd = rsqrtf(wave_sum(ss) * (1.0f / D) + EPS);
#pragma unroll
        for (int j = 0; j < 8; ++j) v[j] = v[j] * rstd * w[j];
        if (MODE == 3) { GAS float* op = a.out + (size_t)m * D;
#pragma unroll
            for (int j = 0; j < 8; ++j) __builtin_nontemporal_store(v[j], (GAS f32x4*)op + lane + 64 * j);
        } else { GAS bf16_t* op = XA + (size_t)m * D;
#pragma unroll
            for (int j = 0; j < 8; ++j) { u32x2 o; o.x = cvt_pk(v[j][0], v[j][1]); o.y = cvt_pk(v[j][2], v[j][3]); *((GAS u32x2*)op + lane + 64 * j) = o; } }
        if (MODE <= 1) {
            float mine = 0.f;
#pragma unroll
            for (int g = 0; g < 8; ++g) { float s = 0.f;
#pragma unroll
                for (int j = 0; j < 8; ++j) { const f32x4 wg = *((const LAS f32x4*)(WG + g * D) + lane + 64 * j); s += (v[j][0] * wg[0] + v[j][1] * wg[1]) + (v[j][2] * wg[2] + v[j][3] * wg[3]); }
                s = wave_sum(s); mine = (lane == g) ? s : mine; }
            if (lane < 8) { const float raw = mine + a.bg[layer * 8 + lane]; const float e2 = __expf(raw * (2.0f / GATE_CAP)); const float cp = GATE_CAP * (e2 - 1.0f) / (e2 + 1.0f);
                if (lane < 4) LI[m * 4 + lane] = cp; else LF[m * 4 + lane - 4] = fminf(cp, 0.f) - __logf(1.0f + __expf(-fabsf(cp))); }
        }
    }
}

__device__ __forceinline__ bf16x8 pack8(const f32x4& x, const f32x4& y) {
    u32x4 w; w.x = cvt_pk(x[0], x[1]); w.y = cvt_pk(x[2], x[3]); w.z = cvt_pk(y[0], y[1]); w.w = cvt_pk(y[2], y[3]); return __builtin_bit_cast(bf16x8, w);
}

typedef short v4i16_t __attribute__((ext_vector_type(4)));
__device__ __forceinline__ s16x4 lds_tr(LAS unsigned char* p) { return __builtin_bit_cast(s16x4, __builtin_amdgcn_ds_read_tr16_b64_v4i16((LAS v4i16_t*)p)); }
#define MFMA16(x, y, c) __builtin_amdgcn_mfma_f32_16x16x32_bf16((x), (y), (c), 0, 0, 0)
constexpr int KIMG_STRIDE = 288, KIMG_BYTES = 64 * KIMG_STRIDE;
constexpr int VIMG_STRIDE = 72, VIMG_BYTES = 64 * VIMG_STRIDE;
constexpr int MTEAM_BYTES = 2 * (KIMG_BYTES + VIMG_BYTES);
constexpr int MSC_OFF = 2 * MTEAM_BYTES;

__device__ __forceinline__ void mlstm_team(const PArgs& a, bool valid, bool den_item, int bh, int sl, int tb, LAS unsigned char* kteam, LAS float* sc, int lane_in) {
    const GAS bf16_t* proj = (const GAS bf16_t*)(a.ws + WS_PROJ);
    const GAS float* LI = (const GAS float*)(a.ws + WS_LI); const GAS float* LF = (const GAS float*)(a.ws + WS_LF);
    GAS bf16_t* NUM = (GAS bf16_t*)(a.ws + WS_NUM); GAS float* DEN = (GAS float*)(a.ws + WS_DEN); GAS float* MT = (GAS float*)(a.ws + WS_MT);
    const int b = bh >> 2, hd = bh & 3;
    int lane = lane_in; asm volatile("" : "+v"(lane));
    int fr = lane & 15, fq = lane >> 4;
    f32x4 C[2][8], C2[8];
#pragma unroll
    for (int i = 0; i < 8; ++i) { C[0][i] = (f32x4){0.f, 0.f, 0.f, 0.f}; C[1][i] = (f32x4){0.f, 0.f, 0.f, 0.f}; C2[i] = (f32x4){0.f, 0.f, 0.f, 0.f}; }
    f32x4 dn_p = (f32x4){0.f, 0.f, 0.f, 0.f};
    float m_st = 0.f;
#define ROWOF(cc, p) ((cc) == 0 ? (MREAL + ((p) < 48 ? 0 : (p) - 48)) : (b * SEQ + ((cc) - 1) * 64 + (p)))
    u32x4 kpre[4], vpre; float lfpre = 0.f, lipre = 0.f; bf16x8 qpre[4];
    f32x4 nm_p[2]; float mt_p = 0.f; nm_p[0] = (f32x4){0.f, 0.f, 0.f, 0.f}; nm_p[1] = nm_p[0];
#define LOAD_CHUNK(cc) do { \
        { const GAS bf16_t* rp_ = proj + (size_t)ROWOF(cc, 16 * tb + (lane >> 2)) * LDP; \
          _Pragma("unroll") for (int i = 0; i < 4; ++i) kpre[i] = *(const GAS u32x4*)(rp_ + C_K + hd * 128 + (lane & 3) * 32 + 8 * i); \
          vpre = *(const GAS u32x4*)(rp_ + C_V + hd * 256 + sl * 32 + (lane & 3) * 8); } \
        { const int rl_ = ROWOF(cc, lane); lfpre = LF[rl_ * 4 + hd]; lipre = LI[rl_ * 4 + hd]; } \
        { const GAS bf16_t* rp_ = proj + (size_t)ROWOF(cc, tb * 16 + fr) * LDP + C_Q + hd * 128 + fq * 4; \
          _Pragma("unroll") for (int kc = 0; kc < 4; ++kc) { const s16x4 lo_ = *(const GAS s16x4*)(rp_ + 32 * kc), hi_ = *(const GAS s16x4*)(rp_ + 32 * kc + 16); qpre[kc] = __builtin_shufflevector(lo_, hi_, 0, 1, 2, 3, 4, 5, 6, 7); } } } while (0)
#define STORE_OUT(cc) do { if ((cc) > 0 || (tb == 3 && b == 0)) { \
        _Pragma("unroll") for (int sx = 0; sx < 2; ++sx) _Pragma("unroll") for (int jj = 0; jj < 4; ++jj) \
            NUM[(size_t)ROWOF(cc, tb * 16 + fq * 4 + jj) * 1024 + hd * 256 + sl * 32 + sx * 16 + fr] = (bf16_t)(cvt_pk(nm_p[sx][jj], 0.f) & 0xffffu); \
        if (den_item) { if (fr == 0) { _Pragma("unroll") for (int jj = 0; jj < 4; ++jj) DEN[ROWOF(cc, tb * 16 + fq * 4 + jj) * 4 + hd] = dn_p[jj]; } \
            if (fq == 0) MT[ROWOF(cc, tb * 16 + fr) * 4 + hd] = mt_p; } } } while (0)
    if (valid) LOAD_CHUNK(0);
#pragma unroll 1
    for (int c = 0; c < NCHUNK; ++c) {
        const int cn = c + 1 < NCHUNK ? c + 1 : c;
        LAS unsigned char* kimg = kteam + (c & 1) * (KIMG_BYTES + VIMG_BYTES); LAS unsigned char* vimg = kimg + KIMG_BYTES;
        float w_old = 0.f, m_new = 0.f; bf16x8 qf[4];
        if (valid) {
            asm volatile("" : "+v"(lane)); fr = lane & 15; fq = lane >> 4;
            __builtin_amdgcn_s_waitcnt(0x0F70);
            const float lf0 = lfpre, li0 = lipre;
            { LAS unsigned char* wp = kimg + (16 * tb + (lane >> 2)) * KIMG_STRIDE + (lane & 3) * 64;
#pragma unroll
              for (int i = 0; i < 4; ++i) *(LAS u32x4*)(wp + 16 * i) = kpre[i];
              const u32x4 vv = vpre;
              LAS unsigned char* vp = vimg + (16 * tb + (lane >> 2)) * VIMG_STRIDE + (lane & 3) * 16;
              *(LAS u32x2*)vp = (u32x2){vv[0], vv[1]}; *(LAS u32x2*)(vp + 8) = (u32x2){vv[2], vv[3]}; }
#pragma unroll
            for (int kc = 0; kc < 4; ++kc) qf[kc] = qpre[kc];
            LOAD_CHUNK(cn);
            {
                float lf = lf0, li = li0;
                if (c == 0 && lane < 48) { lf = 0.f; li = -1e30f; }
                const float bc = wave_scan_sum(lf);
                const float b_end = __builtin_bit_cast(float, __builtin_amdgcn_readlane(__builtin_bit_cast(int, bc), 63));
                const float decay = b_end - bc + li;
                m_new = fmaxf(b_end + m_st, wave_max_last(decay));
                w_old = __expf(b_end + m_st - m_new);
                sc[lane] = li - bc; sc[64 + lane] = __expf(decay - m_new); sc[128 + lane] = bc;
            }
        }
        asm volatile("s_waitcnt lgkmcnt(0)" ::: "memory");
        __builtin_amdgcn_s_barrier();
        asm volatile("" ::: "memory");
        if (valid) {
            bf16x8 vf[2][2], wvf[2][2];
#pragma unroll
            for (int ks = 0; ks < 2; ++ks) { const f32x4 wi0 = *(const LAS f32x4*)(sc + 64 + 32 * ks + 4 * fq), wi1 = *(const LAS f32x4*)(sc + 64 + 32 * ks + 16 + 4 * fq);
#pragma unroll
                for (int sx = 0; sx < 2; ++sx) { LAS unsigned char* tp = vimg + (32 * ks + 4 * fq + (fr >> 2)) * VIMG_STRIDE + (sx * 16 + 4 * (fr & 3)) * 2;
                    const s16x4 lo = lds_tr(tp), hi = lds_tr(tp + 16 * VIMG_STRIDE);
                    vf[sx][ks] = __builtin_shufflevector(lo, hi, 0, 1, 2, 3, 4, 5, 6, 7);
                    const u32x2 l2 = __builtin_bit_cast(u32x2, lo), h2 = __builtin_bit_cast(u32x2, hi);
                    wvf[sx][ks] = pack8((f32x4){bflo(l2[0]) * wi0[0], bfhi(l2[0]) * wi0[1], bflo(l2[1]) * wi0[2], bfhi(l2[1]) * wi0[3]},
                                        (f32x4){bflo(h2[0]) * wi1[0], bfhi(h2[0]) * wi1[1], bflo(h2[1]) * wi1[2], bfhi(h2[1]) * wi1[3]}); } }
            const int t = tb * 16 + fr;
            f32x4 S[4];
#pragma unroll
            for (int hb = 0; hb < 2; ++hb) { bf16x8 kf[2][4];
#pragma unroll
              for (int sb = 0; sb < 2; ++sb) { const LAS unsigned char* kp = kimg + ((2 * hb + sb) * 16 + fr) * KIMG_STRIDE + fq * 8;
#pragma unroll
                for (int kc = 0; kc < 4; ++kc) { const s16x4 lo = *(const LAS s16x4*)(kp + 64 * kc), hi = *(const LAS s16x4*)(kp + 64 * kc + 32); kf[sb][kc] = __builtin_shufflevector(lo, hi, 0, 1, 2, 3, 4, 5, 6, 7); } }
              __builtin_amdgcn_sched_barrier(0);
#pragma unroll
              for (int sb = 0; sb < 2; ++sb) { f32x4 acc = (f32x4){0.f, 0.f, 0.f, 0.f};
#pragma unroll
                for (int kc = 0; kc < 4; ++kc) acc = MFMA16(kf[sb][kc], qf[kc], acc);
                S[2 * hb + sb] = acc; }
              __builtin_amdgcn_sched_barrier(0); }
            const float bt = sc[128 + t];
            f32x4 gs[4];
#pragma unroll
            for (int sb = 0; sb < 4; ++sb) gs[sb] = *(const LAS f32x4*)(sc + sb * 16 + 4 * fq);
            float dmax = -1e30f;
#pragma unroll
            for (int sb = 0; sb < 4; ++sb)
#pragma unroll
                for (int jj = 0; jj < 4; ++jj) { const float d = (sb < tb || (sb == tb && fq * 4 + jj <= fr)) ? bt + gs[sb][jj] : -1e30f; dmax = fmaxf(dmax, d); }
            { auto r16 = __builtin_amdgcn_permlane16_swap(__float_as_uint(dmax), __float_as_uint(dmax), false, false); dmax = fmaxf(__uint_as_float(r16[0]), __uint_as_float(r16[1]));
              auto r32 = __builtin_amdgcn_permlane32_swap(__float_as_uint(dmax), __float_as_uint(dmax), false, false); dmax = fmaxf(__uint_as_float(r32[0]), __uint_as_float(r32[1])); }
            const float inter = bt + m_st, mt = fmaxf(inter, dmax);
            sc[192 + fr] = __expf(inter - mt);
#pragma unroll
            for (int sb = 0; sb < 4; ++sb)
#pragma unroll
                for (int jj = 0; jj < 4; ++jj) { const float e = (sb < tb || (sb == tb && fq * 4 + jj <= fr)) ? __expf(bt + gs[sb][jj] - mt) : 0.f; S[sb][jj] *= e; }
            const f32x4 wint = *(const LAS f32x4*)(sc + 192 + 4 * fq);
            const bf16x8 sw0 = pack8(S[0], S[1]), sw1 = pack8(S[2], S[3]);
#pragma unroll
            for (int sx = 0; sx < 2; ++sx) { f32x4 nm = (f32x4){0.f, 0.f, 0.f, 0.f};
#pragma unroll
                for (int kc = 0; kc < 4; ++kc) nm = MFMA16(qf[kc], pack8(C[sx][2 * kc], C[sx][2 * kc + 1]), nm);
                nm = nm * wint;
                nm = MFMA16(sw0, vf[sx][0], nm);
                nm = MFMA16(sw1, vf[sx][1], nm);
                nm_p[sx] = nm; }
            mt_p = mt;
            bf16x8 w2f[2];
            if (den_item) {
#pragma unroll
                for (int ks = 0; ks < 2; ++ks) { const f32x4 wi0 = *(const LAS f32x4*)(sc + 64 + 32 * ks + 4 * fq), wi1 = *(const LAS f32x4*)(sc + 64 + 32 * ks + 16 + 4 * fq);
                    const f32x4 z = (f32x4){0.f, 0.f, 0.f, 0.f}; w2f[ks] = pack8(fr == 0 ? wi0 : z, fr == 0 ? wi1 : z); }
                const unsigned one2 = (fr == 0) ? 0x3F803F80u : 0u; const bf16x8 onesf = __builtin_bit_cast(bf16x8, (u32x4){one2, one2, one2, one2});
                f32x4 dn = (f32x4){0.f, 0.f, 0.f, 0.f};
#pragma unroll
                for (int kc = 0; kc < 4; ++kc) dn = MFMA16(qf[kc], pack8(C2[2 * kc], C2[2 * kc + 1]), dn);
                dn = dn * wint; dn = MFMA16(sw0, onesf, dn); dn = MFMA16(sw1, onesf, dn); dn_p = dn;
            } else { w2f[0] = sw0; w2f[1] = sw0; }
#pragma unroll
            for (int dh = 0; dh < 2; ++dh) { bf16x8 kt[4][2];
#pragma unroll
                for (int d4 = 0; d4 < 4; ++d4)
#pragma unroll
                    for (int ks = 0; ks < 2; ++ks) { LAS unsigned char* tp = kimg + (32 * ks + 4 * fq + (fr >> 2)) * KIMG_STRIDE + ((dh * 4 + d4) * 16 + 4 * (fr & 3)) * 2;
                        const s16x4 lo = lds_tr(tp), hi = lds_tr(tp + 16 * KIMG_STRIDE); kt[d4][ks] = __builtin_shufflevector(lo, hi, 0, 1, 2, 3, 4, 5, 6, 7); }
                __builtin_amdgcn_sched_barrier(0);
#pragma unroll
                for (int sx = 0; sx < 2; ++sx)
#pragma unroll
                    for (int d4 = 0; d4 < 4; ++d4) { const int dt = dh * 4 + d4; f32x4 cc = C[sx][dt] * w_old;
                        cc = MFMA16(kt[d4][0], wvf[sx][0], cc); cc = MFMA16(kt[d4][1], wvf[sx][1], cc); C[sx][dt] = cc; }
                if (den_item) {
#pragma unroll
                    for (int d4 = 0; d4 < 4; ++d4) { const int dt = dh * 4 + d4; f32x4 c2 = C2[dt] * w_old;
                        c2 = MFMA16(kt[d4][0], w2f[0], c2); c2 = MFMA16(kt[d4][1], w2f[1], c2); C2[dt] = c2; } }
                __builtin_amdgcn_sched_barrier(0); }
            m_st = m_new;
            STORE_OUT(c);
        }
        asm volatile("s_waitcnt lgkmcnt(0)" ::: "memory");
    }
#undef STORE_OUT
#undef ROWOF
#undef LOAD_CHUNK
}
__device__ __forceinline__ void mlstm_den_wave(const PArgs& a, int bh, int tb, LAS unsigned char* kteam, LAS float* sc, int lane_in) {
    const GAS bf16_t* proj = (const GAS bf16_t*)(a.ws + WS_PROJ);
    const GAS float* LI = (const GAS float*)(a.ws + WS_LI); const GAS float* LF = (const GAS float*)(a.ws + WS_LF);
    GAS float* DEN = (GAS float*)(a.ws + WS_DEN); GAS float* MT = (GAS float*)(a.ws + WS_MT);
    const int b = bh >> 2, hd = bh & 3;
    int lane = lane_in; asm volatile("" : "+v"(lane));
    int fr = lane & 15, fq = lane >> 4;
    f32x4 C2[8];
#pragma unroll
    for (int i = 0; i < 8; ++i) C2[i] = (f32x4){0.f, 0.f, 0.f, 0.f};
    float m_st = 0.f;
#define ROWOF(cc, p) ((cc) == 0 ? (MREAL + ((p) < 48 ? 0 : (p) - 48)) : (b * SEQ + ((cc) - 1) * 64 + (p)))
    float lfpre = 0.f, lipre = 0.f; bf16x8 qpre[4]; f32x4 dn_p = (f32x4){0.f, 0.f, 0.f, 0.f}; float mt_p = 0.f;
#define LOAD_D(cc) do { \
        { const int rl_ = ROWOF(cc, lane); lfpre = LF[rl_ * 4 + hd]; lipre = LI[rl_ * 4 + hd]; } \
        { const GAS bf16_t* rp_ = proj + (size_t)ROWOF(cc, tb * 16 + fr) * LDP + C_Q + hd * 128 + fq * 4; \
          _Pragma("unroll") for (int kc = 0; kc < 4; ++kc) { const s16x4 lo_ = *(const GAS s16x4*)(rp_ + 32 * kc), hi_ = *(const GAS s16x4*)(rp_ + 32 * kc + 16); qpre[kc] = __builtin_shufflevector(lo_, hi_, 0, 1, 2, 3, 4, 5, 6, 7); } } } while (0)
#define STORE_D(cc) do { if ((cc) > 0 || (tb == 3 && b == 0)) { \
        if (fr == 0) { _Pragma("unroll") for (int jj = 0; jj < 4; ++jj) DEN[ROWOF(cc, tb * 16 + fq * 4 + jj) * 4 + hd] = dn_p[jj]; } \
        if (fq == 0) MT[ROWOF(cc, tb * 16 + fr) * 4 + hd] = mt_p; } } while (0)
    LOAD_D(0);
#pragma unroll 1
    for (int c = 0; c < NCHUNK; ++c) {
        const int cn = c + 1 < NCHUNK ? c + 1 : c;
        LAS unsigned char* kimg = kteam + (c & 1) * (KIMG_BYTES + VIMG_BYTES);
        float w_old, m_new; bf16x8 qf[4];
        asm volatile("" : "+v"(lane)); fr = lane & 15; fq = lane >> 4;
        __builtin_amdgcn_s_waitcnt(0x0F70);
        { const float lf0 = lfpre, li0 = lipre;
#pragma unroll
          for (int kc = 0; kc < 4; ++kc) qf[kc] = qpre[kc];
          LOAD_D(cn);
          float lf = lf0, li = li0;
          if (c == 0 && lane < 48) { lf = 0.f; li = -1e30f; }
          const float bc = wave_scan_sum(lf);
          const float b_end = __builtin_bit_cast(float, __builtin_amdgcn_readlane(__builtin_bit_cast(int, bc), 63));
          const float decay = b_end - bc + li;
          m_new = fmaxf(b_end + m_st, wave_max_last(decay));
          w_old = __expf(b_end + m_st - m_new);
          sc[lane] = li - bc; sc[64 + lane] = __expf(decay - m_new); sc[128 + lane] = bc; }
        asm volatile("s_waitcnt lgkmcnt(0)" ::: "memory");
        __builtin_amdgcn_s_barrier();
        asm volatile("" ::: "memory");
        bf16x8 w2f[2];
#pragma unroll
        for (int ks = 0; ks < 2; ++ks) { const f32x4 wi0 = *(const LAS f32x4*)(sc + 64 + 32 * ks + 4 * fq), wi1 = *(const LAS f32x4*)(sc + 64 + 32 * ks + 16 + 4 * fq);
            const f32x4 z = (f32x4){0.f, 0.f, 0.f, 0.f}; w2f[ks] = pack8(fr == 0 ? wi0 : z, fr == 0 ? wi1 : z); }
        const unsigned one2 = (fr == 0) ? 0x3F803F80u : 0u;
        const bf16x8 onesf = __builtin_bit_cast(bf16x8, (u32x4){one2, one2, one2, one2});
        const int t = tb * 16 + fr;
        f32x4 S[4];
#pragma unroll
        for (int hb = 0; hb < 2; ++hb) { bf16x8 kf[2][4];
#pragma unroll
          for (int sb = 0; sb < 2; ++sb) { const LAS unsigned char* kp = kimg + ((2 * hb + sb) * 16 + fr) * KIMG_STRIDE + fq * 8;
#pragma unroll
            for (int kc = 0; kc < 4; ++kc) { const s16x4 lo = *(const LAS s16x4*)(kp + 64 * kc), hi = *(const LAS s16x4*)(kp + 64 * kc + 32); kf[sb][kc] = __builtin_shufflevector(lo, hi, 0, 1, 2, 3, 4, 5, 6, 7); } }
          __builtin_amdgcn_sched_barrier(0);
#pragma unroll
          for (int sb = 0; sb < 2; ++sb) { f32x4 acc = (f32x4){0.f, 0.f, 0.f, 0.f};
#pragma unroll
            for (int kc = 0; kc < 4; ++kc) acc = MFMA16(kf[sb][kc], qf[kc], acc);
            S[2 * hb + sb] = acc; }
          __builtin_amdgcn_sched_barrier(0); }
        const float bt = sc[128 + t];
        f32x4 gs[4];
#pragma unroll
        for (int sb = 0; sb < 4; ++sb) gs[sb] = *(const LAS f32x4*)(sc + sb * 16 + 4 * fq);
        float dmax = -1e30f;
#pragma unroll
        for (int sb = 0; sb < 4; ++sb)
#pragma unroll
            for (int jj = 0; jj < 4; ++jj) { const float d = (sb < tb || (sb == tb && fq * 4 + jj <= fr)) ? bt + gs[sb][jj] : -1e30f; dmax = fmaxf(dmax, d); }
        { auto r16 = __builtin_amdgcn_permlane16_swap(__float_as_uint(dmax), __float_as_uint(dmax), false, false); dmax = fmaxf(__uint_as_float(r16[0]), __uint_as_float(r16[1]));
          auto r32 = __builtin_amdgcn_permlane32_swap(__float_as_uint(dmax), __float_as_uint(dmax), false, false); dmax = fmaxf(__uint_as_float(r32[0]), __uint_as_float(r32[1])); }
        const float inter = bt + m_st, mt = fmaxf(inter, dmax);
        sc[192 + fr] = __expf(inter - mt);
#pragma unroll
        for (int sb = 0; sb < 4; ++sb)
#pragma unroll
            for (int jj = 0; jj < 4; ++jj) { const float e = (sb < tb || (sb == tb && fq * 4 + jj <= fr)) ? __expf(bt + gs[sb][jj] - mt) : 0.f; S[sb][jj] *= e; }
        const f32x4 wint = *(const LAS f32x4*)(sc + 192 + 4 * fq);
        const bf16x8 sw0 = pack8(S[0], S[1]), sw1 = pack8(S[2], S[3]);
        { f32x4 dn = (f32x4){0.f, 0.f, 0.f, 0.f};
#pragma unroll
          for (int kc = 0; kc < 4; ++kc) dn = MFMA16(qf[kc], pack8(C2[2 * kc], C2[2 * kc + 1]), dn);
          dn = dn * wint; dn = MFMA16(sw0, onesf, dn); dn = MFMA16(sw1, onesf, dn);
          dn_p = dn; mt_p = mt; }
#pragma unroll
        for (int dh = 0; dh < 2; ++dh) { bf16x8 kt[4][2];
#pragma unroll
            for (int d4 = 0; d4 < 4; ++d4)
#pragma unroll
                for (int ks = 0; ks < 2; ++ks) { LAS unsigned char* tp = kimg + (32 * ks + 4 * fq + (fr >> 2)) * KIMG_STRIDE + ((dh * 4 + d4) * 16 + 4 * (fr & 3)) * 2;
                    const s16x4 lo = lds_tr(tp), hi = lds_tr(tp + 16 * KIMG_STRIDE); kt[d4][ks] = __builtin_shufflevector(lo, hi, 0, 1, 2, 3, 4, 5, 6, 7); }
            __builtin_amdgcn_sched_barrier(0);
#pragma unroll
            for (int d4 = 0; d4 < 4; ++d4) { const int dt = dh * 4 + d4; f32x4 c2 = C2[dt] * w_old;
                c2 = MFMA16(kt[d4][0], w2f[0], c2); c2 = MFMA16(kt[d4][1], w2f[1], c2); C2[dt] = c2; }
            __builtin_amdgcn_sched_barrier(0); }
        m_st = m_new;
        STORE_D(c);
        asm volatile("s_waitcnt lgkmcnt(0)" ::: "memory");
    }
#undef STORE_D
#undef LOAD_D
#undef ROWOF
}
constexpr int MCONV_OFF = MSC_OFF + 8 * 1024;
static_assert(MCONV_OFF + 4 * 9216 <= LDS_BYTES - 256, "mLSTM LDS map");
__device__ __forceinline__ void mlstm_phase(const PArgs& a, LAS unsigned char* lds, int wave, int lane, int conv_layer) {
    const int G = gridDim.x;
    LAS float* sc = (LAS float*)(lds + MSC_OFF + wave * 1024);
    const int base = (int)blockIdx.x; (void)G;
    if (base < 256) {
        if (wave < 4) { const bool crit = (base & 7) < 4 && wave == (base & 7); if (crit) __builtin_amdgcn_s_setprio(1);
            mlstm_team(a, true, crit, base >> 3, base & 7, wave, lds, sc, lane); __builtin_amdgcn_s_setprio(0); }
        else if (wave >= 5 && conv_layer >= 0) weights_stream(a, (LAS float*)(lds + MCONV_OFF + (wave - 5) * 9216), lane, base * 3 + (wave - 5), 768, conv_layer * W_ITEMS_LAYER, NCHUNK);
        else { for (int c = 0; c < NCHUNK; ++c) { asm volatile("s_waitcnt lgkmcnt(0)" ::: "memory"); __builtin_amdgcn_s_barrier(); asm volatile("" ::: "memory"); } }
        __syncthreads();
    }
}

template <int NSTEP>
__device__ __forceinline__ f32x4 mini_dot(const GAS bf16_t* Ar, const GAS bf16_t* Br) {
    f32x4 acc = (f32x4){0.f, 0.f, 0.f, 0.f};
#pragma unroll
    for (int s0 = 0; s0 < NSTEP; s0 += 8) { constexpr int dummy = 0; (void)dummy; bf16x8 av[8], bv[8];
#pragma unroll
        for (int i = 0; i < 8; ++i) if (s0 + i < NSTEP) { av[i] = *(const GAS bf16x8*)(Ar + 32 * (s0 + i)); bv[i] = *(const GAS bf16x8*)(Br + 32 * (s0 + i)); }
#pragma unroll
        for (int i = 0; i < 8; ++i) if (s0 + i < NSTEP) acc = MFMA16(bv[i], av[i], acc); }
    return acc;
}
template <int WHICH>
__device__ __forceinline__ void mini_gemm(const PArgs& a, int l, LAS unsigned char* lds, int wave, int lane) {
    const int fr = lane & 15, fq = lane >> 4, G = gridDim.x;
    const GAS bf16_t* XA = (const GAS bf16_t*)(a.ws + WS_XA); GAS bf16_t* PROJ = (GAS bf16_t*)(a.ws + WS_PROJ); GAS bf16_t* hm = (GAS bf16_t*)(a.ws + WS_HMETA);
    LAS f32x4* red = (LAS f32x4*)lds;
    constexpr int NT = WHICH == 1 ? LDP / 16 : (WHICH == 3 ? DFF / 16 : D / 16);
    constexpr int K = WHICH == 4 ? DFF : D, KS = K / 8, NSTEP = KS / 32;
    for (int t = (int)blockIdx.x; t < NT; t += G) {
        const int n0 = t * 16;
        const GAS bf16_t* Ar = (WHICH == 4 ? (const GAS bf16_t*)PROJ : XA) + (size_t)(MREAL + fr) * K + wave * KS + 8 * fq;
        const GAS bf16_t* Wt = (const GAS bf16_t*)(a.ws + (WHICH == 1 ? WS_WT_IN + l * SZ_WT_IN : WHICH == 2 ? WS_WT_OUT + l * SZ_WT_OUT : WHICH == 3 ? WS_WT_GU + l * SZ_WT_GU : WS_WT_DN + l * SZ_WT_DN));
        const bool prod1 = (WHICH == 1 && n0 >= C_A && n0 < C_GB);
        const int r0 = WHICH == 3 ? (n0 >> 7) * 256 + (n0 & 127) : (WHICH == 1 ? (n0 < C_A ? n0 : (n0 < C_GB ? 3072 + ((n0 - C_A) >> 7) * 256 + ((n0 - C_A) & 127) : 5120 + (n0 - C_GB))) : n0);
        red[wave * 64 + lane] = mini_dot<NSTEP>(Ar, Wt + (size_t)(r0 + fr) * K + wave * KS + 8 * fq);
        if (WHICH == 3 || prod1) red[512 + wave * 64 + lane] = mini_dot<NSTEP>(Ar, Wt + (size_t)(r0 + 128 + fr) * K + wave * KS + 8 * fq);
        __syncthreads();
        if (wave == 0) {
            f32x4 acc = red[lane], up = (f32x4){0.f, 0.f, 0.f, 0.f};
#pragma unroll
            for (int w = 1; w < 8; ++w) acc = acc + red[w * 64 + lane];
            if (WHICH == 3 || prod1) { up = red[512 + lane];
#pragma unroll
                for (int w = 1; w < 8; ++w) up = up + red[512 + w * 64 + lane]; }
            if (WHICH == 1) { if (n0 < C_K) acc = acc * 0.08838834764831845f; if (prod1) acc = acc * up;
                u32x2 o; o.x = cvt_pk(acc[0], acc[1]); o.y = cvt_pk(acc[2], acc[3]); *(GAS u32x2*)(PROJ + (size_t)(MREAL + fr) * LDP + n0 + 4 * fq) = o; }
            if (WHICH == 2 || WHICH == 4) { GAS u32x2* hp = (GAS u32x2*)(hm + (size_t)fr * D + n0 + 4 * fq); const u32x2 o = *hp; u32x2 w; w.x = cvt_pk(bflo(o.x) + acc[0], bfhi(o.x) + acc[1]); w.y = cvt_pk(bflo(o.y) + acc[2], bfhi(o.y) + acc[3]); *hp = w; }
            if (WHICH == 3) { float r[4];
#pragma unroll
                for (int j = 0; j < 4; ++j) r[j] = acc[j] * up[j] * __builtin_amdgcn_rcpf(1.0f + __expf(-acc[j]));
                u32x2 o; o.x = cvt_pk(r[0], r[1]); o.y = cvt_pk(r[2], r[3]); *(GAS u32x2*)(PROJ + (size_t)(MREAL + fr) * DFF + n0 + 4 * fq) = o; }
        }
        __syncthreads();
    }
}

__device__ __forceinline__ void cat_phase(const PArgs& a, int layer, int wave, int lane) {
    const GAS bf16_t* proj = (const GAS bf16_t*)(a.ws + WS_PROJ); const GAS bf16_t* NUM = (const GAS bf16_t*)(a.ws + WS_NUM);
    const GAS float* DEN = (const GAS float*)(a.ws + WS_DEN); const GAS float* MT = (const GAS float*)(a.ws + WS_MT);
    GAS bf16_t* XA = (GAS bf16_t*)(a.ws + WS_XA);
    const GAS float* mnw = a.mnw + layer * 1024; const GAS float* cw = a.cw + layer * 3 * 1024;
    const int gw = blockIdx.x * NWAVES + wave, NGW = gridDim.x * NWAVES;
    f32x4 w4[4], k0[4], k1[4], k2[4];
#pragma unroll
    for (int j = 0; j < 4; ++j) { const int c = lane * 4 + 256 * j; w4[j] = *(const GAS f32x4*)(mnw + c); k0[j] = *(const GAS f32x4*)(cw + c); k1[j] = *(const GAS f32x4*)(cw + 1024 + c); k2[j] = *(const GAS f32x4*)(cw + 2048 + c); }
    for (int m = gw; m < MTOT; m += NGW) {
        int p1, p2;
        if (m < MREAL) { const int t = m & (SEQ - 1); p1 = t >= 1 ? m - 1 : MREAL + 15; p2 = t >= 2 ? m - 2 : MREAL + 14 + t; }
        else { const int j = (m - MREAL) & 15; p1 = j >= 1 ? m - 1 : -1; p2 = j >= 2 ? m - 2 : -1; }
        const GAS bf16_t* pr = proj + (size_t)m * LDP; const GAS bf16_t* pr1 = proj + (size_t)(p1 < 0 ? m : p1) * LDP; const GAS bf16_t* pr2 = proj + (size_t)(p2 < 0 ? m : p2) * LDP;
        const float z1 = p1 < 0 ? 0.f : 1.f, z2 = p2 < 0 ? 0.f : 1.f;
        u32x2 nv[4], ogv[4], a0[4], gb[4], a1[4], a2[4]; float den[4], mt[4];
#pragma unroll
        for (int j = 0; j < 4; ++j) { const int c = lane * 4 + 256 * j;
            nv[j] = *(const GAS u32x2*)(NUM + (size_t)m * 1024 + c); den[j] = DEN[m * 4 + j]; mt[j] = MT[m * 4 + j]; ogv[j] = *(const GAS u32x2*)(pr + C_OG + c);
            a0[j] = *(const GAS u32x2*)(pr + C_A + c); gb[j] = *(const GAS u32x2*)(pr + C_GB + c); a1[j] = *(const GAS u32x2*)(pr1 + C_A + c); a2[j] = *(const GAS u32x2*)(pr2 + C_A + c); }
#pragma unroll
        for (int j = 0; j < 4; ++j) {
            const int c = lane * 4 + 256 * j;
            const float sc = 1.0f / fmaxf(fabsf(den[j]), __expf(-mt[j]));
            const float h0 = bflo(nv[j].x) * sc, h1 = bfhi(nv[j].x) * sc, h2 = bflo(nv[j].y) * sc, h3 = bfhi(nv[j].y) * sc;
            const float r = rsqrtf(wave_sum((h0 * h0 + h1 * h1) + (h2 * h2 + h3 * h3)) * (1.0f / DV) + EPS);
            const float s0 = 1.0f / (1.0f + __expf(-bflo(ogv[j].x))), s1 = 1.0f / (1.0f + __expf(-bfhi(ogv[j].x))), s2 = 1.0f / (1.0f + __expf(-bflo(ogv[j].y))), s3 = 1.0f / (1.0f + __expf(-bfhi(ogv[j].y)));
            u32x2 o; o.x = cvt_pk(s0 * h0 * r * w4[j][0], s1 * h1 * r * w4[j][1]); o.y = cvt_pk(s2 * h2 * r * w4[j][2], s3 * h3 * r * w4[j][3]);
            *(GAS u32x2*)(XA + (size_t)m * D + c) = o;
            float cv[4];
            cv[0] = z2 * bflo(a2[j].x) * k0[j][0] + z1 * bflo(a1[j].x) * k1[j][0] + bflo(a0[j].x) * k2[j][0];
            cv[1] = z2 * bfhi(a2[j].x) * k0[j][1] + z1 * bfhi(a1[j].x) * k1[j][1] + bfhi(a0[j].x) * k2[j][1];
            cv[2] = z2 * bflo(a2[j].y) * k0[j][2] + z1 * bflo(a1[j].y) * k1[j][2] + bflo(a0[j].y) * k2[j][2];
            cv[3] = z2 * bfhi(a2[j].y) * k0[j][3] + z1 * bfhi(a1[j].y) * k1[j][3] + bfhi(a0[j].y) * k2[j][3];
            u32x2 oc; oc.x = cvt_pk(bflo(gb[j].x) * cv[0], bfhi(gb[j].x) * cv[1]); oc.y = cvt_pk(bflo(gb[j].y) * cv[2], bfhi(gb[j].y) * cv[3]);
            *(GAS u32x2*)(XA + (size_t)m * D + 1024 + c) = oc;
        }
    }
}

#ifndef MK_PER_PHASE
#define MK_PER_PHASE 0
#endif

__device__ __forceinline__ PArgs launder(const Args& s) { Args r = s;
    asm volatile("" : "+s"(r.x), "+s"(r.meta), "+s"(r.nmw), "+s"(r.win), "+s"(r.bg), "+s"(r.cw), "+s"(r.mnw), "+s"(r.wout), "+s"(r.nfw), "+s"(r.wg), "+s"(r.wu), "+s"(r.wd), "+s"(r.nfin), "+s"(r.out), "+s"(r.ws));
    PArgs q; q.x = (const GAS float*)r.x; q.meta = (const GAS float*)r.meta; q.nmw = (const GAS float*)r.nmw; q.win = (const GAS float*)r.win; q.bg = (const GAS float*)r.bg; q.cw = (const GAS float*)r.cw;
    q.mnw = (const GAS float*)r.mnw; q.wout = (const GAS float*)r.wout; q.nfw = (const GAS float*)r.nfw; q.wg = (const GAS float*)r.wg; q.wu = (const GAS float*)r.wu; q.wd = (const GAS float*)r.wd; q.nfin = (const GAS float*)r.nfin;
    q.out = (GAS float*)r.out; q.ws = (GAS unsigned char*)r.ws;
    return q; }
constexpr int N_PHASES = 17;

__global__ void __launch_bounds__(NTHREADS, 2) hymba_fwd(Args a_in) {
    extern __shared__ __attribute__((aligned(16))) unsigned char lds_raw[];
    LAS unsigned char* lds = (LAS unsigned char*)lds_raw;
    const int wave = __builtin_amdgcn_readfirstlane(threadIdx.x >> 6);
#define LANE() ({ int l_; asm volatile("v_mbcnt_lo_u32_b32 %0, -1, 0\n\tv_mbcnt_hi_u32_b32 %0, -1, %0" : "=v"(l_)); l_; })
    const int G = gridDim.x, bid = blockIdx.x;
    const int lo = a_in.ph_lo, hi = a_in.ph_hi;
    volatile LAS unsigned* MISC = (volatile LAS unsigned*)(lds + LDS_BYTES - 256);
    XcdBarrier bar; bar.bar = (unsigned*)(a_in.ws + WS_CTL); bar.x = 0; bar.st = MISC + 8;
    if (hi - lo > 1) { if (threadIdx.x < 64) MISC[threadIdx.x] = 0u; __syncthreads(); bar = xcd_barrier_post((unsigned*)(a_in.ws + WS_CTL), MISC + 8); }
#define IN(k) (lo <= (k) && (k) < hi)
#ifndef PROBE
#define PROBE 0
#endif
#define DUP(n) for (int rep_ = 0; rep_ < ((PROBE == (n)) ? 2 : 1); ++rep_)
#ifndef TPROBE
#define TPROBE 0
#endif
    unsigned long long tstart = 0ull;
#define TBEG(cls) do { if ((TPROBE >> (cls)) & 1) { if (threadIdx.x == 0 && blockIdx.x == 0) tstart = __builtin_amdgcn_s_memrealtime(); } } while (0)
#define TEND(cls) do { if ((TPROBE >> (cls)) & 1) { if (threadIdx.x == 0 && blockIdx.x == 0) MISC[16] += (unsigned)(__builtin_amdgcn_s_memrealtime() - tstart); } } while (0)
#define SEAM(k) do { TBEG(10); if (IN(k) && IN((k) + 1)) { if ((k) == 0) cg::this_grid().sync(); else xcd_barrier(bar); if (PROBE == 9) xcd_barrier(bar); } TEND(10); } while (0)
    TBEG(1); if (IN(0)) { const PArgs a = launder(a_in); DUP(1) { weights_phase(a, lds, wave, LANE()); __syncthreads(); } norm_phase<0>(a, 0, lds, wave, LANE()); __syncthreads(); } TEND(1);
    SEAM(0);
#pragma unroll
    for (int l = 0; l < 2; ++l) {
        const int p0 = 1 + 8 * l;
        TBEG(2); if (IN(p0 + 0)) DUP(2) { const PArgs a = launder(a_in); pg8::Gemm g{(const bf16_t*)(const unsigned char*)(a.ws + WS_XA), (const bf16_t*)(const unsigned char*)(a.ws + WS_WT_IN + l * SZ_WT_IN), MREAL, NPROJ, D}; pg8::StaticOrder S; S.init(MREAL, NPROJ, G, bid);
            EpiProj E{(GAS bf16_t*)(a.ws + WS_PROJ)}; pg8::gemm_phase<EpiProj, pg8::StaticOrder, true, true>(lds, g, S, E, wave); mini_gemm<1>(a, l, lds, wave, LANE()); } TEND(2);
        SEAM(p0 + 0);
        TBEG(3); if (IN(p0 + 1)) DUP(3) { const PArgs a = launder(a_in); mlstm_phase(a, lds, wave, LANE(), l == 0 ? 1 : -1); __syncthreads(); } TEND(3);
        SEAM(p0 + 1);
        TBEG(4); if (IN(p0 + 2)) DUP(4) { const PArgs a = launder(a_in); cat_phase(a, l, wave, LANE()); } TEND(4);
        SEAM(p0 + 2);
        TBEG(5); if (IN(p0 + 3)) { const PArgs a = launder(a_in); pg8::Gemm g{(const bf16_t*)(const unsigned char*)(a.ws + WS_XA), (const bf16_t*)(const unsigned char*)(a.ws + WS_WT_OUT + l * SZ_WT_OUT), MREAL, D, D}; pg8::StaticOrder S; S.init(MREAL, D, G, bid);
            EpiResid E{a.out}; pg8::gemm_phase<EpiResid, pg8::StaticOrder, true, true>(lds, g, S, E, wave); mini_gemm<2>(a, l, lds, wave, LANE()); } TEND(5);
        SEAM(p0 + 3);
        TBEG(6); if (IN(p0 + 4)) DUP(5) { const PArgs a = launder(a_in); norm_phase<2>(a, l, lds, wave, LANE()); } TEND(6);
        SEAM(p0 + 4);
        TBEG(7); if (IN(p0 + 5)) DUP(6) { const PArgs a = launder(a_in); pg8::Gemm g{(const bf16_t*)(const unsigned char*)(a.ws + WS_XA), (const bf16_t*)(const unsigned char*)(a.ws + WS_WT_GU + l * SZ_WT_GU), MREAL, NGU, D}; pg8::StaticOrder S; S.init(MREAL, NGU, G, bid);
            EpiSwiglu E{(GAS bf16_t*)(a.ws + WS_PROJ)}; pg8::gemm_phase<EpiSwiglu, pg8::StaticOrder, true, true>(lds, g, S, E, wave); mini_gemm<3>(a, l, lds, wave, LANE()); } TEND(7);
        SEAM(p0 + 5);
        TBEG(8); if (IN(p0 + 6)) { const PArgs a = launder(a_in); pg8::Gemm g{(const bf16_t*)(const unsigned char*)(a.ws + WS_PROJ), (const bf16_t*)(const unsigned char*)(a.ws + WS_WT_DN + l * SZ_WT_DN), MREAL, D, DFF}; pg8::StaticOrder S; S.init(MREAL, D, G, bid);
            EpiResid E{a.out}; pg8::gemm_phase<EpiResid, pg8::StaticOrder, true, true>(lds, g, S, E, wave); mini_gemm<4>(a, l, lds, wave, LANE()); } TEND(8);
        SEAM(p0 + 6);
        TBEG(9); if (IN(p0 + 7)) { const PArgs a = launder(a_in); if (l == 0) { norm_phase<1>(a, 1, lds, wave, LANE()); __syncthreads(); } else norm_phase<3>(a, 0, lds, wave, LANE()); } TEND(9);
        if (l == 0) SEAM(p0 + 7);
    }
    if (TPROBE) { if (threadIdx.x == 0 && blockIdx.x == 0) { const unsigned long long t0 = __builtin_amdgcn_s_memrealtime(); const unsigned dly = MISC[16]; while ((unsigned)(__builtin_amdgcn_s_memrealtime() - t0) < dly) __builtin_amdgcn_s_sleep(8); } }
#undef IN
#undef SEAM
}

extern "C" void kernel_launch(void* const* d_in, const int* in_sizes, int n_in, void* d_out, int out_size, void* d_ws, size_t ws_size, hipStream_t stream) {
    static int grid = 0;
    if (grid == 0) {
        if (n_in != 13 || in_sizes[0] != MREAL * D || out_size != MREAL * D || ws_size < WS_END) {
            fprintf(stderr, "kernel_launch: unexpected shapes (n_in %d, in0 %d, out %d, ws %zu; need ws >= %zu); nothing launched\n", n_in, n_in > 0 ? in_sizes[0] : -1, out_size, ws_size, (size_t)WS_END); grid = -1; return; }
        int dev = 0, cus = 0, per_cu = 0;
        hipGetDevice(&dev); hipDeviceGetAttribute(&cus, hipDeviceAttributeMultiprocessorCount, dev);
        if (hipFuncSetAttribute((const void*)hymba_fwd, hipFuncAttributeMaxDynamicSharedMemorySize, LDS_BYTES) != hipSuccess) { fprintf(stderr, "kernel_launch: hipFuncSetAttribute failed\n"); grid = -1; return; }
        if (hipOccupancyMaxActiveBlocksPerMultiprocessor(&per_cu, (const void*)hymba_fwd, NTHREADS, LDS_BYTES) != hipSuccess || per_cu < 1) { fprintf(stderr, "kernel_launch: occupancy query says %d\n", per_cu); per_cu = 1; }
        (void)hipGetLastError();
        grid = cus * per_cu;
        if (grid != 256) { fprintf(stderr, "kernel_launch: built for a 256-workgroup grid (MI355X, one per CU); got %d; nothing launched\n", grid); grid = -1; return; }
    }
    if (grid < 0) return;
    Args a{};
    a.x = (const float*)d_in[0]; a.meta = (const float*)d_in[1]; a.nmw = (const float*)d_in[2]; a.win = (const float*)d_in[3]; a.bg = (const float*)d_in[4]; a.cw = (const float*)d_in[5];
    a.mnw = (const float*)d_in[6]; a.wout = (const float*)d_in[7]; a.nfw = (const float*)d_in[8]; a.wg = (const float*)d_in[9]; a.wu = (const float*)d_in[10]; a.wd = (const float*)d_in[11]; a.nfin = (const float*)d_in[12];
    a.out = (float*)d_out; a.ws = (unsigned char*)d_ws;
#if MK_PER_PHASE
    for (int p = 0; p < N_PHASES; ++p) { a.ph_lo = p; a.ph_hi = p + 1; hipLaunchKernelGGL(hymba_fwd, dim3(grid), dim3(NTHREADS), LDS_BYTES, stream, a); }
#else
    a.ph_lo = 0; a.ph_hi = N_PHASES;
    if (hipMemsetAsync((char*)d_ws + WS_CTL, 0, CTL_BYTES, stream) != hipSuccess) { fprintf(stderr, "kernel_launch: memset failed\n"); return; }
    void* args[] = {&a};
    hipError_t e = hipLaunchCooperativeKernel((const void*)hymba_fwd, dim3(grid), dim3(NTHREADS), args, LDS_BYTES, stream);
    if (e != hipSuccess) fprintf(stderr, "kernel_launch: cooperative launch failed: %s (grid %d)\n", hipGetErrorString(e), grid);
#endif
}
```

```cpp
#include <hip/hip_runtime.h>
#include <hip/hip_cooperative_groups.h>
#include <cstdio>
#include <cstdint>
namespace cg = cooperative_groups;
namespace pg8 {
#define PG8_LAS __attribute__((address_space(3)))
typedef unsigned short bf16_t;
typedef short bf16x8 __attribute__((ext_vector_type(8)));
typedef float f32x4 __attribute__((ext_vector_type(4)));
typedef unsigned u32x4 __attribute__((ext_vector_type(4)));
constexpr int BM = 256, BK = 64, HALF = 128, HTB = HALF * BK * 2  , STAGE_BYTES = 8 * HTB, NXCD = 8, WGM = 8;

__host__ __device__ __forceinline__ int lds_byte(int r, int c) { const int st = (r >> 4) * 2 + (c >> 5), rr = r & 15, cc = c & 31, ob = rr * 64 + cc * 2; return st * 1024 + (ob ^ (((ob >> 9) & 1) << 5)); }
__host__ __device__ __forceinline__ void stage_rc(int b, int& R, int& C) { const int st = b / 1024, sb = b % 1024, swz = sb ^ (((sb >> 9) & 1) << 5); R = (st >> 1) * 16 + swz / 64; C = (st & 1) * 32 + (swz % 64) / 2; }
__host__ __device__ __forceinline__ int perm32(int rho) { const int n = rho >> 4, i = rho & 15; return 8 * (i >> 2) + 4 * n + (i & 3); }

struct Unit { int pm, pn; };
struct Gemm { const bf16_t* A; const bf16_t* Bt; int M, N, K; };

struct StaticOrder {
    int nM, nN, nwg, G, c;
    __host__ __device__ void init(int M, int N, int G_, int c_) { nM = M / BM; nN = N / BM; nwg = nM * nN; G = G_; c = c_; }
    __host__ __device__ bool next(int i, Unit& u) const {
        const long L = (long)i * G + c; if (L >= nwg) return false;
        int wgid = (int)L; { const int q = nwg / NXCD, r = nwg % NXCD, xcd = wgid % NXCD, off = wgid / NXCD; wgid = (xcd < r ? xcd * (q + 1) : r * (q + 1) + (xcd - r) * q) + off; }
        const int nig = WGM * nN, gid = wgid / nig, fm = gid * WGM, gsz = (nM - fm) < WGM ? (nM - fm) : WGM;
        u.pm = fm + ((wgid % nig) % gsz); u.pn = (wgid % nig) / gsz; return true;
    }
    __device__ __forceinline__ void a_ready(const Unit&) const {}
    __device__ __forceinline__ void done(const Unit&) const {}
};
__device__ __forceinline__ unsigned cvt_pk_bf16(float lo, float hi) { unsigned r; asm volatile("v_cvt_pk_bf16_f32 %0, %1, %2" : "=v"(r) : "v"(lo), "v"(hi)); return r; }
typedef float f32x2 __attribute__((ext_vector_type(2)));
template <class Epi, class Sched, bool ALIGN_EPI = false, bool SP2 = false>
__device__ __forceinline__ void gemm_phase(PG8_LAS unsigned char* lds, const Gemm g, const Sched& S, const Epi& E, const int wave_in) {
    int tid_; asm volatile("v_mbcnt_lo_u32_b32 %0, -1, 0\n\tv_mbcnt_hi_u32_b32 %0, -1, %0" : "=v"(tid_)); tid_ += wave_in * 64;
    const int tid = tid_, wid = __builtin_amdgcn_readfirstlane(tid >> 6), lane = tid & 63, wr = wid >> 2, wc = wid & 3, fr = lane & 15, fq = lane >> 4;
    const int K = g.K, nt = K / BK;
    unsigned voffA[2], voffB[2];
#pragma unroll
    for (int i = 0; i < 2; ++i) { int R, C; stage_rc(tid * 16 + i * 8192, R, C); const int Rb = Epi::PERM ? ((R & ~31) + perm32(R & 31)) : R;
        voffA[i] = (unsigned)(R * K + C) * 2u; voffB[i] = (unsigned)(Rb * K + C) * 2u; }
    const size_t kstep = (size_t)(BK * 2);
    const size_t hstep = (size_t)HALF * K * 2;
    const size_t tstep = 2 * hstep;
    const unsigned ldsw = (unsigned)wid * 1024u;
    const int aoff = lds_byte(wr * 64 + fr, fq * 8), boff = lds_byte(wc * 32 + fr, fq * 8);
#define PG8_SA(b, h) (((b) * 2 + (h)) * HTB)
#define PG8_SB(b, h) ((4 + (b) * 2 + (h)) * HTB)
#define PG8_STAGE(bufoff, gbase, voff) do { _Pragma("unroll") for (int _i = 0; _i < 2; ++_i) \
        __builtin_amdgcn_global_load_lds((const unsigned*)((const char*)(gbase) + (voff)[_i]), (PG8_LAS unsigned*)(lds + (bufoff) + ldsw + _i * 8192), 16, 0, 0); } while (0)
#define PG8_LDA(dst, b, h) do { _Pragma("unroll") for (int m = 0; m < 4; ++m) _Pragma("unroll") for (int k = 0; k < 2; ++k) dst[m][k] = *(const PG8_LAS bf16x8*)(lds + PG8_SA(b, h) + aoff + m * 2048 + k * 1024); } while (0)
#define PG8_LDB(dst, b, h) do { _Pragma("unroll") for (int n = 0; n < 2; ++n) _Pragma("unroll") for (int k = 0; k < 2; ++k) dst[n][k] = *(const PG8_LAS bf16x8*)(lds + PG8_SB(b, h) + boff + n * 2048 + k * 1024); } while (0)
#define PG8_MMA(ai, bj, At, Bt) do { __builtin_amdgcn_s_setprio(1); _Pragma("unroll") for (int m = 0; m < 4; ++m) _Pragma("unroll") for (int n = 0; n < 2; ++n) _Pragma("unroll") for (int k = 0; k < 2; ++k) \
        acc[ai][bj][m][n] = __builtin_amdgcn_mfma_f32_16x16x32_bf16(Bt[n][k], At[m][k], acc[ai][bj][m][n], 0, 0, 0); __builtin_amdgcn_s_setprio(0); } while (0)
#define PG8_WAIT_V(n) asm volatile("s_waitcnt vmcnt(" #n ")" ::: "memory")
#define PG8_WAIT_L(n) asm volatile("s_waitcnt lgkmcnt(" #n ")" ::: "memory")
#define PG8_BAR __builtin_amdgcn_s_barrier()
#define PG8_SCHED __builtin_amdgcn_sched_barrier(0)
    Unit cur, nxt; int ui = 0;
    if (!S.next(0, cur)) return;
    f32x4 acc[2][2][4][2];
#pragma unroll
    for (int a = 0; a < 2; ++a)
#pragma unroll
        for (int b = 0; b < 2; ++b)
#pragma unroll
            for (int m = 0; m < 4; ++m)
#pragma unroll
                for (int n = 0; n < 2; ++n) acc[a][b][m][n] = (f32x4){0.f, 0.f, 0.f, 0.f};
    bf16x8 At[4][2], B0[2][2], B1[2][2];
    const char* cA = (const char*)g.A + (size_t)cur.pm * tstep; const char* cB = (const char*)g.Bt + (size_t)cur.pn * tstep;
    S.a_ready(cur);
    if constexpr (SP2) {
        PG8_STAGE(PG8_SB(0, 0), cB, voffB); PG8_STAGE(PG8_SB(0, 1), cB + hstep, voffB); PG8_STAGE(PG8_SA(0, 0), cA, voffA); PG8_STAGE(PG8_SA(0, 1), cA + hstep, voffA);
        if (wr == 1) PG8_BAR;
        PG8_WAIT_V(2); PG8_BAR;
        PG8_STAGE(PG8_SB(1, 0), cB + kstep, voffB); PG8_STAGE(PG8_SA(1, 0), cA + kstep, voffA); PG8_STAGE(PG8_SB(1, 1), cB + hstep + kstep, voffB);
        PG8_WAIT_V(6); PG8_BAR;
    } else {
        PG8_STAGE(PG8_SB(0, 0), cB, voffB); PG8_STAGE(PG8_SA(0, 0), cA, voffA); PG8_STAGE(PG8_SB(0, 1), cB + hstep, voffB); PG8_STAGE(PG8_SA(0, 1), cA + hstep, voffA);
        if (wr == 1) PG8_BAR;
        PG8_WAIT_V(4); PG8_BAR;
        PG8_STAGE(PG8_SB(1, 0), cB + kstep, voffB); PG8_STAGE(PG8_SA(1, 0), cA + kstep, voffA); PG8_STAGE(PG8_SB(1, 1), cB + hstep + kstep, voffB);
        PG8_WAIT_V(6); PG8_BAR;
    }
    for (;;) {
        const bool has_next = S.next(ui + 1, nxt);
        const char* nA = has_next ? (const char*)g.A + (size_t)nxt.pm * tstep : cA; const char* nB = has_next ? (const char*)g.Bt + (size_t)nxt.pn * tstep : cB;
        for (int t = 0; t < nt; t += 2) {
            const bool last = (t == nt - 2);
            const char* a1 = cA + (size_t)(t + 1) * kstep;
            const char* a2 = last ? nA : cA + (size_t)(t + 2) * kstep; const char* b2 = last ? nB : cB + (size_t)(t + 2) * kstep;
            const char* a3 = a2 + kstep; const char* b3 = b2 + kstep;
            if (last && has_next) S.a_ready(nxt);
            if constexpr (SP2) {
            PG8_LDB(B0, 0, 0); PG8_LDB(B1, 0, 1); PG8_SCHED; PG8_LDA(At, 0, 0); PG8_STAGE(PG8_SA(1, 1), a1 + hstep, voffA);
            PG8_WAIT_V(8); PG8_WAIT_L(0); PG8_BAR; PG8_MMA(0, 0, At, B0); PG8_MMA(0, 1, At, B1); PG8_BAR; PG8_SCHED;
            PG8_LDA(At, 0, 1); PG8_STAGE(PG8_SB(0, 0), b2, voffB); PG8_STAGE(PG8_SB(0, 1), b2 + hstep, voffB); PG8_STAGE(PG8_SA(0, 0), a2, voffA);
            PG8_WAIT_V(8); PG8_WAIT_L(0); PG8_BAR; PG8_MMA(1, 0, At, B0); PG8_MMA(1, 1, At, B1); PG8_BAR; PG8_SCHED;
            PG8_LDB(B0, 1, 0); PG8_LDB(B1, 1, 1); PG8_SCHED; PG8_LDA(At, 1, 0); PG8_STAGE(PG8_SA(0, 1), a2 + hstep, voffA);
            PG8_WAIT_V(8); PG8_WAIT_L(0); PG8_BAR; PG8_MMA(0, 0, At, B0); PG8_MMA(0, 1, At, B1); PG8_BAR; PG8_SCHED;
            PG8_LDA(At, 1, 1); PG8_STAGE(PG8_SB(1, 0), b3, voffB); PG8_STAGE(PG8_SB(1, 1), b3 + hstep, voffB); PG8_STAGE(PG8_SA(1, 0), a3, voffA);
            PG8_WAIT_V(8); PG8_WAIT_L(0); PG8_BAR; PG8_MMA(1, 0, At, B0); PG8_MMA(1, 1, At, B1); PG8_BAR; PG8_SCHED;
            } else {
            PG8_LDB(B0, 0, 0); PG8_SCHED; PG8_LDA(At, 0, 0); PG8_STAGE(PG8_SA(1, 1), a1 + hstep, voffA);
            PG8_WAIT_L(8); PG8_BAR; PG8_WAIT_L(0); PG8_MMA(0, 0, At, B0); PG8_BAR; PG8_SCHED;
            PG8_LDB(B1, 0, 1); PG8_STAGE(PG8_SB(0, 0), b2, voffB);
            PG8_BAR; PG8_WAIT_L(0); PG8_MMA(0, 1, At, B1); PG8_BAR;
            PG8_LDA(At, 0, 1); PG8_STAGE(PG8_SA(0, 0), a2, voffA);
            PG8_BAR; PG8_WAIT_L(0); PG8_MMA(1, 0, At, B0); PG8_BAR; PG8_SCHED;
            PG8_STAGE(PG8_SB(0, 1), b2 + hstep, voffB);
            PG8_WAIT_V(6); PG8_BAR; PG8_MMA(1, 1, At, B1); PG8_BAR;
            PG8_LDB(B0, 1, 0); PG8_SCHED; PG8_LDA(At, 1, 0); PG8_STAGE(PG8_SA(0, 1), a2 + hstep, voffA);
            PG8_WAIT_L(8); PG8_BAR; PG8_WAIT_L(0); PG8_MMA(0, 0, At, B0); PG8_BAR; PG8_SCHED;
            PG8_LDB(B1, 1, 1); PG8_STAGE(PG8_SB(1, 0), b3, voffB);
            PG8_BAR; PG8_WAIT_L(0); PG8_MMA(0, 1, At, B1); PG8_BAR;
            PG8_LDA(At, 1, 1); PG8_STAGE(PG8_SA(1, 0), a3, voffA);
            PG8_BAR; PG8_WAIT_L(0); PG8_MMA(1, 0, At, B0); PG8_BAR; PG8_SCHED;
            PG8_STAGE(PG8_SB(1, 1), b3 + hstep, voffB);
            PG8_WAIT_V(6); PG8_BAR; PG8_MMA(1, 1, At, B1); PG8_BAR;
            }
        }
        if constexpr (ALIGN_EPI) { if (wr == 0) PG8_BAR; }
        if constexpr (!Epi::AFTER_DRAIN) { E(acc, cur, wr, wc, fr, fq); S.done(cur); }
        if (!has_next) break;
#pragma unroll
        for (int a = 0; a < 2; ++a)
#pragma unroll
            for (int b = 0; b < 2; ++b)
#pragma unroll
                for (int m = 0; m < 4; ++m)
#pragma unroll
                    for (int n = 0; n < 2; ++n) acc[a][b][m][n] = (f32x4){0.f, 0.f, 0.f, 0.f};
        cur = nxt; cA = nA; cB = nB; ++ui;
        if constexpr (ALIGN_EPI) { if (wr == 1) PG8_BAR; }
    }
    PG8_WAIT_V(0);
    if constexpr (!ALIGN_EPI) { if (wr == 0) PG8_BAR; }
    PG8_BAR;
    if constexpr (Epi::AFTER_DRAIN) { E.fused(acc, cur, wr, wc, fr, fq, lds, wid, lane); S.done(cur); }
#undef PG8_SA
#undef PG8_SB
#undef PG8_STAGE
#undef PG8_LDA
#undef PG8_LDB
#undef PG8_MMA
#undef PG8_WAIT_V
#undef PG8_WAIT_L
#undef PG8_BAR
#undef PG8_SCHED
}
}

#define LAS __attribute__((address_space(3)))
typedef unsigned short bf16_t;
typedef short bf16x8 __attribute__((ext_vector_type(8)));
typedef short s16x4 __attribute__((ext_vector_type(4)));
typedef float f32x4 __attribute__((ext_vector_type(4)));
typedef unsigned u32x4 __attribute__((ext_vector_type(4)));
typedef unsigned u32x2 __attribute__((ext_vector_type(2)));

constexpr int D = 2048, NB = 8, SEQ = 2048, NMETA = 16, NHEAD = 4, DV = 256, DQK = 128;
constexpr int MREAL = NB * SEQ;
constexpr int MMETA = NMETA;
constexpr int MTOT = MREAL + MMETA;
constexpr int MPAD = MTOT;
constexpr int DIN = 6152, NPROJ = 6144, DFF = 5632, NGU = 2 * DFF;
constexpr int LDP = 5120;
constexpr int C_Q = 0, C_K = 512, C_V = 1024, C_OG = 2048, C_A = 3072, C_GB = 4096;
constexpr float EPS = 1e-6f, GATE_CAP = 15.0f;
constexpr int NCHUNK = 33;

constexpr size_t MiB = 1u << 20;
constexpr size_t SZ_WT_IN = (size_t)NPROJ * D * 2, SZ_WT_OUT = (size_t)D * D * 2, SZ_WT_GU = (size_t)NGU * D * 2, SZ_WT_DN = (size_t)D * DFF * 2;
constexpr size_t WS_WT_IN = 0, WS_WT_OUT = 48 * MiB, WS_WT_GU = 64 * MiB, WS_WT_DN = 152 * MiB;
constexpr size_t WS_XA = 196 * MiB;
constexpr size_t WS_PROJ = 261 * MiB;
constexpr size_t WS_NUM = 456 * MiB;
constexpr size_t WS_HMETA = 489 * MiB;
constexpr size_t WS_LI = 491 * MiB, WS_LF = WS_LI + MiB / 2, WS_DEN = 492 * MiB, WS_MT = WS_DEN + MiB / 2;
constexpr size_t WS_CTL = 493 * MiB, CTL_BYTES = 65536;
constexpr size_t WS_END = 494 * MiB;
static_assert(2 * SZ_WT_IN <= WS_WT_OUT - WS_WT_IN && 2 * SZ_WT_OUT <= WS_WT_GU - WS_WT_OUT && 2 * SZ_WT_GU <= WS_WT_DN - WS_WT_GU && 2 * SZ_WT_DN <= WS_XA - WS_WT_DN, "ws map");
static_assert((size_t)MPAD * D * 2 <= WS_PROJ - WS_XA && (size_t)MPAD * NPROJ * 2 <= WS_NUM - WS_PROJ && (size_t)MPAD * 1024 * 2 <= WS_HMETA - WS_NUM, "ws map");

constexpr int LDS_BYTES = 147456;
constexpr int NWAVES = 8, NTHREADS = 512;

__device__ __forceinline__ unsigned cvt_pk(float lo, float hi) { unsigned r; asm volatile("v_cvt_pk_bf16_f32 %0, %1, %2" : "=v"(r) : "v"(lo), "v"(hi)); return r; }
__device__ __forceinline__ float bf2f(unsigned short b) { return __uint_as_float(((unsigned)b) << 16); }
__device__ __forceinline__ float bflo(unsigned w) { return __uint_as_float(w << 16); }
__device__ __forceinline__ float bfhi(unsigned w) { return __uint_as_float(w & 0xffff0000u); }
#define DPPF(old_, src_, ctrl_, rmask_) __builtin_bit_cast(float, __builtin_amdgcn_update_dpp(__builtin_bit_cast(int, (float)(old_)), __builtin_bit_cast(int, (float)(src_)), ctrl_, rmask_, 0xF, false))
__device__ __forceinline__ float wave_scan_sum(float v) {
    v += DPPF(0.f, v, 0x111, 0xF); v += DPPF(0.f, v, 0x112, 0xF); v += DPPF(0.f, v, 0x114, 0xF); v += DPPF(0.f, v, 0x118, 0xF);
    v += DPPF(0.f, v, 0x142, 0xA); v += DPPF(0.f, v, 0x143, 0xC);
    return v;
}
__device__ __forceinline__ float wave_max_last(float v) {
    const float ninf = -3.0e38f;
    v = fmaxf(v, DPPF(ninf, v, 0x111, 0xF)); v = fmaxf(v, DPPF(ninf, v, 0x112, 0xF)); v = fmaxf(v, DPPF(ninf, v, 0x114, 0xF)); v = fmaxf(v, DPPF(ninf, v, 0x118, 0xF));
    v = fmaxf(v, DPPF(ninf, v, 0x142, 0xA)); v = fmaxf(v, DPPF(ninf, v, 0x143, 0xC));
    return __builtin_bit_cast(float, __builtin_amdgcn_readlane(__builtin_bit_cast(int, v), 63));
}
__device__ __forceinline__ float wave_sum(float v) { return __builtin_bit_cast(float, __builtin_amdgcn_readlane(__builtin_bit_cast(int, wave_scan_sum(v)), 63)); }
__device__ __forceinline__ float wave_max(float v) { return wave_max_last(v); }

struct Args {
    const float *x, *meta, *nmw, *win, *bg, *cw, *mnw, *wout, *nfw, *wg, *wu, *wd, *nfin;
    float* out; unsigned char* ws; int ph_lo, ph_hi;
};
static_assert(sizeof(Args) == 15 * 8 + 8, "Args has no padding");

#define GAS __attribute__((address_space(1)))
struct PArgs {
    const GAS float *x, *meta, *nmw, *win, *bg, *cw, *mnw, *wout, *nfw, *wg, *wu, *wd, *nfin;
    GAS float* out; GAS unsigned char* ws;
};
__device__ __forceinline__ GAS bf16_t* hrow(const PArgs& a, int m) { return m < MREAL ? (GAS bf16_t*)a.out + (size_t)m * (2 * D) + D : (GAS bf16_t*)(a.ws + WS_HMETA) + (size_t)(m - MREAL) * D; }

struct EpiProj {
    static constexpr bool PERM = true, AFTER_DRAIN = false;
    GAS bf16_t* O;
    __device__ __forceinline__ void operator()(const f32x4 (&acc)[2][2][4][2], const pg8::Unit& u, int wr, int wc, int fr, int fq) const {
        const int row0 = u.pm * 256 + wr * 64 + fr;
        if (u.pn >= 12 && u.pn < 20) {
            const int col0 = C_A + (u.pn - 12) * 128 + wc * 32 + 8 * fq;
#pragma unroll
            for (int ai = 0; ai < 2; ++ai)
#pragma unroll
                for (int m = 0; m < 4; ++m) { const f32x4 v0 = acc[ai][0][m][0] * acc[ai][1][m][0], v1 = acc[ai][0][m][1] * acc[ai][1][m][1];
                    u32x4 w; w.x = cvt_pk(v0[0], v0[1]); w.y = cvt_pk(v0[2], v0[3]); w.z = cvt_pk(v1[0], v1[1]); w.w = cvt_pk(v1[2], v1[3]);
                    *(GAS u32x4*)(O + (size_t)(row0 + ai * 128 + m * 16) * LDP + col0) = w; }
        } else {
            const int colt = u.pn < 12 ? u.pn * 256 : C_GB + (u.pn - 20) * 256;
            const float sc = (colt < C_K) ? 0.08838834764831845f : 1.0f;
            const int col0 = colt + wc * 32 + 8 * fq;
#pragma unroll
            for (int ai = 0; ai < 2; ++ai)
#pragma unroll
                for (int m = 0; m < 4; ++m) { GAS bf16_t* rowp = O + (size_t)(row0 + ai * 128 + m * 16) * LDP + col0;
#pragma unroll
                    for (int bj = 0; bj < 2; ++bj) { const f32x4 v0 = acc[ai][bj][m][0] * sc, v1 = acc[ai][bj][m][1] * sc;
                        u32x4 w; w.x = cvt_pk(v0[0], v0[1]); w.y = cvt_pk(v0[2], v0[3]); w.z = cvt_pk(v1[0], v1[1]); w.w = cvt_pk(v1[2], v1[3]);
                        *(GAS u32x4*)(rowp + bj * 128) = w; } }
        }
    }
};
struct EpiResid {
    static constexpr bool PERM = true, AFTER_DRAIN = false;
    GAS float* out;
    __device__ __forceinline__ void operator()(const f32x4 (&acc)[2][2][4][2], const pg8::Unit& u, int wr, int wc, int fr, int fq) const {
        GAS bf16_t* hb = (GAS bf16_t*)out + (size_t)(u.pm * 256) * (2 * D) + D;
        const int r0 = wr * 64 + fr, col0 = u.pn * 256 + wc * 32 + 8 * fq;
#pragma unroll
        for (int ai = 0; ai < 2; ++ai) { u32x4 old[4][2];
#pragma unroll
            for (int m = 0; m < 4; ++m) { const GAS bf16_t* rowp = hb + (size_t)(r0 + ai * 128 + m * 16) * (2 * D) + col0;
#pragma unroll
                for (int bj = 0; bj < 2; ++bj) old[m][bj] = *(const GAS u32x4*)(rowp + bj * 128); }
#pragma unroll
            for (int m = 0; m < 4; ++m) { GAS bf16_t* rowp = hb + (size_t)(r0 + ai * 128 + m * 16) * (2 * D) + col0;
#pragma unroll
                for (int bj = 0; bj < 2; ++bj) { const u32x4 o = old[m][bj]; const f32x4 a0 = acc[ai][bj][m][0], a1 = acc[ai][bj][m][1];
                    u32x4 w; w.x = cvt_pk(bflo(o.x) + a0[0], bfhi(o.x) + a0[1]); w.y = cvt_pk(bflo(o.y) + a0[2], bfhi(o.y) + a0[3]); w.z = cvt_pk(bflo(o.z) + a1[0], bfhi(o.z) + a1[1]); w.w = cvt_pk(bflo(o.w) + a1[2], bfhi(o.w) + a1[3]);
                    *(GAS u32x4*)(rowp + bj * 128) = w; } }
        }
    }
};
struct EpiSwiglu {
    static constexpr bool PERM = true, AFTER_DRAIN = false;
    GAS bf16_t* O;
    __device__ __forceinline__ void operator()(const f32x4 (&acc)[2][2][4][2], const pg8::Unit& u, int wr, int wc, int fr, int fq) const {
        const int row0 = u.pm * 256 + wr * 64 + fr, col0 = u.pn * 128 + wc * 32 + 8 * fq;
#pragma unroll
        for (int ai = 0; ai < 2; ++ai)
#pragma unroll
            for (int m = 0; m < 4; ++m) { GAS bf16_t* rowp = O + (size_t)(row0 + ai * 128 + m * 16) * DFF + col0;
                float r[8];
#pragma unroll
                for (int n = 0; n < 2; ++n)
#pragma unroll
                    for (int j = 0; j < 4; ++j) { const float g = acc[ai][0][m][n][j], up = acc[ai][1][m][n][j]; r[n * 4 + j] = g * up * __builtin_amdgcn_rcpf(1.0f + __expf(-g)); }
                u32x4 w; w.x = cvt_pk(r[0], r[1]); w.y = cvt_pk(r[2], r[3]); w.z = cvt_pk(r[4], r[5]); w.w = cvt_pk(r[6], r[7]);
                *(GAS u32x4*)rowp = w; }
    }
};

#define RLX_AGENT __ATOMIC_RELAXED, __HIP_MEMORY_SCOPE_AGENT
#define XB_TMO      128
#define XB_XCNT(j)  (256  + 64 * (j))
#define XB_XSUB(j)  (1280 + 64 * (j))
#define XB_XGEN(j)  (2304 + 64 * (j))
#define XB_TOP      3328
#define XB_TOPGEN   3392
#define XCD_BAR_WORDS 3456
#define XB_SPIN_CAP (1u << 18)

__device__ __forceinline__ unsigned xb_ld(unsigned* p)              { return __hip_atomic_load(p, __ATOMIC_RELAXED, __HIP_MEMORY_SCOPE_AGENT); }
__device__ __forceinline__ unsigned xb_add(unsigned* p, unsigned v) { return __hip_atomic_fetch_add(p, v, __ATOMIC_RELAXED, __HIP_MEMORY_SCOPE_AGENT); }
__device__ __forceinline__ unsigned xb_xcc_id() { return (unsigned)__builtin_amdgcn_s_getreg((3 << 11) | 20) & 0xFu; }
#define XB_SPIN(cond, bar) do { unsigned _sp = 0; while (cond) { __builtin_amdgcn_s_sleep(1); \
    if ((++_sp & 255u) == 0u) { if (xb_ld(&(bar)[XB_TMO])) break; if (_sp > XB_SPIN_CAP) { atomicAdd(&(bar)[XB_TMO], 1u); break; } } } } while (0)

struct XcdBarrier {
    unsigned* bar; unsigned x;
    volatile LAS unsigned* st;
};

__device__ __forceinline__ XcdBarrier xcd_barrier_post(unsigned* bar, volatile LAS unsigned* st) {
    XcdBarrier b; b.bar = bar; b.x = xb_xcc_id(); b.st = st;
    if (threadIdx.x == 0) (void)xb_add(&bar[XB_XCNT(b.x)], 1u);
    return b;
}
__device__ __forceinline__ void xcd_barrier_complete(unsigned* bar, unsigned x, unsigned& nloc, unsigned& nx) {
    const unsigned G = gridDim.x * gridDim.y * gridDim.z;
    unsigned sum, cnt, mine, sp = 0u;
    for (;;) {
        sum = 0u; cnt = 0u; mine = 0u;
#pragma unroll
        for (unsigned j = 0; j < 16; ++j) { const unsigned c = xb_ld(&bar[XB_XCNT(j)]); sum += c; cnt += (c > 0u) ? 1u : 0u; mine = (j == x) ? c : mine; }
        if (sum == G) break;
        __builtin_amdgcn_s_sleep(1);
        if ((++sp & 255u) == 0u) { if (xb_ld(&bar[XB_TMO])) break; if (sp > XB_SPIN_CAP) { atomicAdd(&bar[XB_TMO], 1u); break; } }
    }
    nloc = mine > 0u ? mine : 1u; nx = cnt > 0u ? cnt : 1u;
}

__device__ __forceinline__ void xcd_barrier(const XcdBarrier& b) {
    asm volatile("s_waitcnt vmcnt(0)" ::: "memory");
    __syncthreads();
    if (threadIdx.x == 0) {
        unsigned* bar = b.bar;
        __builtin_amdgcn_s_waitcnt(0);
        unsigned nloc = b.st[0], nx = b.st[1];
        if (nloc == 0u) { xcd_barrier_complete(bar, b.x, nloc, nx); b.st[0] = nloc; b.st[1] = nx; }
        const unsigned old = xb_add(&bar[XB_XSUB(b.x)], 1u);
        const unsigned gen = old / nloc;
        if (old + 1u == (gen + 1u) * nloc) {
            __builtin_amdgcn_fence(__ATOMIC_RELEASE, "agent");
            asm volatile("s_waitcnt vmcnt(0)" ::: "memory");
            const unsigned og = xb_add(&bar[XB_TOP], 1u);
            const unsigned tg = og / nx;
            if (og + 1u == (tg + 1u) * nx) xb_add(&bar[XB_TOPGEN], 1u);
            else XB_SPIN(xb_ld(&bar[XB_TOPGEN]) == tg, bar);
            __builtin_amdgcn_fence(__ATOMIC_ACQUIRE, "agent");
            xb_add(&bar[XB_XGEN(b.x)], 1u);
            asm volatile("s_waitcnt vmcnt(0)" ::: "memory");
        } else {
            XB_SPIN(xb_ld(&bar[XB_XGEN(b.x)]) == gen, bar);
            __builtin_amdgcn_fence(__ATOMIC_ACQUIRE, "agent");
            asm volatile("s_waitcnt vmcnt(0)" ::: "memory");
        }
    }
    __syncthreads();
}


struct WItem { const GAS float* src; GAS bf16_t* dst; int ldw, K; };
__device__ __forceinline__ WItem witem(const PArgs& a, int it) {
    constexpr int I_IN = 32 * 192, I_OUT = 32 * 64, I_G = 32 * 176, I_DN = 88 * 64, I_LAYER = I_IN + I_OUT + 2 * I_G + I_DN;
    const int l = it / I_LAYER; int r = it - l * I_LAYER; WItem w;
    if (r < I_IN) { const int kb = r / 192, nb = r % 192, d0 = nb * 32; w.ldw = DIN; w.K = D; w.src = a.win + (size_t)l * D * DIN + (size_t)(kb * 64) * DIN + (d0 < 3072 ? d0 : (d0 < 5120 ? ((((d0 - 3072) & 255) < 128) ? 3080 + ((d0 - 3072) >> 8) * 128 + ((d0 - 3072) & 127) : 5128 + ((d0 - 3072) >> 8) * 128 + ((d0 - 3072) & 127)) : 4104 + (d0 - 5120))); w.dst = (GAS bf16_t*)(a.ws + WS_WT_IN + l * SZ_WT_IN) + (size_t)d0 * D + kb * 64; return w; } r -= I_IN;
    if (r < I_OUT) { const int kb = r / 64, nb = r % 64; w.ldw = D; w.K = D; w.src = a.wout + (size_t)l * D * D + (size_t)(kb * 64) * D + nb * 32; w.dst = (GAS bf16_t*)(a.ws + WS_WT_OUT + l * SZ_WT_OUT) + (size_t)(nb * 32) * D + kb * 64; return w; } r -= I_OUT;
    if (r < 2 * I_G) { const int up = r >= I_G; r -= up * I_G; const int kb = r / 176, nb = r % 176, n0 = nb * 32; w.ldw = DFF; w.K = D; w.src = (up ? a.wu : a.wg) + (size_t)l * D * DFF + (size_t)(kb * 64) * DFF + n0;
        w.dst = (GAS bf16_t*)(a.ws + WS_WT_GU + l * SZ_WT_GU) + (size_t)((n0 >> 7) * 256 + up * 128 + (n0 & 127)) * D + kb * 64; return w; } r -= 2 * I_G;
    { const int kb = r / 64, nb = r % 64; w.ldw = D; w.K = DFF; w.src = a.wd + (size_t)l * DFF * D + (size_t)(kb * 64) * D + nb * 32; w.dst = (GAS bf16_t*)(a.ws + WS_WT_DN + l * SZ_WT_DN) + (size_t)(nb * 32) * DFF + kb * 64; return w; }
}
constexpr int W_ITEMS_LAYER = 32 * 192 + 32 * 64 + 2 * 32 * 176 + 88 * 64;
__device__ __forceinline__ void weights_one(const PArgs& a, int it, LAS float* scr, int lane) {
    const WItem w = witem(a, it); const int kr = lane >> 3, n4 = (lane & 7) * 4;
    f32x4 v[8];
#pragma unroll
    for (int i = 0; i < 8; ++i) v[i] = __builtin_nontemporal_load((const GAS f32x4*)(w.src + (size_t)(8 * i + kr) * w.ldw + n4));
#pragma unroll
    for (int i = 0; i < 8; ++i) *(LAS f32x4*)(scr + (8 * i + kr) * 36 + n4) = v[i];
    asm volatile("s_waitcnt lgkmcnt(0)" ::: "memory");
    const int c = lane & 7;
#pragma unroll
    for (int j = 0; j < 4; ++j) { const int n = (lane >> 3) + 8 * j; const LAS float* s = scr + (8 * c) * 36 + n;
        u32x4 o; o.x = cvt_pk(s[0 * 36], s[1 * 36]); o.y = cvt_pk(s[2 * 36], s[3 * 36]); o.z = cvt_pk(s[4 * 36], s[5 * 36]); o.w = cvt_pk(s[6 * 36], s[7 * 36]);
        *(GAS u32x4*)(w.dst + (size_t)n * w.K + 8 * c) = o; }
    asm volatile("s_waitcnt lgkmcnt(0)" ::: "memory");
}
__device__ __forceinline__ void weights_stream(const PArgs& a, LAS float* scr, int lane, int first, int stride, int it0, int nbar) {
    const int kr = lane >> 3, n4 = (lane & 7) * 4;
    f32x4 v[8];
    int it = first;
    if (it < W_ITEMS_LAYER) { const WItem w = witem(a, it0 + it);
#pragma unroll
        for (int i = 0; i < 8; ++i) v[i] = __builtin_nontemporal_load((const GAS f32x4*)(w.src + (size_t)(8 * i + kr) * w.ldw + n4)); }
#pragma unroll 1
    for (; it < W_ITEMS_LAYER; it += stride) {
        const WItem w = witem(a, it0 + it);
#pragma unroll
        for (int i = 0; i < 8; ++i) *(LAS f32x4*)(scr + (8 * i + kr) * 36 + n4) = v[i];
        if (it + stride < W_ITEMS_LAYER) { const WItem wn = witem(a, it0 + it + stride);
#pragma unroll
            for (int i = 0; i < 8; ++i) v[i] = __builtin_nontemporal_load((const GAS f32x4*)(wn.src + (size_t)(8 * i + kr) * wn.ldw + n4)); }
        asm volatile("s_waitcnt lgkmcnt(0)" ::: "memory");
        const int c = lane & 7;
#pragma unroll
        for (int j = 0; j < 4; ++j) { const int n = (lane >> 3) + 8 * j; const LAS float* s = scr + (8 * c) * 36 + n;
            u32x4 o; o.x = cvt_pk(s[0 * 36], s[1 * 36]); o.y = cvt_pk(s[2 * 36], s[3 * 36]); o.z = cvt_pk(s[4 * 36], s[5 * 36]); o.w = cvt_pk(s[6 * 36], s[7 * 36]);
            *(GAS u32x4*)(w.dst + (size_t)n * w.K + 8 * c) = o; }
        asm volatile("s_waitcnt lgkmcnt(0)" ::: "memory");
        if (nbar > 0) { --nbar; __builtin_amdgcn_s_barrier(); asm volatile("" ::: "memory"); }
    }
    for (; nbar > 0; --nbar) { __builtin_amdgcn_s_barrier(); asm volatile("" ::: "memory"); }
}
__device__ __forceinline__ void weights_phase(const PArgs& a, LAS unsigned char* lds, int wave, int lane) {
    weights_stream(a, (LAS float*)(lds + wave * 16384), lane, blockIdx.x * NWAVES + wave, gridDim.x * NWAVES, 0, 0);
}

template <int MODE>
__device__ __forceinline__ void norm_phase(const PArgs& a, int layer, LAS unsigned char* lds, int wave, int lane) {
    const GAS float* nw = MODE <= 1 ? a.nmw + layer * D : (MODE == 2 ? a.nfw + layer * D : a.nfin);
    LAS float* WG = (LAS float*)lds;
    if (MODE <= 1) {
        const GAS float* wsrc = a.win + (size_t)layer * D * DIN + 3072;
        for (int k = wave * 64 + lane; k < D; k += NTHREADS) { const f32x4 g0 = *(const GAS f32x4*)(wsrc + (size_t)k * DIN), g1 = *(const GAS f32x4*)(wsrc + (size_t)k * DIN + 4);
            WG[0 * D + k] = g0[0]; WG[1 * D + k] = g0[1]; WG[2 * D + k] = g0[2]; WG[3 * D + k] = g0[3]; WG[4 * D + k] = g1[0]; WG[5 * D + k] = g1[1]; WG[6 * D + k] = g1[2]; WG[7 * D + k] = g1[3]; }
        __syncthreads();
    }
    GAS bf16_t* XA = (GAS bf16_t*)(a.ws + WS_XA); GAS float* LI = (GAS float*)(a.ws + WS_LI); GAS float* LF = (GAS float*)(a.ws + WS_LF);
    const int gw = blockIdx.x * NWAVES + wave, NGW = gridDim.x * NWAVES;
    f32x4 w[8];
#pragma unroll
    for (int j = 0; j < 8; ++j) w[j] = *((const GAS f32x4*)nw + lane + 64 * j);
    constexpr int MEND = (MODE == 3 ? MREAL : MTOT);
#define NORM_SRC(mm) ((mm) < MREAL ? a.x + (size_t)(mm) * D : a.meta + (size_t)(((mm) - MREAL) & 15) * D)
    f32x4 vn[8]; u32x2 hn[8];
    if (gw < MEND) { if (MODE == 0) { const GAS float* src = NORM_SRC(gw);
#pragma unroll
            for (int j = 0; j < 8; ++j) vn[j] = __builtin_nontemporal_load((const GAS f32x4*)src + lane + 64 * j); }
        else { const GAS bf16_t* src = hrow(a, gw);
#pragma unroll
            for (int j = 0; j < 8; ++j) hn[j] = *((const GAS u32x2*)src + lane + 64 * j); } }
    for (int m = gw; m < MEND; m += NGW) {
        f32x4 v[8]; float ss = 0.f;
#pragma unroll
        for (int j = 0; j < 8; ++j) { if (MODE == 0) v[j] = vn[j]; else v[j] = (f32x4){bflo(hn[j].x), bfhi(hn[j].x), bflo(hn[j].y), bfhi(hn[j].y)};
            ss += (v[j][0] * v[j][0] + v[j][1] * v[j][1]) + (v[j][2] * v[j][2] + v[j][3] * v[j][3]); }
        if (m + NGW < MEND) { if (MODE == 0) { const GAS float* src = NORM_SRC(m + NGW);
#pragma unroll
                for (int j = 0; j < 8; ++j) vn[j] = __builtin_nontemporal_load((const GAS f32x4*)src + lane + 64 * j); }
            else { const GAS bf16_t* src = hrow(a, m + NGW);
#pragma unroll
                for (int j = 0; j < 8; ++j) hn[j] = *((const GAS u32x2*)src + lane + 64 * j); } }
        if (MODE == 0) { GAS bf16_t* hp = hrow(a, m);
#pragma unroll
            for (int j = 0; j < 8; ++j) { u32x2 o; o.x = cvt_pk(v[j][0], v[j][1]); o.y = cvt_pk(v[j][2], v[j][3]); *((GAS u32x2*)hp + lane + 64 * j) = o; } }
        const float rstd = rsqrtf(wave_sum(ss) * (1.0f / D) + EPS);
#pragma unroll
        for (int j = 0; j < 8; ++j) v[j] = v[j] * rstd * w[j];
        if (MODE == 3) { GAS float* op = a.out + (size_t)m * D;
#pragma unroll
            for (int j = 0; j < 8; ++j) __builtin_nontemporal_store(v[j], (GAS f32x4*)op + lane + 64 * j);
        } else { GAS bf16_t* op = XA + (size_t)m * D;
#pragma unroll
            for (int j = 0; j < 8; ++j) { u32x2 o; o.x = cvt_pk(v[j][0], v[j][1]); o.y = cvt_pk(v[j][2], v[j][3]); *((GAS u32x2*)op + lane + 64 * j) = o; } }
        if (MODE <= 1) {
            float mine = 0.f;
#pragma unroll
            for (int g = 0; g < 8; ++g) { float s = 0.f;
#pragma unroll
                for (int j = 0; j < 8; ++j) { const f32x4 wg = *((const LAS f32x4*)(WG + g * D) + lane + 64 * j); s += (v[j][0] * wg[0] + v[j][1] * wg[1]) + (v[j][2] * wg[2] + v[j][3] * wg[3]); }
                s = wave_sum(s); mine = (lane == g) ? s : mine; }
            if (lane < 8) { const float raw = mine + a.bg[layer * 8 + lane]; const float e2 = __expf(raw * (2.0f / GATE_CAP)); const float cp = GATE_CAP * (e2 - 1.0f) / (e2 + 1.0f);
                if (lane < 4) LI[m * 4 + lane] = cp; else LF[m * 4 + lane - 4] = fminf(cp, 0.f) - __logf(1.0f + __expf(-fabsf(cp))); }
        }
    }
}

__device__ __forceinline__ bf16x8 pack8(const f32x4& x, const f32x4& y) {
    u32x4 w; w.x = cvt_pk(x[0], x[1]); w.y = cvt_pk(x[2], x[3]); w.z = cvt_pk(y[0], y[1]); w.w = cvt_pk(y[2], y[3]); return __builtin_bit_cast(bf16x8, w);
}

typedef short v4i16_t __attribute__((ext_vector_type(4)));
__device__ __forceinline__ s16x4 lds_tr(LAS unsigned char* p) { return __builtin_bit_cast(s16x4, __builtin_amdgcn_ds_read_tr16_b64_v4i16((LAS v4i16_t*)p)); }
#define MFMA16(x, y, c) __builtin_amdgcn_mfma_f32_16x16x32_bf16((x), (y), (c), 0, 0, 0)
constexpr int KIMG_STRIDE = 288, KIMG_BYTES = 64 * KIMG_STRIDE;
constexpr int VIMG_STRIDE = 72, VIMG_BYTES = 64 * VIMG_STRIDE;
constexpr int MTEAM_BYTES = 2 * (KIMG_BYTES + VIMG_BYTES);
constexpr int MSC_OFF = 2 * MTEAM_BYTES;

__device__ __forceinline__ void mlstm_team(const PArgs& a, bool valid, bool den_item, int bh, int sl, int tb, LAS unsigned char* kteam, LAS float* sc, int lane_in) {
    const GAS bf16_t* proj = (const GAS bf16_t*)(a.ws + WS_PROJ);
    const GAS float* LI = (const GAS float*)(a.ws + WS_LI); const GAS float* LF = (const GAS float*)(a.ws + WS_LF);
    GAS bf16_t* NUM = (GAS bf16_t*)(a.ws + WS_NUM); GAS float* DEN = (GAS float*)(a.ws + WS_DEN); GAS float* MT = (GAS float*)(a.ws + WS_MT);
    const int b = bh >> 2, hd = bh & 3;
    int lane = lane_in; asm volatile("" : "+v"(lane));
    int fr = lane & 15, fq = lane >> 4;
    f32x4 C[2][8], C2[8];
#pragma unroll
    for (int i = 0; i < 8; ++i) { C[0][i] = (f32x4){0.f, 0.f, 0.f, 0.f}; C[1][i] = (f32x4){0.f, 0.f, 0.f, 0.f}; C2[i] = (f32x4){0.f, 0.f, 0.f, 0.f}; }
    f32x4 dn_p = (f32x4){0.f, 0.f, 0.f, 0.f};
    float m_st = 0.f;
#define ROWOF(cc, p) ((cc) == 0 ? (MREAL + ((p) < 48 ? 0 : (p) - 48)) : (b * SEQ + ((cc) - 1) * 64 + (p)))
    u32x4 kpre[4], vpre; float lfpre = 0.f, lipre = 0.f; bf16x8 qpre[4];
    f32x4 nm_p[2]; float mt_p = 0.f; nm_p[0] = (f32x4){0.f, 0.f, 0.f, 0.f}; nm_p[1] = nm_p[0];
#define LOAD_CHUNK(cc) do { \
        { const GAS bf16_t* rp_ = proj + (size_t)ROWOF(cc, 16 * tb + (lane >> 2)) * LDP; \
          _Pragma("unroll") for (int i = 0; i < 4; ++i) kpre[i] = *(const GAS u32x4*)(rp_ + C_K + hd * 128 + (lane & 3) * 32 + 8 * i); \
          vpre = *(const GAS u32x4*)(rp_ + C_V + hd * 256 + sl * 32 + (lane & 3) * 8); } \
        { const int rl_ = ROWOF(cc, lane); lfpre = LF[rl_ * 4 + hd]; lipre = LI[rl_ * 4 + hd]; } \
        { const GAS bf16_t* rp_ = proj + (size_t)ROWOF(cc, tb * 16 + fr) * LDP + C_Q + hd * 128 + fq * 4; \
          _Pragma("unroll") for (int kc = 0; kc < 4; ++kc) { const s16x4 lo_ = *(const GAS s16x4*)(rp_ + 32 * kc), hi_ = *(const GAS s16x4*)(rp_ + 32 * kc + 16); qpre[kc] = __builtin_shufflevector(lo_, hi_, 0, 1, 2, 3, 4, 5, 6, 7); } } } while (0)
#define STORE_OUT(cc) do { if ((cc) > 0 || (tb == 3 && b == 0)) { \
        _Pragma("unroll") for (int sx = 0; sx < 2; ++sx) _Pragma("unroll") for (int jj = 0; jj < 4; ++jj) \
            NUM[(size_t)ROWOF(cc, tb * 16 + fq * 4 + jj) * 1024 + hd * 256 + sl * 32 + sx * 16 + fr] = (bf16_t)(cvt_pk(nm_p[sx][jj], 0.f) & 0xffffu); \
        if (den_item) { if (fr == 0) { _Pragma("unroll") for (int jj = 0; jj < 4; ++jj) DEN[ROWOF(cc, tb * 16 + fq * 4 + jj) * 4 + hd] = dn_p[jj]; } \
            if (fq == 0) MT[ROWOF(cc, tb * 16 + fr) * 4 + hd] = mt_p; } } } while (0)
    if (valid) LOAD_CHUNK(0);
#pragma unroll 1
    for (int c = 0; c < NCHUNK; ++c) {
        const int cn = c + 1 < NCHUNK ? c + 1 : c;
        LAS unsigned char* kimg = kteam + (c & 1) * (KIMG_BYTES + VIMG_BYTES); LAS unsigned char* vimg = kimg + KIMG_BYTES;
        float w_old = 0.f, m_new = 0.f; bf16x8 qf[4];
        if (valid) {
            asm volatile("" : "+v"(lane)); fr = lane & 15; fq = lane >> 4;
            __builtin_amdgcn_s_waitcnt(0x0F70);
            const float lf0 = lfpre, li0 = lipre;
            { LAS unsigned char* wp = kimg + (16 * tb + (lane >> 2)) * KIMG_STRIDE + (lane & 3) * 64;
#pragma unroll
              for (int i = 0; i < 4; ++i) *(LAS u32x4*)(wp + 16 * i) = kpre[i];
              const u32x4 vv = vpre;
              LAS unsigned char* vp = vimg + (16 * tb + (lane >> 2)) * VIMG_STRIDE + (lane & 3) * 16;
              *(LAS u32x2*)vp = (u32x2){vv[0], vv[1]}; *(LAS u32x2*)(vp + 8) = (u32x2){vv[2], vv[3]}; }
#pragma unroll
            for (int kc = 0; kc < 4; ++kc) qf[kc] = qpre[kc];
            LOAD_CHUNK(cn);
            {
                float lf = lf0, li = li0;
                if (c == 0 && lane < 48) { lf = 0.f; li = -1e30f; }
                const float bc = wave_scan_sum(lf);
                const float b_end = __builtin_bit_cast(float, __builtin_amdgcn_readlane(__builtin_bit_cast(int, bc), 63));
                const float decay = b_end - bc + li;
                m_new = fmaxf(b_end + m_st, wave_max_last(decay));
                w_old = __expf(b_end + m_st - m_new);
                sc[lane] = li - bc; sc[64 + lane] = __expf(decay - m_new); sc[128 + lane] = bc;
            }
        }
        asm volatile("s_waitcnt lgkmcnt(0)" ::: "memory");
        __builtin_amdgcn_s_barrier();
        asm volatile("" ::: "memory");
        if (valid) {
            bf16x8 vf[2][2], wvf[2][2];
#pragma unroll
            for (int ks = 0; ks < 2; ++ks) { const f32x4 wi0 = *(const LAS f32x4*)(sc + 64 + 32 * ks + 4 * fq), wi1 = *(const LAS f32x4*)(sc + 64 + 32 * ks + 16 + 4 * fq);
#pragma unroll
                for (int sx = 0; sx < 2; ++sx) { LAS unsigned char* tp = vimg + (32 * ks + 4 * fq + (fr >> 2)) * VIMG_STRIDE + (sx * 16 + 4 * (fr & 3)) * 2;
                    const s16x4 lo = lds_tr(tp), hi = lds_tr(tp + 16 * VIMG_STRIDE);
                    vf[sx][ks] = __builtin_shufflevector(lo, hi, 0, 1, 2, 3, 4, 5, 6, 7);
                    const u32x2 l2 = __builtin_bit_cast(u32x2, lo), h2 = __builtin_bit_cast(u32x2, hi);
                    wvf[sx][ks] = pack8((f32x4){bflo(l2[0]) * wi0[0], bfhi(l2[0]) * wi0[1], bflo(l2[1]) * wi0[2], bfhi(l2[1]) * wi0[3]},
                                        (f32x4){bflo(h2[0]) * wi1[0], bfhi(h2[0]) * wi1[1], bflo(h2[1]) * wi1[2], bfhi(h2[1]) * wi1[3]}); } }
            const int t = tb * 16 + fr;
            f32x4 S[4];
#pragma unroll
            for (int hb = 0; hb < 2; ++hb) { bf16x8 kf[2][4];
#pragma unroll
              for (int sb = 0; sb < 2; ++sb) { const LAS unsigned char* kp = kimg + ((2 * hb + sb) * 16 + fr) * KIMG_STRIDE + fq * 8;
#pragma unroll
                for (int kc = 0; kc < 4; ++kc) { const s16x4 lo = *(const LAS s16x4*)(kp + 64 * kc), hi = *(const LAS s16x4*)(kp + 64 * kc + 32); kf[sb][kc] = __builtin_shufflevector(lo, hi, 0, 1, 2, 3, 4, 5, 6, 7); } }
              __builtin_amdgcn_sched_barrier(0);
#pragma unroll
              for (int sb = 0; sb < 2; ++sb) { f32x4 acc = (f32x4){0.f, 0.f, 0.f, 0.f};
#pragma unroll
                for (int kc = 0; kc < 4; ++kc) acc = MFMA16(kf[sb][kc], qf[kc], acc);
                S[2 * hb + sb] = acc; }
              __builtin_amdgcn_sched_barrier(0); }
            const float bt = sc[128 + t];
            f32x4 gs[4];
#pragma unroll
            for (int sb = 0; sb < 4; ++sb) gs[sb] = *(const LAS f32x4*)(sc + sb * 16 + 4 * fq);
            float dmax = -1e30f;
#pragma unroll
            for (int sb = 0; sb < 4; ++sb)
#pragma unroll
                for (int jj = 0; jj < 4; ++jj) { const float d = (sb < tb || (sb == tb && fq * 4 + jj <= fr)) ? bt + gs[sb][jj] : -1e30f; dmax = fmaxf(dmax, d); }
            { auto r16 = __builtin_amdgcn_permlane16_swap(__float_as_uint(dmax), __float_as_uint(dmax), false, false); dmax = fmaxf(__uint_as_float(r16[0]), __uint_as_float(r16[1]));
              auto r32 = __builtin_amdgcn_permlane32_swap(__float_as_uint(dmax), __float_as_uint(dmax), false, false); dmax = fmaxf(__uint_as_float(r32[0]), __uint_as_float(r32[1])); }
            const float inter = bt + m_st, mt = fmaxf(inter, dmax);
            sc[192 + fr] = __expf(inter - mt);
#pragma unroll
            for (int sb = 0; sb < 4; ++sb)
#pragma unroll
                for (int jj = 0; jj < 4; ++jj) { const float e = (sb < tb || (sb == tb && fq * 4 + jj <= fr)) ? __expf(bt + gs[sb][jj] - mt) : 0.f; S[sb][jj] *= e; }
            const f32x4 wint = *(const LAS f32x4*)(sc + 192 + 4 * fq);
            const bf16x8 sw0 = pack8(S[0], S[1]), sw1 = pack8(S[2], S[3]);
#pragma unroll
            for (int sx = 0; sx < 2; ++sx) { f32x4 nm = (f32x4){0.f, 0.f, 0.f, 0.f};
#pragma unroll
                for (int kc = 0; kc < 4; ++kc) nm = MFMA16(qf[kc], pack8(C[sx][2 * kc], C[sx][2 * kc + 1]), nm);
                nm = nm * wint;
                nm = MFMA16(sw0, vf[sx][0], nm);
                nm = MFMA16(sw1, vf[sx][1], nm);
                nm_p[sx] = nm; }
            mt_p = mt;
            bf16x8 w2f[2];
            if (den_item) {
#pragma unroll
                for (int ks = 0; ks < 2; ++ks) { const f32x4 wi0 = *(const LAS f32x4*)(sc + 64 + 32 * ks + 4 * fq), wi1 = *(const LAS f32x4*)(sc + 64 + 32 * ks + 16 + 4 * fq);
                    const f32x4 z = (f32x4){0.f, 0.f, 0.f, 0.f}; w2f[ks] = pack8(fr == 0 ? wi0 : z, fr == 0 ? wi1 : z); }
                const unsigned one2 = (fr == 0) ? 0x3F803F80u : 0u; const bf16x8 onesf = __builtin_bit_cast(bf16x8, (u32x4){one2, one2, one2, one2});
                f32x4 dn = (f32x4){0.f, 0.f, 0.f, 0.f};
#pragma unroll
                for (int kc = 0; kc < 4; ++kc) dn = MFMA16(qf[kc], pack8(C2[2 * kc], C2[2 * kc + 1]), dn);
                dn = dn * wint; dn = MFMA16(sw0, onesf, dn); dn = MFMA16(sw1, onesf, dn); dn_p = dn;
            } else { w2f[0] = sw0; w2f[1] = sw0; }
#pragma unroll
            for (int dh = 0; dh < 2; ++dh) { bf16x8 kt[4][2];
#pragma unroll
                for (int d4 = 0; d4 < 4; ++d4)
#pragma unroll
                    for (int ks = 0; ks < 2; ++ks) { LAS unsigned char* tp = kimg + (32 * ks + 4 * fq + (fr >> 2)) * KIMG_STRIDE + ((dh * 4 + d4) * 16 + 4 * (fr & 3)) * 2;
                        const s16x4 lo = lds_tr(tp), hi = lds_tr(tp + 16 * KIMG_STRIDE); kt[d4][ks] = __builtin_shufflevector(lo, hi, 0, 1, 2, 3, 4, 5, 6, 7); }
                __builtin_amdgcn_sched_barrier(0);
#pragma unroll
                for (int sx = 0; sx < 2; ++sx)
#pragma unroll
                    for (int d4 = 0; d4 < 4; ++d4) { const int dt = dh * 4 + d4; f32x4 cc = C[sx][dt] * w_old;
                        cc = MFMA16(kt[d4][0], wvf[sx][0], cc); cc = MFMA16(kt[d4][1], wvf[sx][1], cc); C[sx][dt] = cc; }
                if (den_item) {
#pragma unroll
                    for (int d4 = 0; d4 < 4; ++d4) { const int dt = dh * 4 + d4; f32x4 c2 = C2[dt] * w_old;
                        c2 = MFMA16(kt[d4][0], w2f[0], c2); c2 = MFMA16(kt[d4][1], w2f[1], c2); C2[dt] = c2; } }
                __builtin_amdgcn_sched_barrier(0); }
            m_st = m_new;
            STORE_OUT(c);
        }
        asm volatile("s_waitcnt lgkmcnt(0)" ::: "memory");
    }
#undef STORE_OUT
#undef ROWOF
#undef LOAD_CHUNK
}
__device__ __forceinline__ void mlstm_den_wave(const PArgs& a, int bh, int tb, LAS unsigned char* kteam, LAS float* sc, int lane_in) {
    const GAS bf16_t* proj = (const GAS bf16_t*)(a.ws + WS_PROJ);
    const GAS float* LI = (const GAS float*)(a.ws + WS_LI); const GAS float* LF = (const GAS float*)(a.ws + WS_LF);
    GAS float* DEN = (GAS float*)(a.ws + WS_DEN); GAS float* MT = (GAS float*)(a.ws + WS_MT);
    const int b = bh >> 2, hd = bh & 3;
    int lane = lane_in; asm volatile("" : "+v"(lane));
    int fr = lane & 15, fq = lane >> 4;
    f32x4 C2[8];
#pragma unroll
    for (int i = 0; i < 8; ++i) C2[i] = (f32x4){0.f, 0.f, 0.f, 0.f};
    float m_st = 0.f;
#define ROWOF(cc, p) ((cc) == 0 ? (MREAL + ((p) < 48 ? 0 : (p) - 48)) : (b * SEQ + ((cc) - 1) * 64 + (p)))
    float lfpre = 0.f, lipre = 0.f; bf16x8 qpre[4]; f32x4 dn_p = (f32x4){0.f, 0.f, 0.f, 0.f}; float mt_p = 0.f;
#define LOAD_D(cc) do { \
        { const int rl_ = ROWOF(cc, lane); lfpre = LF[rl_ * 4 + hd]; lipre = LI[rl_ * 4 + hd]; } \
        { const GAS bf16_t* rp_ = proj + (size_t)ROWOF(cc, tb * 16 + fr) * LDP + C_Q + hd * 128 + fq * 4; \
          _Pragma("unroll") for (int kc = 0; kc < 4; ++kc) { const s16x4 lo_ = *(const GAS s16x4*)(rp_ + 32 * kc), hi_ = *(const GAS s16x4*)(rp_ + 32 * kc + 16); qpre[kc] = __builtin_shufflevector(lo_, hi_, 0, 1, 2, 3, 4, 5, 6, 7); } } } while (0)
#define STORE_D(cc) do { if ((cc) > 0 || (tb == 3 && b == 0)) { \
        if (fr == 0) { _Pragma("unroll") for (int jj = 0; jj < 4; ++jj) DEN[ROWOF(cc, tb * 16 + fq * 4 + jj) * 4 + hd] = dn_p[jj]; } \
        if (fq == 0) MT[ROWOF(cc, tb * 16 + fr) * 4 + hd] = mt_p; } } while (0)
    LOAD_D(0);
#pragma unroll 1
    for (int c = 0; c < NCHUNK; ++c) {
        const int cn = c + 1 < NCHUNK ? c + 1 : c;
        LAS unsigned char* kimg = kteam + (c & 1) * (KIMG_BYTES + VIMG_BYTES);
        float w_old, m_new; bf16x8 qf[4];
        asm volatile("" : "+v"(lane)); fr = lane & 15; fq = lane >> 4;
        __builtin_amdgcn_s_waitcnt(0x0F70);
        { const float lf0 = lfpre, li0 = lipre;
#pragma unroll
          for (int kc = 0; kc < 4; ++kc) qf[kc] = qpre[kc];
          LOAD_D(cn);
          float lf = lf0, li = li0;
          if (c == 0 && lane < 48) { lf = 0.f; li = -1e30f; }
          const float bc = wave_scan_sum(lf);
          const float b_end = __builtin_bit_cast(float, __builtin_amdgcn_readlane(__builtin_bit_cast(int, bc), 63));
          const float decay = b_end - bc + li;
          m_new = fmaxf(b_end + m_st, wave_max_last(decay));
          w_old = __expf(b_end + m_st - m_new);
          sc[lane] = li - bc; sc[64 + lane] = __expf(decay - m_new); sc[128 + lane] = bc; }
        asm volatile("s_waitcnt lgkmcnt(0)" ::: "memory");
        __builtin_amdgcn_s_barrier();
        asm volatile("" ::: "memory");
        bf16x8 w2f[2];
#pragma unroll
        for (int ks = 0; ks < 2; ++ks) { const f32x4 wi0 = *(const LAS f32x4*)(sc + 64 + 32 * ks + 4 * fq), wi1 = *(const LAS f32x4*)(sc + 64 + 32 * ks + 16 + 4 * fq);
            const f32x4 z = (f32x4){0.f, 0.f, 0.f, 0.f}; w2f[ks] = pack8(fr == 0 ? wi0 : z, fr == 0 ? wi1 : z); }
        const unsigned one2 = (fr == 0) ? 0x3F803F80u : 0u;
        const bf16x8 onesf = __builtin_bit_cast(bf16x8, (u32x4){one2, one2, one2, one2});
        const int t = tb * 16 + fr;
        f32x4 S[4];
#pragma unroll
        for (int hb = 0; hb < 2; ++hb) { bf16x8 kf[2][4];
#pragma unroll
          for (int sb = 0; sb < 2; ++sb) { const LAS unsigned char* kp = kimg + ((2 * hb + sb) * 16 + fr) * KIMG_STRIDE + fq * 8;
#pragma unroll
            for (int kc = 0; kc < 4; ++kc) { const s16x4 lo = *(const LAS s16x4*)(kp + 64 * kc), hi = *(const LAS s16x4*)(kp + 64 * kc + 32); kf[sb][kc] = __builtin_shufflevector(lo, hi, 0, 1, 2, 3, 4, 5, 6, 7); } }
          __builtin_amdgcn_sched_barrier(0);
#pragma unroll
          for (int sb = 0; sb < 2; ++sb) { f32x4 acc = (f32x4){0.f, 0.f, 0.f, 0.f};
#pragma unroll
            for (int kc = 0; kc < 4; ++kc) acc = MFMA16(kf[sb][kc], qf[kc], acc);
            S[2 * hb + sb] = acc; }
          __builtin_amdgcn_sched_barrier(0); }
        const float bt = sc[128 + t];
        f32x4 gs[4];
#pragma unroll
        for (int sb = 0; sb < 4; ++sb) gs[sb] = *(const LAS f32x4*)(sc + sb * 16 + 4 * fq);
        float dmax = -1e30f;
#pragma unroll
        for (int sb = 0; sb < 4; ++sb)
#pragma unroll
            for (int jj = 0; jj < 4; ++jj) { const float d = (sb < tb || (sb == tb && fq * 4 + jj <= fr)) ? bt + gs[sb][jj] : -1e30f; dmax = fmaxf(dmax, d); }
        { auto r16 = __builtin_amdgcn_permlane16_swap(__float_as_uint(dmax), __float_as_uint(dmax), false, false); dmax = fmaxf(__uint_as_float(r16[0]), __uint_as_float(r16[1]));
          auto r32 = __builtin_amdgcn_permlane32_swap(__float_as_uint(dmax), __float_as_uint(dmax), false, false); dmax = fmaxf(__uint_as_float(r32[0]), __uint_as_float(r32[1])); }
        const float inter = bt + m_st, mt = fmaxf(inter, dmax);
        sc[192 + fr] = __expf(inter - mt);
#pragma unroll
        for (int sb = 0; sb < 4; ++sb)
#pragma unroll
            for (int jj = 0; jj < 4; ++jj) { const float e = (sb < tb || (sb == tb && fq * 4 + jj <= fr)) ? __expf(bt + gs[sb][jj] - mt) : 0.f; S[sb][jj] *= e; }
        const f32x4 wint = *(const LAS f32x4*)(sc + 192 + 4 * fq);
        const bf16x8 sw0 = pack8(S[0], S[1]), sw1 = pack8(S[2], S[3]);
        { f32x4 dn = (f32x4){0.f, 0.f, 0.f, 0.f};
#pragma unroll
          for (int kc = 0; kc < 4; ++kc) dn = MFMA16(qf[kc], pack8(C2[2 * kc], C2[2 * kc + 1]), dn);
          dn = dn * wint; dn = MFMA16(sw0, onesf, dn); dn = MFMA16(sw1, onesf, dn);
          dn_p = dn; mt_p = mt; }
#pragma unroll
        for (int dh = 0; dh < 2; ++dh) { bf16x8 kt[4][2];
#pragma unroll
            for (int d4 = 0; d4 < 4; ++d4)
#pragma unroll
                for (int ks = 0; ks < 2; ++ks) { LAS unsigned char* tp = kimg + (32 * ks + 4 * fq + (fr >> 2)) * KIMG_STRIDE + ((dh * 4 + d4) * 16 + 4 * (fr & 3)) * 2;
                    const s16x4 lo = lds_tr(tp), hi = lds_tr(tp + 16 * KIMG_STRIDE); kt[d4][ks] = __builtin_shufflevector(lo, hi, 0, 1, 2, 3, 4, 5, 6, 7); }
            __builtin_amdgcn_sched_barrier(0);
#pragma unroll
            for (int d4 = 0; d4 < 4; ++d4) { const int dt = dh * 4 + d4; f32x4 c2 = C2[dt] * w_old;
                c2 = MFMA16(kt[d4][0], w2f[0], c2); c2 = MFMA16(kt[d4][1], w2f[1], c2); C2[dt] = c2; }
            __builtin_amdgcn_sched_barrier(0); }
        m_st = m_new;
        STORE_D(c);
        asm volatile("s_waitcnt lgkmcnt(0)" ::: "memory");
    }
#undef STORE_D
#undef LOAD_D
#undef ROWOF
}
constexpr int MCONV_OFF = MSC_OFF + 8 * 1024;
static_assert(MCONV_OFF + 4 * 9216 <= LDS_BYTES - 256, "mLSTM LDS map");
__device__ __forceinline__ void mlstm_phase(const PArgs& a, LAS unsigned char* lds, int wave, int lane, int conv_layer) {
    const int G = gridDim.x;
    LAS float* sc = (LAS float*)(lds + MSC_OFF + wave * 1024);
    const int base = (int)blockIdx.x; (void)G;
    if (base < 256) {
        if (wave < 4) mlstm_team(a, true, ((base & 1) == 0) && wave == ((base & 7) >> 1), base >> 3, base & 7, wave, lds, sc, lane);
        else if (wave >= 5 && conv_layer >= 0) weights_stream(a, (LAS float*)(lds + MCONV_OFF + (wave - 5) * 9216), lane, base * 3 + (wave - 5), 768, conv_layer * W_ITEMS_LAYER, NCHUNK);
        else { for (int c = 0; c < NCHUNK; ++c) { asm volatile("s_waitcnt lgkmcnt(0)" ::: "memory"); __builtin_amdgcn_s_barrier(); asm volatile("" ::: "memory"); } }
        __syncthreads();
    }
}

template <int NSTEP>
__device__ __forceinline__ f32x4 mini_dot(const GAS bf16_t* Ar, const GAS bf16_t* Br) {
    f32x4 acc = (f32x4){0.f, 0.f, 0.f, 0.f};
#pragma unroll
    for (int s0 = 0; s0 < NSTEP; s0 += 8) { constexpr int dummy = 0; (void)dummy; bf16x8 av[8], bv[8];
#pragma unroll
        for (int i = 0; i < 8; ++i) if (s0 + i < NSTEP) { av[i] = *(const GAS bf16x8*)(Ar + 32 * (s0 + i)); bv[i] = *(const GAS bf16x8*)(Br + 32 * (s0 + i)); }
#pragma unroll
        for (int i = 0; i < 8; ++i) if (s0 + i < NSTEP) acc = MFMA16(bv[i], av[i], acc); }
    return acc;
}
template <int WHICH>
__device__ __forceinline__ void mini_gemm(const PArgs& a, int l, LAS unsigned char* lds, int wave, int lane) {
    const int fr = lane & 15, fq = lane >> 4, G = gridDim.x;
    const GAS bf16_t* XA = (const GAS bf16_t*)(a.ws + WS_XA); GAS bf16_t* PROJ = (GAS bf16_t*)(a.ws + WS_PROJ); GAS bf16_t* hm = (GAS bf16_t*)(a.ws + WS_HMETA);
    LAS f32x4* red = (LAS f32x4*)lds;
    constexpr int NT = WHICH == 1 ? LDP / 16 : (WHICH == 3 ? DFF / 16 : D / 16);
    constexpr int K = WHICH == 4 ? DFF : D, KS = K / 8, NSTEP = KS / 32;
    for (int t = (int)blockIdx.x; t < NT; t += G) {
        const int n0 = t * 16;
        const GAS bf16_t* Ar = (WHICH == 4 ? (const GAS bf16_t*)PROJ : XA) + (size_t)(MREAL + fr) * K + wave * KS + 8 * fq;
        const GAS bf16_t* Wt = (const GAS bf16_t*)(a.ws + (WHICH == 1 ? WS_WT_IN + l * SZ_WT_IN : WHICH == 2 ? WS_WT_OUT + l * SZ_WT_OUT : WHICH == 3 ? WS_WT_GU + l * SZ_WT_GU : WS_WT_DN + l * SZ_WT_DN));
        const bool prod1 = (WHICH == 1 && n0 >= C_A && n0 < C_GB);
        const int r0 = WHICH == 3 ? (n0 >> 7) * 256 + (n0 & 127) : (WHICH == 1 ? (n0 < C_A ? n0 : (n0 < C_GB ? 3072 + ((n0 - C_A) >> 7) * 256 + ((n0 - C_A) & 127) : 5120 + (n0 - C_GB))) : n0);
        red[wave * 64 + lane] = mini_dot<NSTEP>(Ar, Wt + (size_t)(r0 + fr) * K + wave * KS + 8 * fq);
        if (WHICH == 3 || prod1) red[512 + wave * 64 + lane] = mini_dot<NSTEP>(Ar, Wt + (size_t)(r0 + 128 + fr) * K + wave * KS + 8 * fq);
        __syncthreads();
        if (wave == 0) {
            f32x4 acc = red[lane], up = (f32x4){0.f, 0.f, 0.f, 0.f};
#pragma unroll
            for (int w = 1; w < 8; ++w) acc = acc + red[w * 64 + lane];
            if (WHICH == 3 || prod1) { up = red[512 + lane];
#pragma unroll
                for (int w = 1; w < 8; ++w) up = up + red[512 + w * 64 + lane]; }
            if (WHICH == 1) { if (n0 < C_K) acc = acc * 0.08838834764831845f; if (prod1) acc = acc * up;
                u32x2 o; o.x = cvt_pk(acc[0], acc[1]); o.y = cvt_pk(acc[2], acc[3]); *(GAS u32x2*)(PROJ + (size_t)(MREAL + fr) * LDP + n0 + 4 * fq) = o; }
            if (WHICH == 2 || WHICH == 4) { GAS u32x2* hp = (GAS u32x2*)(hm + (size_t)fr * D + n0 + 4 * fq); const u32x2 o = *hp; u32x2 w; w.x = cvt_pk(bflo(o.x) + acc[0], bfhi(o.x) + acc[1]); w.y = cvt_pk(bflo(o.y) + acc[2], bfhi(o.y) + acc[3]); *hp = w; }
            if (WHICH == 3) { float r[4];
#pragma unroll
                for (int j = 0; j < 4; ++j) r[j] = acc[j] * up[j] * __builtin_amdgcn_rcpf(1.0f + __expf(-acc[j]));
                u32x2 o; o.x = cvt_pk(r[0], r[1]); o.y = cvt_pk(r[2], r[3]); *(GAS u32x2*)(PROJ + (size_t)(MREAL + fr) * DFF + n0 + 4 * fq) = o; }
        }
        __syncthreads();
    }
}

__device__ __forceinline__ void cat_phase(const PArgs& a, int layer, int wave, int lane) {
    const GAS bf16_t* proj = (const GAS bf16_t*)(a.ws + WS_PROJ); const GAS bf16_t* NUM = (const GAS bf16_t*)(a.ws + WS_NUM);
    const GAS float* DEN = (const GAS float*)(a.ws + WS_DEN); const GAS float* MT = (const GAS float*)(a.ws + WS_MT);
    GAS bf16_t* XA = (GAS bf16_t*)(a.ws + WS_XA);
    const GAS float* mnw = a.mnw + layer * 1024; const GAS float* cw = a.cw + layer * 3 * 1024;
    const int gw = blockIdx.x * NWAVES + wave, NGW = gridDim.x * NWAVES;
    f32x4 w4[4], k0[4], k1[4], k2[4];
#pragma unroll
    for (int j = 0; j < 4; ++j) { const int c = lane * 4 + 256 * j; w4[j] = *(const GAS f32x4*)(mnw + c); k0[j] = *(const GAS f32x4*)(cw + c); k1[j] = *(const GAS f32x4*)(cw + 1024 + c); k2[j] = *(const GAS f32x4*)(cw + 2048 + c); }
    for (int m = gw; m < MTOT; m += NGW) {
        int p1, p2;
        if (m < MREAL) { const int t = m & (SEQ - 1); p1 = t >= 1 ? m - 1 : MREAL + 15; p2 = t >= 2 ? m - 2 : MREAL + 14 + t; }
        else { const int j = (m - MREAL) & 15; p1 = j >= 1 ? m - 1 : -1; p2 = j >= 2 ? m - 2 : -1; }
        const GAS bf16_t* pr = proj + (size_t)m * LDP; const GAS bf16_t* pr1 = proj + (size_t)(p1 < 0 ? m : p1) * LDP; const GAS bf16_t* pr2 = proj + (size_t)(p2 < 0 ? m : p2) * LDP;
        const float z1 = p1 < 0 ? 0.f : 1.f, z2 = p2 < 0 ? 0.f : 1.f;
        u32x2 nv[4], ogv[4], a0[4], gb[4], a1[4], a2[4]; float den[4], mt[4];
#pragma unroll
        for (int j = 0; j < 4; ++j) { const int c = lane * 4 + 256 * j;
            nv[j] = *(const GAS u32x2*)(NUM + (size_t)m * 1024 + c); den[j] = DEN[m * 4 + j]; mt[j] = MT[m * 4 + j]; ogv[j] = *(const GAS u32x2*)(pr + C_OG + c);
            a0[j] = *(const GAS u32x2*)(pr + C_A + c); gb[j] = *(const GAS u32x2*)(pr + C_GB + c); a1[j] = *(const GAS u32x2*)(pr1 + C_A + c); a2[j] = *(const GAS u32x2*)(pr2 + C_A + c); }
#pragma unroll
        for (int j = 0; j < 4; ++j) {
            const int c = lane * 4 + 256 * j;
            const float sc = 1.0f / fmaxf(fabsf(den[j]), __expf(-mt[j]));
            const float h0 = bflo(nv[j].x) * sc, h1 = bfhi(nv[j].x) * sc, h2 = bflo(nv[j].y) * sc, h3 = bfhi(nv[j].y) * sc;
            const float r = rsqrtf(wave_sum((h0 * h0 + h1 * h1) + (h2 * h2 + h3 * h3)) * (1.0f / DV) + EPS);
            const float s0 = 1.0f / (1.0f + __expf(-bflo(ogv[j].x))), s1 = 1.0f / (1.0f + __expf(-bfhi(ogv[j].x))), s2 = 1.0f / (1.0f + __expf(-bflo(ogv[j].y))), s3 = 1.0f / (1.0f + __expf(-bfhi(ogv[j].y)));
            u32x2 o; o.x = cvt_pk(s0 * h0 * r * w4[j][0], s1 * h1 * r * w4[j][1]); o.y = cvt_pk(s2 * h2 * r * w4[j][2], s3 * h3 * r * w4[j][3]);
            *(GAS u32x2*)(XA + (size_t)m * D + c) = o;
            float cv[4];
            cv[0] = z2 * bflo(a2[j].x) * k0[j][0] + z1 * bflo(a1[j].x) * k1[j][0] + bflo(a0[j].x) * k2[j][0];
            cv[1] = z2 * bfhi(a2[j].x) * k0[j][1] + z1 * bfhi(a1[j].x) * k1[j][1] + bfhi(a0[j].x) * k2[j][1];
            cv[2] = z2 * bflo(a2[j].y) * k0[j][2] + z1 * bflo(a1[j].y) * k1[j][2] + bflo(a0[j].y) * k2[j][2];
            cv[3] = z2 * bfhi(a2[j].y) * k0[j][3] + z1 * bfhi(a1[j].y) * k1[j][3] + bfhi(a0[j].y) * k2[j][3];
            u32x2 oc; oc.x = cvt_pk(bflo(gb[j].x) * cv[0], bfhi(gb[j].x) * cv[1]); oc.y = cvt_pk(bflo(gb[j].y) * cv[2], bfhi(gb[j].y) * cv[3]);
            *(GAS u32x2*)(XA + (size_t)m * D + 1024 + c) = oc;
        }
    }
}

#ifndef MK_PER_PHASE
#define MK_PER_PHASE 0
#endif

__device__ __forceinline__ PArgs launder(const Args& s) { Args r = s;
    asm volatile("" : "+s"(r.x), "+s"(r.meta), "+s"(r.nmw), "+s"(r.win), "+s"(r.bg), "+s"(r.cw), "+s"(r.mnw), "+s"(r.wout), "+s"(r.nfw), "+s"(r.wg), "+s"(r.wu), "+s"(r.wd), "+s"(r.nfin), "+s"(r.out), "+s"(r.ws));
    PArgs q; q.x = (const GAS float*)r.x; q.meta = (const GAS float*)r.meta; q.nmw = (const GAS float*)r.nmw; q.win = (const GAS float*)r.win; q.bg = (const GAS float*)r.bg; q.cw = (const GAS float*)r.cw;
    q.mnw = (const GAS float*)r.mnw; q.wout = (const GAS float*)r.wout; q.nfw = (const GAS float*)r.nfw; q.wg = (const GAS float*)r.wg; q.wu = (const GAS float*)r.wu; q.wd = (const GAS float*)r.wd; q.nfin = (const GAS float*)r.nfin;
    q.out = (GAS float*)r.out; q.ws = (GAS unsigned char*)r.ws;
    return q; }
constexpr int N_PHASES = 17;

__global__ void __launch_bounds__(NTHREADS, 2) hymba_fwd(Args a_in) {
    extern __shared__ __attribute__((aligned(16))) unsigned char lds_raw[];
    LAS unsigned char* lds = (LAS unsigned char*)lds_raw;
    const int wave = __builtin_amdgcn_readfirstlane(threadIdx.x >> 6);
#define LANE() ({ int l_; asm volatile("v_mbcnt_lo_u32_b32 %0, -1, 0\n\tv_mbcnt_hi_u32_b32 %0, -1, %0" : "=v"(l_)); l_; })
    const int G = gridDim.x, bid = blockIdx.x;
    const int lo = a_in.ph_lo, hi = a_in.ph_hi;
    volatile LAS unsigned* MISC = (volatile LAS unsigned*)(lds + LDS_BYTES - 256);
    XcdBarrier bar; bar.bar = (unsigned*)(a_in.ws + WS_CTL); bar.x = 0; bar.st = MISC + 8;
    if (hi - lo > 1) { if (threadIdx.x < 64) MISC[threadIdx.x] = 0u; __syncthreads(); bar = xcd_barrier_post((unsigned*)(a_in.ws + WS_CTL), MISC + 8); }
#define IN(k) (lo <= (k) && (k) < hi)
#ifndef PROBE
#define PROBE 0
#endif
#define DUP(n) for (int rep_ = 0; rep_ < ((PROBE == (n)) ? 2 : 1); ++rep_)
#ifndef TPROBE
#define TPROBE 0
#endif
    unsigned long long tstart = 0ull;
#define TBEG(cls) do { if ((TPROBE >> (cls)) & 1) { if (threadIdx.x == 0 && blockIdx.x == 0) tstart = __builtin_amdgcn_s_memrealtime(); } } while (0)
#define TEND(cls) do { if ((TPROBE >> (cls)) & 1) { if (threadIdx.x == 0 && blockIdx.x == 0) MISC[16] += (unsigned)(__builtin_amdgcn_s_memrealtime() - tstart); } } while (0)
#define SEAM(k) do { TBEG(10); if (IN(k) && IN((k) + 1)) { if ((k) == 0) cg::this_grid().sync(); else xcd_barrier(bar); if (PROBE == 9) xcd_barrier(bar); } TEND(10); } while (0)
    TBEG(1); if (IN(0)) { const PArgs a = launder(a_in); DUP(1) { weights_phase(a, lds, wave, LANE()); __syncthreads(); } norm_phase<0>(a, 0, lds, wave, LANE()); __syncthreads(); } TEND(1);
    SEAM(0);
#pragma unroll
    for (int l = 0; l < 2; ++l) {
        const int p0 = 1 + 8 * l;
        TBEG(2); if (IN(p0 + 0)) DUP(2) { const PArgs a = launder(a_in); pg8::Gemm g{(const bf16_t*)(const unsigned char*)(a.ws + WS_XA), (const bf16_t*)(const unsigned char*)(a.ws + WS_WT_IN + l * SZ_WT_IN), MREAL, NPROJ, D}; pg8::StaticOrder S; S.init(MREAL, NPROJ, G, bid);
            EpiProj E{(GAS bf16_t*)(a.ws + WS_PROJ)}; pg8::gemm_phase<EpiProj, pg8::StaticOrder, true, true>(lds, g, S, E, wave); mini_gemm<1>(a, l, lds, wave, LANE()); } TEND(2);
        SEAM(p0 + 0);
        TBEG(3); if (IN(p0 + 1)) DUP(3) { const PArgs a = launder(a_in); mlstm_phase(a, lds, wave, LANE(), l == 0 ? 1 : -1); __syncthreads(); } TEND(3);
        SEAM(p0 + 1);
        TBEG(4); if (IN(p0 + 2)) DUP(4) { const PArgs a = launder(a_in); cat_phase(a, l, wave, LANE()); } TEND(4);
        SEAM(p0 + 2);
        TBEG(5); if (IN(p0 + 3)) { const PArgs a = launder(a_in); pg8::Gemm g{(const bf16_t*)(const unsigned char*)(a.ws + WS_XA), (const bf16_t*)(const unsigned char*)(a.ws + WS_WT_OUT + l * SZ_WT_OUT), MREAL, D, D}; pg8::StaticOrder S; S.init(MREAL, D, G, bid);
            EpiResid E{a.out}; pg8::gemm_phase<EpiResid, pg8::StaticOrder, true, true>(lds, g, S, E, wave); mini_gemm<2>(a, l, lds, wave, LANE()); } TEND(5);
        SEAM(p0 + 3);
        TBEG(6); if (IN(p0 + 4)) DUP(5) { const PArgs a = launder(a_in); norm_phase<2>(a, l, lds, wave, LANE()); } TEND(6);
        SEAM(p0 + 4);
        TBEG(7); if (IN(p0 + 5)) DUP(6) { const PArgs a = launder(a_in); pg8::Gemm g{(const bf16_t*)(const unsigned char*)(a.ws + WS_XA), (const bf16_t*)(const unsigned char*)(a.ws + WS_WT_GU + l * SZ_WT_GU), MREAL, NGU, D}; pg8::StaticOrder S; S.init(MREAL, NGU, G, bid);
            EpiSwiglu E{(GAS bf16_t*)(a.ws + WS_PROJ)}; pg8::gemm_phase<EpiSwiglu, pg8::StaticOrder, true, true>(lds, g, S, E, wave); mini_gemm<3>(a, l, lds, wave, LANE()); } TEND(7);
        SEAM(p0 + 5);
        TBEG(8); if (IN(p0 + 6)) { const PArgs a = launder(a_in); pg8::Gemm g{(const bf16_t*)(const unsigned char*)(a.ws + WS_PROJ), (const bf16_t*)(const unsigned char*)(a.ws + WS_WT_DN + l * SZ_WT_DN), MREAL, D, DFF}; pg8::StaticOrder S; S.init(MREAL, D, G, bid);
            EpiResid E{a.out}; pg8::gemm_phase<EpiResid, pg8::StaticOrder, true, true>(lds, g, S, E, wave); mini_gemm<4>(a, l, lds, wave, LANE()); } TEND(8);
        SEAM(p0 + 6);
        TBEG(9); if (IN(p0 + 7)) { const PArgs a = launder(a_in); if (l == 0) { norm_phase<1>(a, 1, lds, wave, LANE()); __syncthreads(); } else norm_phase<3>(a, 0, lds, wave, LANE()); } TEND(9);
        if (l == 0) SEAM(p0 + 7);
    }
    if (TPROBE) { if (threadIdx.x == 0 && blockIdx.x == 0) { const unsigned long long t0 = __builtin_amdgcn_s_memrealtime(); const unsigned dly = MISC[16]; while ((unsigned)(__builtin_amdgcn_s_memrealtime() - t0) < dly) __builtin_amdgcn_s_sleep(8); } }
#undef IN
#undef SEAM
}

extern "C" void kernel_launch(void* const* d_in, const int* in_sizes, int n_in, void* d_out, int out_size, void* d_ws, size_t ws_size, hipStream_t stream) {
    static int grid = 0;
    if (grid == 0) {
        if (n_in != 13 || in_sizes[0] != MREAL * D || out_size != MREAL * D || ws_size < WS_END) {
            fprintf(stderr, "kernel_launch: unexpected shapes (n_in %d, in0 %d, out %d, ws %zu; need ws >= %zu); nothing launched\n", n_in, n_in > 0 ? in_sizes[0] : -1, out_size, ws_size, (size_t)WS_END); grid = -1; return; }
        int dev = 0, cus = 0, per_cu = 0;
        hipGetDevice(&dev); hipDeviceGetAttribute(&cus, hipDeviceAttributeMultiprocessorCount, dev);
        if (hipFuncSetAttribute((const void*)hymba_fwd, hipFuncAttributeMaxDynamicSharedMemorySize, LDS_BYTES) != hipSuccess) { fprintf(stderr, "kernel_launch: hipFuncSetAttribute failed\n"); grid = -1; return; }
        if (hipOccupancyMaxActiveBlocksPerMultiprocessor(&per_cu, (const void*)hymba_fwd, NTHREADS, LDS_BYTES) != hipSuccess || per_cu < 1) { fprintf(stderr, "kernel_launch: occupancy query says %d\n", per_cu); per_cu = 1; }
        (void)hipGetLastError();
        grid = cus * per_cu;
        if (grid != 256) { fprintf(stderr, "kernel_launch: built for a 256-workgroup grid (MI355X, one per CU); got %d; nothing launched\n", grid); grid = -1; return; }
    }
    if (grid < 0) return;
    Args a{};
    a.x = (const float*)d_in[0]; a.meta = (const float*)d_in[1]; a.nmw = (const float*)d_in[2]; a.win = (const float*)d_in[3]; a.bg = (const float*)d_in[4]; a.cw = (const float*)d_in[5];
    a.mnw = (const float*)d_in[6]; a.wout = (const float*)d_in[7]; a.nfw = (const float*)d_in[8]; a.wg = (const float*)d_in[9]; a.wu = (const float*)d_in[10]; a.wd = (const float*)d_in[11]; a.nfin = (const float*)d_in[12];
    a.out = (float*)d_out; a.ws = (unsigned char*)d_ws;
#if MK_PER_PHASE
    for (int p = 0; p < N_PHASES; ++p) { a.ph_lo = p; a.ph_hi = p + 1; hipLaunchKernelGGL(hymba_fwd, dim3(grid), dim3(NTHREADS), LDS_BYTES, stream, a); }
#else
    a.ph_lo = 0; a.ph_hi = N_PHASES;
    if (hipMemsetAsync((char*)d_ws + WS_CTL, 0, CTL_BYTES, stream) != hipSuccess) { fprintf(stderr, "kernel_launch: memset failed\n"); return; }
    void* args[] = {&a};
    hipError_t e = hipLaunchCooperativeKernel((const void*)hymba_fwd, dim3(grid), dim3(NTHREADS), args, LDS_BYTES, stream);
    if (e != hipSuccess) fprintf(stderr, "kernel_launch: cooperative launch failed: %s (grid %d)\n", hipGetErrorString(e), grid);
#endif
}
```
